# Optimizing an MI355X kernel written in HIP

```python
import jax
import jax.numpy as jnp
from jax import lax
import numpy as np

D_MODEL = 1024
BATCH = 4
SEQ = 8192
DEPTH = 1

HEAD_DIM = 64
RWKV_WIDTH = D_MODEL // 2
RWKV_HEADS = RWKV_WIDTH // HEAD_DIM
DECAY_LORA = 64
ICLR_LORA = 64
RWKV_GN_EPS = 64e-5
NSA_WIDTH = D_MODEL // 4
NSA_HEADS = NSA_WIDTH // HEAD_DIM
N_BRANCH = 3
CMP_BLOCK = 32
CMP_STRIDE = 16
SEL_BLOCK = 64
SEL_TOPK = 16
WINDOW = 512
MEM_LEN = 256
MEM_WIDTH = D_MODEL // 4
MEM_HEADS = 4
MEM_HEAD_DIM = MEM_WIDTH // MEM_HEADS
MIX_WIDTH = RWKV_WIDTH + NSA_WIDTH + MEM_WIDTH
ROPE_THETA = 500000.0
ROPE_DIM = HEAD_DIM // 4
Q_BLOCK = 128
NORM_EPS = 1e-6
NEG_INF = -1e30
FORCE_SCORE = 1e4

RWKV_SIZES = (RWKV_WIDTH, RWKV_WIDTH, RWKV_WIDTH, RWKV_WIDTH, DECAY_LORA, ICLR_LORA)
NSA_SIZES = (NSA_WIDTH, NSA_WIDTH, NSA_HEADS * N_BRANCH) + (HEAD_DIM,) * 6
MEM_SIZES = (MEM_WIDTH, MEM_WIDTH)
RWKV_COLS = sum(RWKV_SIZES)
NSA_COLS = sum(NSA_SIZES)
MEM_COLS = sum(MEM_SIZES)
IN_COLS = RWKV_COLS + NSA_COLS + MEM_COLS

kernel_name = 'hymba_rwkv7_nsa_memx_layer'


def split_cols(p, sizes):
    offs = [int(o) for o in np.cumsum(sizes)[:-1]]
    return jnp.split(p, offs, axis=-1)


def rms_norm(x, g, eps=NORM_EPS):
    xf = x.astype(jnp.float32)
    y = xf * lax.rsqrt(jnp.mean(xf * xf, axis=-1, keepdims=True) + eps)
    return (y * g.astype(jnp.float32)).astype(x.dtype)


def partial_rope(x, pos):
    half = ROPE_DIM // 2
    inv_freq = ROPE_THETA ** (-jnp.arange(half, dtype=jnp.float32) / half)
    ang = pos.astype(jnp.float32)[:, None] * inv_freq[None, :]
    cos = jnp.cos(ang)[:, None, :]
    sin = jnp.sin(ang)[:, None, :]
    xf = x.astype(jnp.float32)
    x1 = xf[..., :half]
    x2 = xf[..., half:ROPE_DIM]
    out = jnp.concatenate([x1 * cos - x2 * sin, x2 * cos + x1 * sin, xf[..., ROPE_DIM:]], axis=-1)
    return out.astype(x.dtype)


def masked_softmax(s, mask):
    s = jnp.where(mask, s.astype(jnp.float32), NEG_INF)
    m = jnp.max(s, axis=-1, keepdims=True)
    e = jnp.exp(s - m) * mask
    return e / jnp.maximum(jnp.sum(e, axis=-1, keepdims=True), 1e-30)


def head_rms_norm(o, g):
    of = o.astype(jnp.float32)
    y = of * lax.rsqrt(jnp.mean(of * of, axis=-1, keepdims=True) + NORM_EPS)
    return (y * g.astype(jnp.float32)).astype(o.dtype)


def rwkv7_scan(r, decay, k, v, kk, a):
    B, T, H, N = r.shape

    def step(S, inp):
        r_t, w_t, k_t, v_t, kk_t, a_t = inp
        sa = jnp.einsum('bhvk,bhk->bhv', S, -kk_t)
        S = (S * w_t[:, :, None, :]
             + sa[..., None] * (kk_t * a_t)[:, :, None, :]
             + v_t[..., None] * k_t[:, :, None, :])
        y = jnp.einsum('bhvk,bhk->bhv', S, r_t)
        return S, y

    xs = tuple(jnp.moveaxis(u, 1, 0) for u in (r, decay, k, v, kk, a))
    S0 = jnp.zeros((B, H, N, N), jnp.float32)
    _, y = lax.scan(step, S0, xs)
    return jnp.moveaxis(y, 0, 1)


def rwkv7_group(p, mu, w0, w_up, a0, a_up, k_k, k_a, r_k, ln_w, ln_b):
    B, T, _ = p.shape
    H, N = RWKV_HEADS, HEAD_DIM
    pf = p.astype(jnp.float32)
    prev = jnp.pad(pf, ((0, 0), (1, 0), (0, 0)))[:, :-1]
    pf = pf + mu * (prev - pf)
    r, k, v, gate, wd, ad = split_cols(pf, RWKV_SIZES)
    w_log = -jax.nn.softplus(-(w0 + jnp.tanh(wd) @ w_up)) - 0.5
    decay = jnp.exp(-jnp.exp(w_log))
    a = jax.nn.sigmoid(a0 + ad @ a_up)
    kk = k * k_k
    k = k * (1.0 + (a - 1.0) * k_a)
    r, k, v, kk, a, decay = (u.reshape(B, T, H, N) for u in (r, k, v, kk, a, decay))
    kk = kk / jnp.maximum(jnp.sqrt(jnp.sum(kk * kk, axis=-1, keepdims=True)), 1e-12)
    y = rwkv7_scan(r, decay, k, v, kk, a)
    mean = jnp.mean(y, axis=-1, keepdims=True)
    var = jnp.mean(jnp.square(y - mean), axis=-1, keepdims=True)
    y = (y - mean) * lax.rsqrt(var + RWKV_GN_EPS) * ln_w.reshape(H, N) + ln_b.reshape(H, N)
    y = y + jnp.sum(r * k * r_k, axis=-1, keepdims=True) * v
    y = y.reshape(B, T, RWKV_WIDTH) * jax.nn.silu(gate)
    return y.astype(p.dtype)


def nsa_group(p, pos, cmp_pos, ck_w1, ck_w2, cv_w1, cv_w2, gate_b, out_g):
    B, T, _ = p.shape
    Hn, D = NSA_HEADS, HEAD_DIM
    q, gate, glog, kc, vc, ks, vs, kw, vw = split_cols(p, NSA_SIZES)
    q = q.reshape(B, T, Hn, D)
    q_rope = partial_rope(q, pos)
    ks = partial_rope(ks[:, :, None, :], pos)[:, :, 0]
    kw = partial_rope(kw[:, :, None, :], pos)[:, :, 0]
    scale = HEAD_DIM ** -0.5

    n_cmp = (T - CMP_BLOCK) // CMP_STRIDE + 1
    blk = jnp.arange(n_cmp)[:, None] * CMP_STRIDE + jnp.arange(CMP_BLOCK)[None, :]

    def compress(u, w1, w2):
        ub = (u[:, blk] + cmp_pos).reshape(B, n_cmp, CMP_BLOCK * D)
        return jax.nn.silu(ub @ w1) @ w2

    k_cmp = compress(kc, ck_w1, ck_w2)
    v_cmp = compress(vc, cv_w1, cv_w2)
    cmp_end = blk[:, -1]

    n_sel = T // SEL_BLOCK
    n_top = min(SEL_TOPK, n_sel)
    sel_start = jnp.arange(n_sel) * SEL_BLOCK
    overlap = jnp.clip(jnp.minimum(blk[:, -1:] + 1, sel_start[None, :] + SEL_BLOCK)
                       - jnp.maximum(blk[:, :1], sel_start[None, :]), 0, None)
    overlap = overlap.astype(jnp.float32) / CMP_BLOCK
    k_sel_blk = ks.reshape(B, n_sel, SEL_BLOCK, D)
    v_sel_blk = vs.reshape(B, n_sel, SEL_BLOCK, D)
    blk_id = jnp.arange(n_sel)

    kw_pad = jnp.pad(kw, ((0, 0), (WINDOW, 0), (0, 0)))
    vw_pad = jnp.pad(vw, ((0, 0), (WINDOW, 0), (0, 0)))

    def per_block(qb):
        t0 = qb * Q_BLOCK
        tq = t0 + jnp.arange(Q_BLOCK)
        qn = lax.dynamic_slice_in_dim(q, t0, Q_BLOCK, axis=1)
        qr = lax.dynamic_slice_in_dim(q_rope, t0, Q_BLOCK, axis=1)
        s_c = jnp.einsum('bqhd,bcd->bhqc', qn, k_cmp) * scale
        p_c = masked_softmax(s_c, cmp_end[None, :] <= tq[:, None])
        o_c = jnp.einsum('bhqc,bcd->bqhd', p_c.astype(v_cmp.dtype), v_cmp)
        imp = jnp.einsum('bhqc,cs->bqs', p_c, overlap)
        cur = tq // SEL_BLOCK
        valid = blk_id[None, :] <= cur[:, None]
        forced = (blk_id[None, :] == 0) | (blk_id[None, :] == cur[:, None]) | (blk_id[None, :] == cur[:, None] - 1)
        score = jnp.where(forced, FORCE_SCORE, jnp.where(valid, imp, -1.0))
        _, idx = lax.top_k(score, n_top)
        kg = jax.vmap(lambda kb, ib: kb[ib])(k_sel_blk, idx).reshape(B, Q_BLOCK, n_top * SEL_BLOCK, D)
        vg = jax.vmap(lambda vb, ib: vb[ib])(v_sel_blk, idx).reshape(B, Q_BLOCK, n_top * SEL_BLOCK, D)
        kpos = (idx[..., None] * SEL_BLOCK + jnp.arange(SEL_BLOCK)).reshape(B, Q_BLOCK, n_top * SEL_BLOCK)
        s_s = jnp.einsum('bqhd,bqkd->bhqk', qr, kg) * scale
        p_s = masked_softmax(s_s, (kpos <= tq[None, :, None])[:, None])
        o_s = jnp.einsum('bhqk,bqkd->bqhd', p_s.astype(vg.dtype), vg)
        kwb = lax.dynamic_slice_in_dim(kw_pad, t0, Q_BLOCK + WINDOW, axis=1)
        vwb = lax.dynamic_slice_in_dim(vw_pad, t0, Q_BLOCK + WINDOW, axis=1)
        wpos = t0 - WINDOW + jnp.arange(Q_BLOCK + WINDOW)
        diff = tq[:, None] - wpos[None, :]
        m_w = (diff >= 0) & (diff < WINDOW) & (wpos[None, :] >= 0)
        s_w = jnp.einsum('bqhd,bkd->bhqk', qr, kwb) * scale
        p_w = masked_softmax(s_w, m_w)
        o_w = jnp.einsum('bhqk,bkd->bqhd', p_w.astype(vwb.dtype), vwb)
        return o_c, o_s, o_w

    o_c, o_s, o_w = lax.map(per_block, jnp.arange(T // Q_BLOCK))
    o_c, o_s, o_w = (jnp.moveaxis(o, 0, 1).reshape(B, T, Hn, D) for o in (o_c, o_s, o_w))
    g = jax.nn.sigmoid(glog.reshape(B, T, Hn, N_BRANCH) + gate_b.reshape(Hn, N_BRANCH))
    o = g[..., 0:1] * o_c + g[..., 1:2] * o_s + g[..., 2:3] * o_w
    o = head_rms_norm(o, out_g.reshape(Hn, D))
    return o.reshape(B, T, NSA_WIDTH) * jax.nn.silu(gate)


def memory_group(p, mem_k, mem_v, out_g):
    B, T, _ = p.shape
    q, gate = split_cols(p, MEM_SIZES)
    q = q.reshape(B, T, MEM_HEADS, MEM_HEAD_DIM)
    s = jnp.einsum('bthd,bmhd->bhtm', q, mem_k) * (MEM_HEAD_DIM ** -0.5)
    prob = jax.nn.softmax(s.astype(jnp.float32), axis=-1)
    o = jnp.einsum('bhtm,bmhd->bthd', prob.astype(mem_v.dtype), mem_v)
    o = head_rms_norm(o, out_g.reshape(MEM_HEADS, MEM_HEAD_DIM))
    return o.reshape(B, T, MEM_WIDTH) * jax.nn.silu(gate)


def setup_inputs(seed: int = 0) -> dict:
    key = jax.random.key(seed)
    ks = jax.random.split(key, 32)
    L = DEPTH
    f32 = jnp.float32

    def nrm(k, shape, scale):
        return jax.random.normal(k, shape, f32) * scale

    def gain(k, shape):
        return 1.0 + 0.05 * jax.random.normal(k, shape, f32)

    cmp_in = CMP_BLOCK * HEAD_DIM
    return {
        'x': nrm(ks[0], (BATCH, SEQ, D_MODEL), 1.0),
        'mem': nrm(ks[1], (BATCH, MEM_LEN, D_MODEL), 1.0),
        'norm_in_g': gain(ks[2], (L, D_MODEL)),
        'w_in': nrm(ks[3], (L, D_MODEL, IN_COLS), D_MODEL ** -0.5),
        'rwkv_mu': jax.random.uniform(ks[4], (L, RWKV_COLS), f32, 0.2, 0.8),
        'rwkv_w0': jax.random.uniform(ks[5], (L, RWKV_WIDTH), f32, -5.0, -1.0),
        'rwkv_w_up': nrm(ks[6], (L, DECAY_LORA, RWKV_WIDTH), 0.1 * DECAY_LORA ** -0.5),
        'rwkv_a0': nrm(ks[7], (L, RWKV_WIDTH), 0.5),
        'rwkv_a_up': nrm(ks[8], (L, ICLR_LORA, RWKV_WIDTH), ICLR_LORA ** -0.5),
        'rwkv_k_k': 0.85 + 0.05 * jax.random.normal(ks[9], (L, RWKV_WIDTH), f32),
        'rwkv_k_a': 1.0 + 0.05 * jax.random.normal(ks[10], (L, RWKV_WIDTH), f32),
        'rwkv_r_k': nrm(ks[11], (L, RWKV_HEADS, HEAD_DIM), 0.1),
        'rwkv_ln_w': gain(ks[12], (L, RWKV_WIDTH)),
        'rwkv_ln_b': nrm(ks[13], (L, RWKV_WIDTH), 0.02),
        'nsa_cmp_pos': nrm(ks[14], (L, CMP_BLOCK, HEAD_DIM), 0.1),
        'nsa_cmp_k_w1': nrm(ks[15], (L, cmp_in, HEAD_DIM), cmp_in ** -0.5),
        'nsa_cmp_k_w2': nrm(ks[16], (L, HEAD_DIM, HEAD_DIM), HEAD_DIM ** -0.5),
        'nsa_cmp_v_w1': nrm(ks[17], (L, cmp_in, HEAD_DIM), cmp_in ** -0.5),
        'nsa_cmp_v_w2': nrm(ks[18], (L, HEAD_DIM, HEAD_DIM), HEAD_DIM ** -0.5),
        'nsa_gate_b': nrm(ks[19], (L, NSA_HEADS * N_BRANCH), 0.1),
        'nsa_out_g': gain(ks[20], (L, NSA_WIDTH)),
        'mem_norm_g': gain(ks[21], (L, D_MODEL)),
        'w_mem_kv': nrm(ks[22], (L, D_MODEL, 2 * MEM_WIDTH), D_MODEL ** -0.5),
        'mem_out_g': gain(ks[23], (L, MEM_WIDTH)),
        'w_out': nrm(ks[24], (L, MIX_WIDTH, D_MODEL), MIX_WIDTH ** -0.5),
        'norm_final_g': gain(ks[25], (D_MODEL,)),
    }


def reference(x, mem, norm_in_g, w_in, rwkv_mu, rwkv_w0, rwkv_w_up, rwkv_a0, rwkv_a_up,
              rwkv_k_k, rwkv_k_a, rwkv_r_k, rwkv_ln_w, rwkv_ln_b, nsa_cmp_pos, nsa_cmp_k_w1,
              nsa_cmp_k_w2, nsa_cmp_v_w1, nsa_cmp_v_w2, nsa_gate_b, nsa_out_g, mem_norm_g,
              w_mem_kv, mem_out_g, w_out, norm_final_g):
    B, T, _ = x.shape
    M = mem.shape[1]
    pos = jnp.arange(T)
    for l in range(DEPTH):
        h = rms_norm(x, norm_in_g[l])
        p = h @ w_in[l]
        p_rwkv, p_nsa, p_mem = jnp.split(p, [RWKV_COLS, RWKV_COLS + NSA_COLS], axis=-1)
        y_rwkv = rwkv7_group(p_rwkv, rwkv_mu[l], rwkv_w0[l], rwkv_w_up[l], rwkv_a0[l], rwkv_a_up[l],
                             rwkv_k_k[l], rwkv_k_a[l], rwkv_r_k[l], rwkv_ln_w[l], rwkv_ln_b[l])
        y_nsa = nsa_group(p_nsa, pos, nsa_cmp_pos[l], nsa_cmp_k_w1[l], nsa_cmp_k_w2[l],
                          nsa_cmp_v_w1[l], nsa_cmp_v_w2[l], nsa_gate_b[l], nsa_out_g[l])
        kv = rms_norm(mem, mem_norm_g[l]) @ w_mem_kv[l]
        mem_k, mem_v = jnp.split(kv.reshape(B, M, 2, MEM_HEADS, MEM_HEAD_DIM), 2, axis=2)
        y_mem = memory_group(p_mem, mem_k[:, :, 0], mem_v[:, :, 0], mem_out_g[l])
        y = jnp.concatenate([y_rwkv.astype(x.dtype), y_nsa.astype(x.dtype), y_mem.astype(x.dtype)], axis=-1)
        x = x + y @ w_out[l]
    return rms_norm(x, norm_final_g)
```

```cpp
#include <hip/hip_runtime.h>
#include <cstdio>
#include <cstdint>
namespace pg8 {
#define PG8_LAS __attribute__((address_space(3)))
typedef unsigned short bf16_t;
typedef short bf16x8 __attribute__((ext_vector_type(8)));
typedef float f32x4 __attribute__((ext_vector_type(4)));
typedef unsigned u32x4 __attribute__((ext_vector_type(4)));
constexpr int BM = 256, BK = 64, HALF = 128, HTB = HALF * BK * 2  , STAGE_BYTES = 8 * HTB, NXCD = 8, WGM = 8;

__host__ __device__ __forceinline__ int lds_byte(int r, int c) { const int st = (r >> 4) * 2 + (c >> 5), rr = r & 15, cc = c & 31, ob = rr * 64 + cc * 2; return st * 1024 + (ob ^ (((ob >> 9) & 1) << 5)); }
__host__ __device__ __forceinline__ void stage_rc(int b, int& R, int& C) { const int st = b / 1024, sb = b % 1024, swz = sb ^ (((sb >> 9) & 1) << 5); R = (st >> 1) * 16 + swz / 64; C = (st & 1) * 32 + (swz % 64) / 2; }
__host__ __device__ __forceinline__ int perm32(int rho) { const int n = rho >> 4, i = rho & 15; return 8 * (i >> 2) + 4 * n + (i & 3); }

struct Unit { int pm, pn; };
struct Gemm { const bf16_t* A; const bf16_t* Bt; int M, N, K; };

struct StaticOrder {
    int nM, nN, nwg, G, c;
    __host__ __device__ void init(int M, int N, int G_, int c_) { nM = M / BM; nN = N / BM; nwg = nM * nN; G = G_; c = c_; }
    __host__ __device__ bool next(int i, Unit& u) const {
        const long L = (long)i * G + c; if (L >= nwg) return false;
        int wgid = (int)L; { const int q = nwg / NXCD, r = nwg % NXCD, xcd = wgid % NXCD, off = wgid / NXCD; wgid = (xcd < r ? xcd * (q + 1) : r * (q + 1) + (xcd - r) * q) + off; }
        const int nig = WGM * nN, gid = wgid / nig, fm = gid * WGM, gsz = (nM - fm) < WGM ? (nM - fm) : WGM;
        u.pm = fm + ((wgid % nig) % gsz); u.pn = (wgid % nig) / gsz; return true;
    }
    __device__ __forceinline__ void a_ready(const Unit&) const {}
    __device__ __forceinline__ void done(const Unit&) const {}
};

__device__ __forceinline__ unsigned cvt_pk_bf16(float lo, float hi) { unsigned r; asm volatile("v_cvt_pk_bf16_f32 %0, %1, %2" : "=v"(r) : "v"(lo), "v"(hi)); return r; }

template <class Epi, class Sched, bool ALIGN_EPI = false, bool SP2 = false>
__device__ __forceinline__ void gemm_phase(PG8_LAS unsigned char* lds, const Gemm g, const Sched& S, const Epi& E) {
    int tid_o = threadIdx.x; asm volatile("" : "+v"(tid_o));
    const int tid = tid_o, wid = __builtin_amdgcn_readfirstlane(tid >> 6), lane = tid & 63, wr = wid >> 2, wc = wid & 3, fr = lane & 15, fq = lane >> 4;
    const int K = g.K, nt = K / BK;
    unsigned voffA[2], voffB[2];
#pragma unroll
    for (int i = 0; i < 2; ++i) { int R, C; stage_rc(tid * 16 + i * 8192, R, C); const int Rb = Epi::PERM ? ((R & ~31) + perm32(R & 31)) : R;
        voffA[i] = (unsigned)(R * K + C) * 2u; voffB[i] = (unsigned)(Rb * K + C) * 2u; }
    const size_t kstep = (size_t)(BK * 2);
    const size_t hstep = (size_t)HALF * K * 2;
    const size_t tstep = 2 * hstep;
    const unsigned ldsw = (unsigned)wid * 1024u;
    const int aoff = lds_byte(wr * 64 + fr, fq * 8), boff = lds_byte(wc * 32 + fr, fq * 8);
#define PG8_SA(b, h) (((b) * 2 + (h)) * HTB)
#define PG8_SB(b, h) ((4 + (b) * 2 + (h)) * HTB)
#define PG8_STAGE(bufoff, gbase, voff) do { _Pragma("unroll") for (int _i = 0; _i < 2; ++_i) \
        __builtin_amdgcn_global_load_lds((const unsigned*)((const char*)(gbase) + (voff)[_i]), (PG8_LAS unsigned*)(lds + (bufoff) + ldsw + _i * 8192), 16, 0, 0); } while (0)
#define PG8_LDA(dst, b, h) do { _Pragma("unroll") for (int m = 0; m < 4; ++m) _Pragma("unroll") for (int k = 0; k < 2; ++k) dst[m][k] = *(const PG8_LAS bf16x8*)(lds + PG8_SA(b, h) + aoff + m * 2048 + k * 1024); } while (0)
#define PG8_LDB(dst, b, h) do { _Pragma("unroll") for (int n = 0; n < 2; ++n) _Pragma("unroll") for (int k = 0; k < 2; ++k) dst[n][k] = *(const PG8_LAS bf16x8*)(lds + PG8_SB(b, h) + boff + n * 2048 + k * 1024); } while (0)
#define PG8_MMA(ai, bj, At, Bt) do { __builtin_amdgcn_s_setprio(1); _Pragma("unroll") for (int m = 0; m < 4; ++m) _Pragma("unroll") for (int n = 0; n < 2; ++n) _Pragma("unroll") for (int k = 0; k < 2; ++k) \
        acc[ai][bj][m][n] = __builtin_amdgcn_mfma_f32_16x16x32_bf16(Bt[n][k], At[m][k], acc[ai][bj][m][n], 0, 0, 0); __builtin_amdgcn_s_setprio(0); } while (0)
#define PG8_WAIT_V(n) asm volatile("s_waitcnt vmcnt(" #n ")" ::: "memory")
#define PG8_WAIT_L(n) asm volatile("s_waitcnt lgkmcnt(" #n ")" ::: "memory")
#define PG8_BAR __builtin_amdgcn_s_barrier()
#define PG8_SCHED __builtin_amdgcn_sched_barrier(0)
    Unit cur, nxt; int ui = 0;
    if (!S.next(0, cur)) return;
    f32x4 acc[2][2][4][2];
#pragma unroll
    for (int a = 0; a < 2; ++a)
#pragma unroll
        for (int b = 0; b < 2; ++b)
#pragma unroll
            for (int m = 0; m < 4; ++m)
#pragma unroll
                for (int n = 0; n < 2; ++n) acc[a][b][m][n] = (f32x4){0.f, 0.f, 0.f, 0.f};
    bf16x8 At[4][2], B0[2][2], B1[2][2];
    const char* cA = (const char*)g.A + (size_t)cur.pm * tstep; const char* cB = (const char*)g.Bt + (size_t)cur.pn * tstep;
    S.a_ready(cur);
    if constexpr (SP2) {
        PG8_STAGE(PG8_SB(0, 0), cB, voffB); PG8_STAGE(PG8_SB(0, 1), cB + hstep, voffB); PG8_STAGE(PG8_SA(0, 0), cA, voffA); PG8_STAGE(PG8_SA(0, 1), cA + hstep, voffA);
        if (wr == 1) PG8_BAR;
        PG8_WAIT_V(2); PG8_BAR;
        PG8_STAGE(PG8_SB(1, 0), cB + kstep, voffB); PG8_STAGE(PG8_SA(1, 0), cA + kstep, voffA); PG8_STAGE(PG8_SB(1, 1), cB + hstep + kstep, voffB);
        PG8_WAIT_V(6); PG8_BAR;
    } else {
        PG8_STAGE(PG8_SB(0, 0), cB, voffB); PG8_STAGE(PG8_SA(0, 0), cA, voffA); PG8_STAGE(PG8_SB(0, 1), cB + hstep, voffB); PG8_STAGE(PG8_SA(0, 1), cA + hstep, voffA);
        if (wr == 1) PG8_BAR;
        PG8_WAIT_V(4); PG8_BAR;
        PG8_STAGE(PG8_SB(1, 0), cB + kstep, voffB); PG8_STAGE(PG8_SA(1, 0), cA + kstep, voffA); PG8_STAGE(PG8_SB(1, 1), cB + hstep + kstep, voffB);
        PG8_WAIT_V(6); PG8_BAR;
    }
    for (;;) {
        const bool has_next = S.next(ui + 1, nxt);
        const char* nA = has_next ? (const char*)g.A + (size_t)nxt.pm * tstep : cA; const char* nB = has_next ? (const char*)g.Bt + (size_t)nxt.pn * tstep : cB;
        for (int t = 0; t < nt; t += 2) {
            const bool last = (t == nt - 2);
            const char* a1 = cA + (size_t)(t + 1) * kstep;
            const char* a2 = last ? nA : cA + (size_t)(t + 2) * kstep; const char* b2 = last ? nB : cB + (size_t)(t + 2) * kstep;
            const char* a3 = a2 + kstep; const char* b3 = b2 + kstep;
            if (last && has_next) S.a_ready(nxt);
            if constexpr (SP2) {
            PG8_LDB(B0, 0, 0); PG8_LDB(B1, 0, 1); PG8_SCHED; PG8_LDA(At, 0, 0); PG8_STAGE(PG8_SA(1, 1), a1 + hstep, voffA);
            PG8_WAIT_V(8); PG8_WAIT_L(0); PG8_BAR; PG8_MMA(0, 0, At, B0); PG8_MMA(0, 1, At, B1); PG8_BAR; PG8_SCHED;
            PG8_LDA(At, 0, 1); PG8_STAGE(PG8_SB(0, 0), b2, voffB); PG8_STAGE(PG8_SB(0, 1), b2 + hstep, voffB); PG8_STAGE(PG8_SA(0, 0), a2, voffA);
            PG8_WAIT_V(8); PG8_WAIT_L(0); PG8_BAR; PG8_MMA(1, 0, At, B0); PG8_MMA(1, 1, At, B1); PG8_BAR; PG8_SCHED;
            PG8_LDB(B0, 1, 0); PG8_LDB(B1, 1, 1); PG8_SCHED; PG8_LDA(At, 1, 0); PG8_STAGE(PG8_SA(0, 1), a2 + hstep, voffA);
            PG8_WAIT_V(8); PG8_WAIT_L(0); PG8_BAR; PG8_MMA(0, 0, At, B0); PG8_MMA(0, 1, At, B1); PG8_BAR; PG8_SCHED;
            PG8_LDA(At, 1, 1); PG8_STAGE(PG8_SB(1, 0), b3, voffB); PG8_STAGE(PG8_SB(1, 1), b3 + hstep, voffB); PG8_STAGE(PG8_SA(1, 0), a3, voffA);
            PG8_WAIT_V(8); PG8_WAIT_L(0); PG8_BAR; PG8_MMA(1, 0, At, B0); PG8_MMA(1, 1, At, B1); PG8_BAR; PG8_SCHED;
            } else {
            PG8_LDB(B0, 0, 0); PG8_SCHED; PG8_LDA(At, 0, 0); PG8_STAGE(PG8_SA(1, 1), a1 + hstep, voffA);
            PG8_WAIT_L(8); PG8_BAR; PG8_WAIT_L(0); PG8_MMA(0, 0, At, B0); PG8_BAR; PG8_SCHED;
            PG8_LDB(B1, 0, 1); PG8_STAGE(PG8_SB(0, 0), b2, voffB);
            PG8_BAR; PG8_WAIT_L(0); PG8_MMA(0, 1, At, B1); PG8_BAR;
            PG8_LDA(At, 0, 1); PG8_STAGE(PG8_SA(0, 0), a2, voffA);
            PG8_BAR; PG8_WAIT_L(0); PG8_MMA(1, 0, At, B0); PG8_BAR; PG8_SCHED;
            PG8_STAGE(PG8_SB(0, 1), b2 + hstep, voffB);
            PG8_WAIT_V(6); PG8_BAR; PG8_MMA(1, 1, At, B1); PG8_BAR;
            PG8_LDB(B0, 1, 0); PG8_SCHED; PG8_LDA(At, 1, 0); PG8_STAGE(PG8_SA(0, 1), a2 + hstep, voffA);
            PG8_WAIT_L(8); PG8_BAR; PG8_WAIT_L(0); PG8_MMA(0, 0, At, B0); PG8_BAR; PG8_SCHED;
            PG8_LDB(B1, 1, 1); PG8_STAGE(PG8_SB(1, 0), b3, voffB);
            PG8_BAR; PG8_WAIT_L(0); PG8_MMA(0, 1, At, B1); PG8_BAR;
            PG8_LDA(At, 1, 1); PG8_STAGE(PG8_SA(1, 0), a3, voffA);
            PG8_BAR; PG8_WAIT_L(0); PG8_MMA(1, 0, At, B0); PG8_BAR; PG8_SCHED;
            PG8_STAGE(PG8_SB(1, 1), b3 + hstep, voffB);
            PG8_WAIT_V(6); PG8_BAR; PG8_MMA(1, 1, At, B1); PG8_BAR;
            }
        }
        if constexpr (ALIGN_EPI) { if (wr == 0) PG8_BAR; }
        if constexpr (!Epi::AFTER_DRAIN) { E(acc, cur, wr, wc, fr, fq); S.done(cur); }
        if (!has_next) break;
#pragma unroll
        for (int a = 0; a < 2; ++a)
#pragma unroll
            for (int b = 0; b < 2; ++b)
#pragma unroll
                for (int m = 0; m < 4; ++m)
#pragma unroll
                    for (int n = 0; n < 2; ++n) acc[a][b][m][n] = (f32x4){0.f, 0.f, 0.f, 0.f};
        cur = nxt; cA = nA; cB = nB; ++ui;
        if constexpr (ALIGN_EPI) { if (wr == 1) PG8_BAR; }
    }
    PG8_WAIT_V(0);
    if constexpr (!ALIGN_EPI) { if (wr == 0) PG8_BAR; }
    PG8_BAR;
    if constexpr (Epi::AFTER_DRAIN) { E.fused(acc, cur, wr, wc, fr, fq, lds, wid, lane); S.done(cur); }
#undef PG8_SA
#undef PG8_SB
#undef PG8_STAGE
#undef PG8_LDA
#undef PG8_LDB
#undef PG8_MMA
#undef PG8_WAIT_V
#undef PG8_WAIT_L
#undef PG8_BAR
#undef PG8_SCHED
}
}
namespace pg8 {
struct EpiRowScaleBf16 {
    static constexpr bool PERM = true, AFTER_DRAIN = false;
    bf16_t* O; int ldc; const float* rs;
    __device__ __forceinline__ void operator()(const f32x4 (&acc)[2][2][4][2], const Unit& u, int wr, int wc, int fr, int fq) const {
        const int row0 = u.pm * BM + wr * 64 + fr; const int col0 = u.pn * BM + wc * 32 + 8 * fq;
#pragma unroll
        for (int ai = 0; ai < 2; ++ai)
#pragma unroll
            for (int m = 0; m < 4; ++m) { const int row = row0 + ai * HALF + m * 16; const float sc = rs[row]; bf16_t* rowp = O + (size_t)row * ldc + col0;
#pragma unroll
                for (int bj = 0; bj < 2; ++bj) { f32x4 v0 = acc[ai][bj][m][0] * sc, v1 = acc[ai][bj][m][1] * sc;
                    u32x4 w; w.x = cvt_pk_bf16(v0[0], v0[1]); w.y = cvt_pk_bf16(v0[2], v0[3]); w.z = cvt_pk_bf16(v1[0], v1[1]); w.w = cvt_pk_bf16(v1[2], v1[3]);
                    *(u32x4*)(rowp + bj * HALF) = w; } }
    }
};
struct EpiResF32 {
    static constexpr bool PERM = false, AFTER_DRAIN = false;
    const float* base; float* out; int ldc;
    __device__ __forceinline__ void operator()(const f32x4 (&acc)[2][2][4][2], const Unit& u, int wr, int wc, int fr, int fq) const {
        const int col0 = u.pn * BM + wc * 32 + 4 * fq;
#pragma unroll
        for (int ai = 0; ai < 2; ++ai)
#pragma unroll
            for (int m = 0; m < 4; ++m) { const int r = u.pm * BM + ai * HALF + wr * 64 + m * 16 + fr; const size_t off = (size_t)r * ldc + col0;
#pragma unroll
                for (int bj = 0; bj < 2; ++bj)
#pragma unroll
                    for (int n = 0; n < 2; ++n) { const f32x4 bs = *(const f32x4*)(base + off + bj * HALF + n * 16); *(f32x4*)(out + off + bj * HALF + n * 16) = bs + acc[ai][bj][m][n]; } }
    }
};
}

constexpr int NB = 4, T = 8192, D = 1024, M = NB * T;
constexpr int NP = 3584;
constexpr int W_IN_COLS = 3596;
constexpr int C_R = 0, C_K = 512, C_V = 1024, C_G = 1536, C_WD = 2048, C_AD = 2112, C_NQ = 2176, C_NG = 2432, C_KC = 2688, C_VC = 2752,
              C_KS = 2816, C_VS = 2880, C_KW = 2944, C_VW = 3008, C_MQ = 3072, C_MG = 3328;
constexpr int GLOG_SRC = 2688;
constexpr int NCMP = 511, NSEL = 128, MEML = 256;

constexpr size_t MiB = 1u << 20;
constexpr size_t WS_CTL = 0, CTL_ZERO_BYTES = 1 * MiB;
constexpr size_t WS_WIN = 1 * MiB, WS_WOUT = 8 * MiB;
constexpr size_t WS_ROPE = 10 * MiB, WS_RS = 10 * MiB + 512 * 1024, WS_KCMP = 11 * MiB, WS_VCMP = 11 * MiB + 512 * 1024, WS_MEMKV = 12 * MiB, WS_GLOG = 14 * MiB;
constexpr size_t WS_P = 16 * MiB, WS_XB = 240 * MiB, WS_YR = 240 * MiB, WS_Y = 304 * MiB, WS_KK = 368 * MiB, WS_KA = 400 * MiB, WS_BB = 432 * MiB, WS_WD = 464 * MiB, WS_END = 496 * MiB;
constexpr int CW_BAR = 4096;

constexpr int RING_BYTES = 131072, LDSCTL_OFF = RING_BYTES, MISC_OFF = LDSCTL_OFF + 320, LDS_BYTES = 147456;
constexpr int NWAVES = 8;

#define GAS __attribute__((address_space(1)))
#define LAS __attribute__((address_space(3)))
typedef unsigned short bf16;
typedef unsigned v4u __attribute__((ext_vector_type(4)));
typedef unsigned v2u __attribute__((ext_vector_type(2)));
typedef float f32x4 __attribute__((ext_vector_type(4)));
#define LDS_WAIT() asm volatile("s_waitcnt lgkmcnt(0)" ::: "memory")
__device__ __forceinline__ unsigned f2bf(float f) { unsigned u = __builtin_bit_cast(unsigned, f); return (u + 0x7fffu + ((u >> 16) & 1u)) >> 16; }
__device__ __forceinline__ unsigned pk2(float lo, float hi) { return f2bf(lo) | (f2bf(hi) << 16); }
__device__ __forceinline__ float bf2f(unsigned short h) { return __builtin_bit_cast(float, (unsigned)h << 16); }
__device__ __forceinline__ float bflo(unsigned u) { return __builtin_bit_cast(float, u << 16); }
__device__ __forceinline__ float bfhi(unsigned u) { return __builtin_bit_cast(float, u & 0xffff0000u); }
__device__ __forceinline__ void unpack8(const v4u v, float (&f)[8]) { f[0] = bflo(v.x); f[1] = bfhi(v.x); f[2] = bflo(v.y); f[3] = bfhi(v.y); f[4] = bflo(v.z); f[5] = bfhi(v.z); f[6] = bflo(v.w); f[7] = bfhi(v.w); }
__device__ __forceinline__ v4u pack8(const float (&f)[8]) { v4u o; o.x = pk2(f[0], f[1]); o.y = pk2(f[2], f[3]); o.z = pk2(f[4], f[5]); o.w = pk2(f[6], f[7]); return o; }
__device__ __forceinline__ float rdlane(float v, int l) { return __builtin_bit_cast(float, __builtin_amdgcn_readlane(__builtin_bit_cast(int, v), l)); }
template <int CTRL> __device__ __forceinline__ float dppf(float v) { return __builtin_bit_cast(float, __builtin_amdgcn_update_dpp(0, __builtin_bit_cast(int, v), CTRL, 0xf, 0xf, true)); }
__device__ __forceinline__ float sum8(float x) { x += dppf<0xB1>(x); x += dppf<0x4E>(x); x += dppf<0x141>(x); return x; }
__device__ __forceinline__ float wave_sum(float v) {
#pragma unroll
    for (int o = 1; o < 64; o <<= 1) v += __shfl_xor(v, o);
    return v;
}
__device__ __forceinline__ float wave_max(float v) {
#pragma unroll
    for (int o = 1; o < 64; o <<= 1) v = fmaxf(v, __shfl_xor(v, o));
    return v;
}
__device__ __forceinline__ float siluf(float x) { return x / (1.f + __expf(-x)); }
__device__ __forceinline__ float sigmf(float x) { return 1.f / (1.f + __expf(-x)); }

#define XB_TMO      128
#define XB_XCNT(j)  (256  + 64 * (j))
#define XB_XSUB(j)  (1280 + 64 * (j))
#define XB_XGEN(j)  (2304 + 64 * (j))
#define XB_TOP      3328
#define XB_TOPGEN   3392
#define XCD_BAR_WORDS 3456
#define XB_SPIN_CAP (1u << 20)
__device__ __forceinline__ unsigned xb_ld(unsigned* p)              { return __hip_atomic_load(p, __ATOMIC_RELAXED, __HIP_MEMORY_SCOPE_AGENT); }
__device__ __forceinline__ unsigned xb_add(unsigned* p, unsigned v) { return __hip_atomic_fetch_add(p, v, __ATOMIC_RELAXED, __HIP_MEMORY_SCOPE_AGENT); }
__device__ __forceinline__ unsigned xb_xcc_id() { return (unsigned)__builtin_amdgcn_s_getreg((3 << 11) | 20) & 0xFu; }
#define XB_SPIN(cond, bar) do { unsigned _sp = 0; while (cond) { __builtin_amdgcn_s_sleep(1); \
    if ((++_sp & 255u) == 0u) { if (xb_ld(&(bar)[XB_TMO])) break; if (_sp > XB_SPIN_CAP) { atomicAdd(&(bar)[XB_TMO], 1u); break; } } } } while (0)
struct XcdBarrier { unsigned* bar; unsigned x; volatile LAS unsigned* st; };
__device__ __forceinline__ XcdBarrier xcd_barrier_post(unsigned* bar, volatile LAS unsigned* st) {
    XcdBarrier b; b.bar = bar; b.x = xb_xcc_id(); b.st = st;
    if (threadIdx.x == 0) (void)xb_add(&bar[XB_XCNT(b.x)], 1u);
    return b;
}
__device__ __forceinline__ void xcd_barrier_complete(unsigned* bar, unsigned x, unsigned& nloc, unsigned& nx) {
    const unsigned G = gridDim.x * gridDim.y * gridDim.z;
    unsigned sum, cnt, mine, sp = 0u;
    for (;;) {
        sum = 0u; cnt = 0u; mine = 0u;
#pragma unroll
        for (unsigned j = 0; j < 16; ++j) { const unsigned c = xb_ld(&bar[XB_XCNT(j)]); sum += c; cnt += (c > 0u) ? 1u : 0u; mine = (j == x) ? c : mine; }
        if (sum == G) break;
        __builtin_amdgcn_s_sleep(1);
        if ((++sp & 255u) == 0u) { if (xb_ld(&bar[XB_TMO])) break; if (sp > XB_SPIN_CAP) { atomicAdd(&bar[XB_TMO], 1u); break; } }
    }
    nloc = mine > 0u ? mine : 1u; nx = cnt > 0u ? cnt : 1u;
}
__device__ __forceinline__ void xcd_barrier(const XcdBarrier& b) {
    asm volatile("s_waitcnt vmcnt(0)" ::: "memory");
    __syncthreads();
    if (threadIdx.x == 0) {
        unsigned* bar = b.bar;
        __builtin_amdgcn_s_waitcnt(0);
        unsigned nloc = b.st[0], nx = b.st[1];
        if (nloc == 0u) { xcd_barrier_complete(bar, b.x, nloc, nx); b.st[0] = nloc; b.st[1] = nx; }
        const unsigned old = xb_add(&bar[XB_XSUB(b.x)], 1u);
        const unsigned gen = old / nloc;
        if (old + 1u == (gen + 1u) * nloc) {
            __builtin_amdgcn_fence(__ATOMIC_RELEASE, "agent");
            asm volatile("s_waitcnt vmcnt(0)" ::: "memory");
            const unsigned og = xb_add(&bar[XB_TOP], 1u);
            const unsigned tg = og / nx;
            if (og + 1u == (tg + 1u) * nx) xb_add(&bar[XB_TOPGEN], 1u);
            else XB_SPIN(xb_ld(&bar[XB_TOPGEN]) == tg, bar);
            __builtin_amdgcn_fence(__ATOMIC_ACQUIRE, "agent");
            xb_add(&bar[XB_XGEN(b.x)], 1u);
            asm volatile("s_waitcnt vmcnt(0)" ::: "memory");
        } else {
            XB_SPIN(xb_ld(&bar[XB_XGEN(b.x)]) == gen, bar);
            __builtin_amdgcn_fence(__ATOMIC_ACQUIRE, "agent");
            asm volatile("s_waitcnt vmcnt(0)" ::: "memory");
        }
    }
    __syncthreads();
}

struct Args { const float* in[26]; float* out; unsigned char* ws; };

__device__ __forceinline__ void p0_transpose_item(const float* W, int ldw, int src_col0, const float* kscale, bf16* WT, int K, int dst_row0, int k0, LAS float* scr, int lane) {
#pragma unroll 8
    for (int i = 0; i < 32; ++i) { const int kk = 2 * i + (lane >> 5); float v = W[(size_t)(k0 + kk) * ldw + src_col0 + (lane & 31)]; if (kscale) v *= kscale[k0 + kk]; scr[kk * 33 + (lane & 31)] = v; }
    LDS_WAIT(); asm volatile("" ::: "memory");
    const int c = lane & 7;
#pragma unroll
    for (int j = 0; j < 4; ++j) { const int n = (lane >> 3) + 8 * j; const LAS float* s = scr + (8 * c) * 33 + n;
        v4u o; o.x = pk2(s[0 * 33], s[1 * 33]); o.y = pk2(s[2 * 33], s[3 * 33]); o.z = pk2(s[4 * 33], s[5 * 33]); o.w = pk2(s[6 * 33], s[7 * 33]);
        *(v4u*)(WT + (size_t)(dst_row0 + n) * K + k0 + 8 * c) = o; }
    LDS_WAIT(); asm volatile("" ::: "memory");
}
__device__ __forceinline__ double rope_inv_freq(int i) {
    return i == 0 ? 1.0 : i == 1 ? 0.19392274474868576 : i == 2 ? 0.03760603093086393 : i == 3 ? 0.007292664737217109 : i == 4 ? 0.001414213562373095 :
           i == 5 ? 0.0002742481756762073 : i == 6 ? 5.318295896944988e-05 : 1.031338537721246e-05;
}
__device__ __forceinline__ void rope_cs(int pos, int i, float& c, float& s) {
    const double ang = (double)pos * rope_inv_freq(i);
    const double n = __builtin_rint(ang * 0.15915494309189535);
    const double r = __builtin_fma(-n, 6.283185307179586, ang);
    const double kq = __builtin_rint(r * 0.6366197723675814);
    const double y = __builtin_fma(-kq, 1.5707963267948966, r);
    const double y2 = y * y;
    const double sy = y * (1.0 + y2 * (-1.0 / 6 + y2 * (1.0 / 120 + y2 * (-1.0 / 5040 + y2 * (1.0 / 362880 - y2 * (1.0 / 39916800))))));
    const double cy = 1.0 + y2 * (-0.5 + y2 * (1.0 / 24 + y2 * (-1.0 / 720 + y2 * (1.0 / 40320 + y2 * (-1.0 / 3628800 + y2 * (1.0 / 479001600))))));
    const int q = ((int)kq) & 3;
    const double cc = q == 0 ? cy : q == 1 ? -sy : q == 2 ? -cy : sy;
    const double ss = q == 0 ? sy : q == 1 ? cy : q == 2 ? -sy : -cy;
    c = (float)cc; s = (float)ss;
}

__device__ __forceinline__ void dot4_bf16(const bf16* krow, const float (&qv)[4], float (&s)[4]) {
    s[0] = s[1] = s[2] = s[3] = 0.f;
#pragma unroll
    for (int pc = 0; pc < 8; ++pc) {
        const v4u kv = *(const v4u*)(krow + 8 * pc); float kf[8]; unpack8(kv, kf);
#pragma unroll
        for (int e = 0; e < 8; ++e)
#pragma unroll
            for (int h = 0; h < 4; ++h) s[h] += kf[e] * rdlane(qv[h], 8 * pc + e);
    }
}
__device__ __forceinline__ void dot4_f32(const float* krow, const float (&qv)[4], float (&s)[4]) {
    s[0] = s[1] = s[2] = s[3] = 0.f;
#pragma unroll
    for (int pc = 0; pc < 16; ++pc) {
        const f32x4 kf = *(const f32x4*)(krow + 4 * pc);
#pragma unroll
        for (int e = 0; e < 4; ++e)
#pragma unroll
            for (int h = 0; h < 4; ++h) s[h] += kf[e] * rdlane(qv[h], 4 * pc + e);
    }
}
__device__ __forceinline__ float dot1_f32(const float* krow, const float qv) {
    float s = 0.f;
#pragma unroll
    for (int pc = 0; pc < 16; ++pc) { const f32x4 kf = *(const f32x4*)(krow + 4 * pc);
#pragma unroll
        for (int e = 0; e < 4; ++e) s += kf[e] * rdlane(qv, 4 * pc + e); }
    return s;
}

#ifndef PHASES
#define PHASES 0x1ff
#endif
__global__ void __launch_bounds__(NWAVES * 64, 2) hymba_fwd(Args args) {
    extern __shared__ __attribute__((aligned(16))) unsigned char lds_raw[];
    LAS unsigned char* lds = (LAS unsigned char*)lds_raw;
    volatile LAS unsigned* MISC = (volatile LAS unsigned*)(lds + MISC_OFF);
    const int tid = threadIdx.x, lane = tid & 63, wave = __builtin_amdgcn_readfirstlane(tid >> 6);
    const int G = gridDim.x; const int bx = blockIdx.x; const int vcu = (G % 8 == 0) ? (bx % 8) * (G / 8) + bx / 8 : bx;
    const int gw = vcu * NWAVES + wave, NGW = G * NWAVES;
    unsigned char* ws = args.ws;
    unsigned* ctl = (unsigned*)(ws + WS_CTL);
    const float* x = args.in[0]; const float* mem = args.in[1]; const float* norm_in_g = args.in[2]; const float* w_in = args.in[3];
    const float* mu = args.in[4]; const float* w0 = args.in[5]; const float* w_up = args.in[6]; const float* a0 = args.in[7]; const float* a_up = args.in[8];
    const float* k_k = args.in[9]; const float* k_a = args.in[10]; const float* r_k = args.in[11]; const float* ln_w = args.in[12]; const float* ln_b = args.in[13];
    const float* cmp_pos = args.in[14]; const float* ck_w1 = args.in[15]; const float* ck_w2 = args.in[16]; const float* cv_w1 = args.in[17]; const float* cv_w2 = args.in[18];
    const float* gate_b = args.in[19]; const float* nsa_out_g = args.in[20]; const float* mem_norm_g = args.in[21]; const float* w_mem_kv = args.in[22];
    const float* mem_out_g = args.in[23]; const float* w_out = args.in[24]; const float* norm_final_g = args.in[25];
    float* out = args.out;
    bf16* WT_IN = (bf16*)(ws + WS_WIN); bf16* WT_OUT = (bf16*)(ws + WS_WOUT);
    float* ROPE = (float*)(ws + WS_ROPE); float* RS = (float*)(ws + WS_RS); float* KCMP = (float*)(ws + WS_KCMP); float* VCMP = (float*)(ws + WS_VCMP);
    float* MEMKV = (float*)(ws + WS_MEMKV); float* GLOG = (float*)(ws + WS_GLOG);
    bf16* P = (bf16*)(ws + WS_P); bf16* XB = (bf16*)(ws + WS_XB); float* YR = (float*)(ws + WS_YR); bf16* Y = (bf16*)(ws + WS_Y);
    bf16* KK = (bf16*)(ws + WS_KK); bf16* KA = (bf16*)(ws + WS_KA); bf16* BB = (bf16*)(ws + WS_BB); bf16* WDc = (bf16*)(ws + WS_WD);

    for (int u = tid; u < (LDS_BYTES - LDSCTL_OFF) / 4; u += NWAVES * 64) ((LAS unsigned*)(lds + LDSCTL_OFF))[u] = 0u;
    __syncthreads();
    XcdBarrier bar = xcd_barrier_post(ctl + CW_BAR, MISC + 8);

    if (PHASES & 1) {
        LAS float* wgt = (LAS float*)(lds + 81920);
        for (int i = tid; i < D * 12; i += NWAVES * 64) { const int k = i / 12, c = i % 12; wgt[i] = norm_in_g[k] * w_in[(size_t)k * W_IN_COLS + GLOG_SRC + c]; }
        __syncthreads();
        LAS float* scr = (LAS float*)(lds + wave * 8704);
        constexpr int I_IN = 16 * (NP / 32), I_OUT = 16 * (D / 32);
        for (int it = gw; it < I_IN + I_OUT; it += NGW) {
            if (it < I_IN) { const int kb = it / (NP / 32), nb = it % (NP / 32); const int src = 32 * nb + (32 * nb >= GLOG_SRC ? 12 : 0);
                p0_transpose_item(w_in, W_IN_COLS, src, norm_in_g, WT_IN, D, 32 * nb, 64 * kb, scr, lane); }
            else { const int r = it - I_IN; const int kb = r / (D / 32), nb = r % (D / 32);
                p0_transpose_item(w_out, D, 32 * nb, nullptr, WT_OUT, D, 32 * nb, 64 * kb, scr, lane); }
        }
        for (int i = gw * 64 + lane; i < T * 8; i += NGW * 64) { float c, s; rope_cs(i >> 3, i & 7, c, s); ROPE[(i >> 3) * 16 + (i & 7)] = c; ROPE[(i >> 3) * 16 + 8 + (i & 7)] = s; }
        for (int m = gw; m < M; m += NGW) {
            const f32x4* xr = (const f32x4*)(x + (size_t)m * D) + lane;
            f32x4 v[4]; float ss = 0.f;
#pragma unroll
            for (int j = 0; j < 4; ++j) { v[j] = xr[64 * j]; ss += (v[j].x * v[j].x + v[j].y * v[j].y) + (v[j].z * v[j].z + v[j].w * v[j].w); }
            ss = wave_sum(ss);
            const float rs = 1.0f / sqrtf(ss * (1.f / D) + 1e-6f);
            unsigned long long* o8 = (unsigned long long*)(XB + (size_t)m * D) + lane;
#pragma unroll
            for (int j = 0; j < 4; ++j) o8[64 * j] = (unsigned long long)pk2(v[j].x, v[j].y) | ((unsigned long long)pk2(v[j].z, v[j].w) << 32);
            float acc[12];
#pragma unroll
            for (int c = 0; c < 12; ++c) acc[c] = 0.f;
#pragma unroll
            for (int j = 0; j < 4; ++j)
#pragma unroll
                for (int e = 0; e < 4; ++e) { const int k = 256 * j + 4 * lane + e; const float xv = v[j][e];
                    const f32x4 w0v = *(const LAS f32x4*)(wgt + k * 12), w1v = *(const LAS f32x4*)(wgt + k * 12 + 4), w2v = *(const LAS f32x4*)(wgt + k * 12 + 8);
                    acc[0] += xv * w0v.x; acc[1] += xv * w0v.y; acc[2] += xv * w0v.z; acc[3] += xv * w0v.w;
                    acc[4] += xv * w1v.x; acc[5] += xv * w1v.y; acc[6] += xv * w1v.z; acc[7] += xv * w1v.w;
                    acc[8] += xv * w2v.x; acc[9] += xv * w2v.y; acc[10] += xv * w2v.z; acc[11] += xv * w2v.w; }
            float mine = 0.f;
#pragma unroll
            for (int c = 0; c < 12; ++c) { const float t = wave_sum(acc[c]); if (lane == c) mine = t; }
            if (lane < 12) GLOG[(size_t)m * 12 + lane] = mine * rs;
            if (lane == 0) RS[m] = rs;
        }
    }
    xcd_barrier(bar);

    if (PHASES & 2) {
        pg8::Gemm g{XB, WT_IN, M, NP, D}; pg8::StaticOrder S; S.init(M, NP, G, bx);
        pg8::EpiRowScaleBf16 E{P, NP, RS};
        pg8::gemm_phase<pg8::EpiRowScaleBf16, pg8::StaticOrder, true, true>(lds, g, S, E);
    }
    xcd_barrier(bar);

    if (PHASES & 4) {
        LAS bf16* wup = (LAS bf16*)lds; LAS bf16* aup = (LAS bf16*)(lds + 65536);
        for (int i = tid; i < 64 * 512; i += NWAVES * 64) { wup[i] = (bf16)f2bf(w_up[i]); aup[i] = (bf16)f2bf(a_up[i]); }
        __syncthreads();
        const int c0 = lane * 8;
        for (int m = gw; m < M; m += NGW) {
            const int t = m & (T - 1); const bool hp = t > 0;
            const bf16* pr = P + (size_t)m * NP; const bf16* pp = pr - NP;
            float wdv, adv;
            { const float c = bf2f(pr[C_WD + lane]), p = hp ? bf2f(pp[C_WD + lane]) : 0.f; wdv = c + mu[C_WD + lane] * (p - c); }
            { const float c = bf2f(pr[C_AD + lane]), p = hp ? bf2f(pp[C_AD + lane]) : 0.f; adv = c + mu[C_AD + lane] * (p - c); }
            const float tw = tanhf(wdv);
            float accw[8], acca[8];
#pragma unroll
            for (int e = 0; e < 8; ++e) { accw[e] = 0.f; acca[e] = 0.f; }
#pragma unroll 8
            for (int j = 0; j < 64; ++j) {
                const float sw = rdlane(tw, j), sa = rdlane(adv, j);
                const v4u wv = *(const LAS v4u*)(wup + j * 512 + c0), av = *(const LAS v4u*)(aup + j * 512 + c0);
                float wf[8], af[8]; unpack8(wv, wf); unpack8(av, af);
#pragma unroll
                for (int e = 0; e < 8; ++e) { accw[e] += sw * wf[e]; acca[e] += sa * af[e]; }
            }
            float kc[8], kp[8];
            { const v4u a = *(const v4u*)(pr + C_K + c0); unpack8(a, kc); if (hp) { const v4u b = *(const v4u*)(pp + C_K + c0); unpack8(b, kp); } else {
#pragma unroll
                for (int e = 0; e < 8; ++e) kp[e] = 0.f; } }
            float kkv[8], kav[8], bbv[8], wdo[8]; float ss = 0.f;
#pragma unroll
            for (int e = 0; e < 8; ++e) {
                const int c = c0 + e;
                const float k = kc[e] + mu[C_K + c] * (kp[e] - kc[e]);
                const float lw = w0[c] + accw[e];
                const float nx = -lw; const float sp = fmaxf(nx, 0.f) + log1pf(__expf(-fabsf(nx)));
                const float wlog = -sp - 0.5f;
                const float ew = __expf(wlog);
                wdo[e] = -expm1f(-ew);
                const float a = sigmf(a0[c] + acca[e]);
                kkv[e] = k * k_k[c]; ss += kkv[e] * kkv[e];
                kav[e] = k * (1.f + (a - 1.f) * k_a[c]);
                bbv[e] = a;
            }
            ss = sum8(ss);
            const float inv = 1.f / fmaxf(sqrtf(ss), 1e-12f);
#pragma unroll
            for (int e = 0; e < 8; ++e) { kkv[e] *= inv; bbv[e] *= kkv[e]; }
            *(v4u*)(KK + (size_t)m * 512 + c0) = pack8(kkv); *(v4u*)(KA + (size_t)m * 512 + c0) = pack8(kav);
            *(v4u*)(BB + (size_t)m * 512 + c0) = pack8(bbv); *(v4u*)(WDc + (size_t)m * 512 + c0) = pack8(wdo);
            if (lane < 16) { const int i = lane & 7; const int cb = (lane < 8) ? C_KS : C_KW; bf16* q = P + (size_t)m * NP + cb;
                const float x1 = bf2f(q[i]), x2 = bf2f(q[8 + i]); const float cs = ROPE[t * 16 + i], sn = ROPE[t * 16 + 8 + i];
                q[i] = (bf16)f2bf(x1 * cs - x2 * sn); q[8 + i] = (bf16)f2bf(x2 * cs + x1 * sn); }
        }
        for (int u = gw; u < NB * 512 * 2; u += NGW) {
            const int kv = u & 1, bc = u >> 1, b = bc >> 9, c = bc & 511;
            float* dst = (kv ? VCMP : KCMP) + (size_t)bc * 64;
            if (c >= NCMP) { dst[lane] = 0.f; continue; }
            const float* W1 = kv ? cv_w1 : ck_w1; const float* W2 = kv ? cv_w2 : ck_w2; const int col = kv ? C_VC : C_KC;
            float acc = 0.f;
            for (int l = 0; l < 32; ++l) {
                const float uval = bf2f(P[(size_t)(b * T + 16 * c + l) * NP + col + lane]) + cmp_pos[l * 64 + lane];
                const float* wr = W1 + (size_t)(l * 64) * 64 + lane;
#pragma unroll 16
                for (int d = 0; d < 64; ++d) acc += rdlane(uval, d) * wr[d * 64];
            }
            const float hv = siluf(acc);
            float o = 0.f;
#pragma unroll 16
            for (int n = 0; n < 64; ++n) o += rdlane(hv, n) * W2[n * 64 + lane];
            dst[lane] = o;
        }
        for (int u = gw; u < NB * MEML * 8; u += NGW) {
            const int r = u >> 3, cb = u & 7;
            float v[16]; float ss = 0.f;
#pragma unroll
            for (int i = 0; i < 16; ++i) { v[i] = mem[(size_t)r * D + 64 * i + lane]; ss += v[i] * v[i]; }
            ss = wave_sum(ss); const float rs = 1.0f / sqrtf(ss * (1.f / D) + 1e-6f);
#pragma unroll
            for (int i = 0; i < 16; ++i) v[i] *= rs * mem_norm_g[64 * i + lane];
            float acc = 0.f;
#pragma unroll
            for (int i = 0; i < 16; ++i) { const float* wr = w_mem_kv + (size_t)(64 * i) * 512 + cb * 64 + lane;
#pragma unroll 16
                for (int j = 0; j < 64; ++j) acc += rdlane(v[i], j) * wr[j * 512]; }
            MEMKV[(size_t)r * 512 + cb * 64 + lane] = acc;
        }
    }
    xcd_barrier(bar);

    if (!(PHASES & 8)) {} else if (wave == 0) {
        if (PHASES & 128) for (int u = bx; u < 256; u += G) {
            const int bh = u >> 3, rg = u & 7, b = bh >> 3, h = bh & 7;
            const int r = lane >> 3, q = lane & 7;
            const int vch = h * 64 + rg * 8 + r, kc0 = h * 64 + q * 8;
            float s[8], mur[8], prev_r[8];
#pragma unroll
            for (int e = 0; e < 8; ++e) { s[e] = 0.f; mur[e] = mu[C_R + kc0 + e]; prev_r[e] = 0.f; }
            const float muv = mu[C_V + vch]; float prev_v = 0.f;
            const size_t m0 = (size_t)b * T;
            v4u n_r = *(const v4u*)(P + m0 * NP + C_R + kc0); unsigned short n_v = P[m0 * NP + C_V + vch];
            v4u n_kk = *(const v4u*)(KK + m0 * 512 + kc0), n_ka = *(const v4u*)(KA + m0 * 512 + kc0), n_bb = *(const v4u*)(BB + m0 * 512 + kc0), n_wd = *(const v4u*)(WDc + m0 * 512 + kc0);
            for (int t = 0; t < T; ++t) {
                const size_t m = m0 + t;
                const v4u c_r = n_r, c_kk = n_kk, c_ka = n_ka, c_bb = n_bb, c_wd = n_wd; const unsigned short c_v = n_v;
                if (t + 1 < T) { const size_t mn = m + 1;
                    n_r = *(const v4u*)(P + mn * NP + C_R + kc0); n_v = P[mn * NP + C_V + vch];
                    n_kk = *(const v4u*)(KK + mn * 512 + kc0); n_ka = *(const v4u*)(KA + mn * 512 + kc0); n_bb = *(const v4u*)(BB + mn * 512 + kc0); n_wd = *(const v4u*)(WDc + mn * 512 + kc0); }
                float pr[8], kk[8], ka[8], bb[8], wd[8]; unpack8(c_r, pr); unpack8(c_kk, kk); unpack8(c_ka, ka); unpack8(c_bb, bb); unpack8(c_wd, wd);
                const float pv = bf2f(c_v); const float vv = pv + muv * (prev_v - pv); prev_v = pv;
                float sa = 0.f;
#pragma unroll
                for (int e = 0; e < 8; ++e) sa -= s[e] * kk[e];
                sa = sum8(sa);
                float y = 0.f;
#pragma unroll
                for (int e = 0; e < 8; ++e) { const float rr = pr[e] + mur[e] * (prev_r[e] - pr[e]); prev_r[e] = pr[e];
                    s[e] = s[e] * (1.f - wd[e]) + sa * bb[e] + vv * ka[e]; y += s[e] * rr; }
                y = sum8(y);
                if (q == 0) YR[m * 512 + vch] = y;
            }
        }
    } else if (PHASES & 256) {
        LAS float* scr = (LAS float*)(lds + wave * 8192);
        LAS float* pbuf = scr + 512, *ph = scr + 768  ;
        for (int m = vcu * 7 + (wave - 1); m < M; m += G * 7) {
            const int b = m >> 13, t = m & (T - 1), cur = t >> 6;
            const bf16* prow = P + (size_t)m * NP;
            float qn[4], qr[4];
            {
                const int i = lane & 7; const float cs = ROPE[t * 16 + i], sn = ROPE[t * 16 + 8 + i];
#pragma unroll
                for (int h = 0; h < 4; ++h) {
                    const float qv = bf2f(prow[C_NQ + h * 64 + lane]);
                    const float other = __shfl_xor(qv, 8);
                    float rv = qv;
                    if (lane < 8) rv = qv * cs - other * sn; else if (lane < 16) rv = qv * cs + other * sn;
                    qn[h] = qv * 0.125f; qr[h] = rv * 0.125f;
                }
            }
            float oc[4] = {0.f, 0.f, 0.f, 0.f};
            const int nvalid = t >= 31 ? min((t - 31) / 16 + 1, NCMP) : 0;
            const int nchunk = (nvalid + 63) >> 6;
            {
                float mx[4] = {-INFINITY, -INFINITY, -INFINITY, -INFINITY}, lsum[4] = {0.f, 0.f, 0.f, 0.f};
#pragma unroll 1
                for (int j = 0; j < nchunk; ++j) {
                    const int c = 64 * j + lane; const bool valid = c < nvalid;
                    float s4[4]; dot4_f32(KCMP + (size_t)(b * 512 + (valid ? c : 0)) * 64, qn, s4);
#pragma unroll
                    for (int h = 0; h < 4; ++h) { const float sv = valid ? s4[h] : -INFINITY; const float mn = fmaxf(mx[h], wave_max(sv));
                        lsum[h] = lsum[h] * __expf(mx[h] - mn) + wave_sum(valid ? __expf(sv - mn) : 0.f); mx[h] = mn; }
                }
#pragma unroll
                for (int h = 0; h < 4; ++h) lsum[h] = 1.f / fmaxf(lsum[h], 1e-30f);
#pragma unroll 1
                for (int j = 0; j < 8; ++j) {
                    float p4[4] = {0.f, 0.f, 0.f, 0.f}; float pt = 0.f;
                    if (j < nchunk) {
                        const int c = 64 * j + lane; const bool valid = c < nvalid;
                        float s4[4]; dot4_f32(KCMP + (size_t)(b * 512 + (valid ? c : 0)) * 64, qn, s4);
#pragma unroll
                        for (int h = 0; h < 4; ++h) { p4[h] = valid ? __expf(s4[h] - mx[h]) * lsum[h] : 0.f; pt += p4[h]; }
                    }
                    ph[64 * j + lane] = pt;
                    if (j < nchunk) {
                        *(LAS f32x4*)(pbuf + lane * 4) = (f32x4){p4[0], p4[1], p4[2], p4[3]};
                        const int nk = min(64, nvalid - 64 * j);
#pragma unroll 4
                        for (int key = 0; key < nk; ++key) { const f32x4 pk = *(const LAS f32x4*)(pbuf + key * 4); const float vv = VCMP[(size_t)(b * 512 + 64 * j + key) * 64 + lane];
                            oc[0] += pk.x * vv; oc[1] += pk.y * vv; oc[2] += pk.z * vv; oc[3] += pk.w * vv; }
                    }
                }
            }
            unsigned long long selm0, selm1;
            {
                float sa, sb;
                { const int s = lane; float im = ph[4 * s] + ph[4 * s + 1] + ph[4 * s + 2] + 0.5f * ph[4 * s + 3] + (s > 0 ? 0.5f * ph[4 * s - 1] : 0.f);
                  const bool forced = (s == 0) || (s == cur) || (s == cur - 1); sa = forced ? 1e4f : (s <= cur ? im : -1.f); }
                { const int s = lane + 64; float im = ph[4 * s] + ph[4 * s + 1] + ph[4 * s + 2] + 0.5f * ph[4 * s + 3] + 0.5f * ph[4 * s - 1];
                  const bool forced = (s == cur) || (s == cur - 1); sb = forced ? 1e4f : (s <= cur ? im : -1.f); }
                int ra = 0, rb = 0;
#pragma unroll 16
                for (int i = 0; i < 64; ++i) { const float o0 = rdlane(sa, i), o1 = rdlane(sb, i);
                    ra += (o0 > sa || (o0 == sa && i < lane)) ? 1 : 0; ra += (o1 > sa) ? 1 : 0;
                    rb += (o0 >= sb) ? 1 : 0; rb += (o1 > sb || (o1 == sb && i < lane)) ? 1 : 0; }
                selm0 = __ballot(ra < 16 && lane <= cur); selm1 = __ballot(rb < 16 && lane + 64 <= cur);
            }
            float os[4] = {0.f, 0.f, 0.f, 0.f}, ow[4] = {0.f, 0.f, 0.f, 0.f};
#pragma unroll 1
            for (int br = 0; br < 2; ++br) {
                float mrun[4] = {-INFINITY, -INFINITY, -INFINITY, -INFINITY}, lrun[4] = {0.f, 0.f, 0.f, 0.f}, o[4] = {0.f, 0.f, 0.f, 0.f};
                const int kcol = br == 0 ? C_KS : C_KW, vcol = br == 0 ? C_VS : C_VW;
                const int slo = br == 0 ? 0 : max(0, (t - 511) >> 6);
                for (int s = slo; s <= cur; ++s) {
                    if (br == 0) { const bool on = s < 64 ? ((selm0 >> s) & 1ull) : ((selm1 >> (s - 64)) & 1ull); if (!on) continue; }
                    const int key = 64 * s + lane;
                    const bool valid = (key <= t) && (br == 0 || key >= t - 511);
                    float s4[4]; dot4_bf16(P + (size_t)(b * T + key) * NP + kcol, qr, s4);
                    float p4[4];
#pragma unroll
                    for (int h = 0; h < 4; ++h) { const float sv = valid ? s4[h] : -INFINITY; const float cm = wave_max(sv); const float mn = fmaxf(mrun[h], cm);
                        const float al = __expf(mrun[h] - mn); p4[h] = valid ? __expf(sv - mn) : 0.f; lrun[h] = lrun[h] * al + wave_sum(p4[h]); o[h] *= al; mrun[h] = mn; }
                    *(LAS f32x4*)(pbuf + lane * 4) = (f32x4){p4[0], p4[1], p4[2], p4[3]};
                    const bf16* vb = P + (size_t)(b * T + 64 * s) * NP + vcol + lane;
                    const int nk = min(64, t - 64 * s + 1);
#pragma unroll 4
                    for (int k2 = 0; k2 < nk; ++k2) { const f32x4 pk = *(const LAS f32x4*)(pbuf + k2 * 4); const float vv = bf2f(vb[(size_t)k2 * NP]);
                        o[0] += pk.x * vv; o[1] += pk.y * vv; o[2] += pk.z * vv; o[3] += pk.w * vv; }
                }
#pragma unroll
                for (int h = 0; h < 4; ++h) { const float r = o[h] / fmaxf(lrun[h], 1e-30f); if (br == 0) os[h] = r; else ow[h] = r; }
            }
#pragma unroll
            for (int h = 0; h < 4; ++h) {
                const float g0 = sigmf(GLOG[(size_t)m * 12 + h * 3 + 0] + gate_b[h * 3 + 0]), g1 = sigmf(GLOG[(size_t)m * 12 + h * 3 + 1] + gate_b[h * 3 + 1]),
                            g2 = sigmf(GLOG[(size_t)m * 12 + h * 3 + 2] + gate_b[h * 3 + 2]);
                float o = g0 * oc[h] + g1 * os[h] + g2 * ow[h];
                const float ms = wave_sum(o * o) * (1.f / 64.f);
                o = o * (1.0f / sqrtf(ms + 1e-6f)) * nsa_out_g[h * 64 + lane];
                o *= siluf(bf2f(prow[C_NG + h * 64 + lane]));
                Y[(size_t)m * D + 512 + h * 64 + lane] = (bf16)f2bf(o);
            }
#pragma unroll 1
            for (int h = 0; h < 4; ++h) {
                const float qm = bf2f(prow[C_MQ + h * 64 + lane]) * 0.125f;
                float sj[4]; float mx = -INFINITY;
#pragma unroll
                for (int j = 0; j < 4; ++j) { sj[j] = dot1_f32(MEMKV + (size_t)(b * MEML + 64 * j + lane) * 512 + h * 64, qm); mx = fmaxf(mx, sj[j]); }
                mx = wave_max(mx); float l = 0.f;
#pragma unroll
                for (int j = 0; j < 4; ++j) { sj[j] = __expf(sj[j] - mx); l += sj[j]; }
                l = 1.f / wave_sum(l);
                float o = 0.f;
#pragma unroll
                for (int j = 0; j < 4; ++j) {
                    pbuf[lane] = sj[j] * l;
                    const float* vb = MEMKV + (size_t)(b * MEML + 64 * j) * 512 + 256 + h * 64 + lane;
#pragma unroll 8
                    for (int k2 = 0; k2 < 64; ++k2) o += pbuf[k2] * vb[(size_t)k2 * 512];
                }
                const float ms = wave_sum(o * o) * (1.f / 64.f);
                o = o * (1.0f / sqrtf(ms + 1e-6f)) * mem_out_g[h * 64 + lane];
                o *= siluf(bf2f(prow[C_MG + h * 64 + lane]));
                Y[(size_t)m * D + 768 + h * 64 + lane] = (bf16)f2bf(o);
            }
        }
    }
    xcd_barrier(bar);

    if (PHASES & 16) {
        const int c0 = lane * 8, h = lane >> 3;
        for (int m = gw; m < M; m += NGW) {
            const int t = m & (T - 1); const bool hp = t > 0;
            const bf16* pr = P + (size_t)m * NP; const bf16* pp = pr - NP;
            const f32x4 ya = *(const f32x4*)(YR + (size_t)m * 512 + c0), yb = *(const f32x4*)(YR + (size_t)m * 512 + c0 + 4);
            float y[8] = {ya.x, ya.y, ya.z, ya.w, yb.x, yb.y, yb.z, yb.w};
            float s = 0.f;
#pragma unroll
            for (int e = 0; e < 8; ++e) s += y[e];
            const float mean = sum8(s) * (1.f / 64.f);
            float q = 0.f;
#pragma unroll
            for (int e = 0; e < 8; ++e) { y[e] -= mean; q += y[e] * y[e]; }
            const float rstd = 1.0f / sqrtf(sum8(q) * (1.f / 64.f) + 64e-5f);
            float rc[8], rp[8], vc[8], vp[8], gc[8], gp[8], ka[8];
            unpack8(*(const v4u*)(pr + C_R + c0), rc); unpack8(*(const v4u*)(pr + C_V + c0), vc); unpack8(*(const v4u*)(pr + C_G + c0), gc);
            if (hp) { unpack8(*(const v4u*)(pp + C_R + c0), rp); unpack8(*(const v4u*)(pp + C_V + c0), vp); unpack8(*(const v4u*)(pp + C_G + c0), gp); }
            else {
#pragma unroll
                for (int e = 0; e < 8; ++e) { rp[e] = 0.f; vp[e] = 0.f; gp[e] = 0.f; } }
            unpack8(*(const v4u*)(KA + (size_t)m * 512 + c0), ka);
            float bon = 0.f; float vv[8], gg[8];
#pragma unroll
            for (int e = 0; e < 8; ++e) { const int c = c0 + e;
                const float r = rc[e] + mu[C_R + c] * (rp[e] - rc[e]); vv[e] = vc[e] + mu[C_V + c] * (vp[e] - vc[e]); gg[e] = gc[e] + mu[C_G + c] * (gp[e] - gc[e]);
                bon += r * ka[e] * r_k[h * 64 + (c & 63)]; }
            bon = sum8(bon);
            float o[8];
#pragma unroll
            for (int e = 0; e < 8; ++e) { const int c = c0 + e; o[e] = (y[e] * rstd * ln_w[c] + ln_b[c] + bon * vv[e]) * siluf(gg[e]); }
            *(v4u*)(Y + (size_t)m * D + c0) = pack8(o);
        }
    }
    xcd_barrier(bar);

    if (PHASES & 32) {
        pg8::Gemm g{Y, WT_OUT, M, D, D}; pg8::StaticOrder S; S.init(M, D, G, bx);
        pg8::EpiResF32 E{x, out, D};
        pg8::gemm_phase<pg8::EpiResF32, pg8::StaticOrder, true, true>(lds, g, S, E);
    }
    xcd_barrier(bar);

    if (PHASES & 64) for (int m = gw; m < M; m += NGW) {
        f32x4* xr = (f32x4*)(out + (size_t)m * D) + lane;
        f32x4 v[4]; float ss = 0.f;
#pragma unroll
        for (int j = 0; j < 4; ++j) { v[j] = xr[64 * j]; ss += (v[j].x * v[j].x + v[j].y * v[j].y) + (v[j].z * v[j].z + v[j].w * v[j].w); }
        ss = wave_sum(ss);
        const float rs = 1.0f / sqrtf(ss * (1.f / D) + 1e-6f);
#pragma unroll
        for (int j = 0; j < 4; ++j) { const f32x4 g = *((const f32x4*)norm_final_g + 64 * j + lane); xr[64 * j] = v[j] * rs * g; }
    }
}

extern "C" void kernel_launch(void* const* d_in, const int* in_sizes, int n_in, void* d_out, int out_size, void* d_ws, size_t ws_size, hipStream_t stream) {
    static int grid = 0;
    if (grid == 0) {
        if (n_in != 26 || in_sizes[0] != M * D || out_size != M * D || ws_size < WS_END) { fprintf(stderr, "kernel_launch: unexpected shapes (n_in %d, in0 %d, out %d, ws %zu); nothing launched\n", n_in, n_in > 0 ? in_sizes[0] : -1, out_size, ws_size); grid = -1; return; }
        int dev = 0, cus = 0;
        if (hipGetDevice(&dev) != hipSuccess || hipDeviceGetAttribute(&cus, hipDeviceAttributeMultiprocessorCount, dev) != hipSuccess) { grid = -1; return; }
        if (hipFuncSetAttribute((const void*)hymba_fwd, hipFuncAttributeMaxDynamicSharedMemorySize, LDS_BYTES) != hipSuccess) { fprintf(stderr, "kernel_launch: hipFuncSetAttribute failed\n"); grid = -1; return; }
        (void)hipGetLastError();
        grid = cus;
    }
    if (grid < 0) return;
    (void)hipMemsetAsync((char*)d_ws + WS_CTL, 0, CTL_ZERO_BYTES, stream);
    Args a{};
    for (int i = 0; i < 26; ++i) a.in[i] = (const float*)d_in[i];
    a.out = (float*)d_out; a.ws = (unsigned char*)d_ws;
    hipLaunchKernelGGL(hymba_fwd, dim3(grid), dim3(NWAVES * 64), LDS_BYTES, stream, a);
}
```

```cpp
#include <hip/hip_runtime.h>
#include <cstdio>
#include <cstdint>
namespace pg8 {
#define PG8_LAS __attribute__((address_space(3)))
typedef unsigned short bf16_t;
typedef short bf16x8 __attribute__((ext_vector_type(8)));
typedef float f32x4 __attribute__((ext_vector_type(4)));
typedef unsigned u32x4 __attribute__((ext_vector_type(4)));
constexpr int BM = 256, BK = 64, HALF = 128, HTB = HALF * BK * 2  , STAGE_BYTES = 8 * HTB, NXCD = 8, WGM = 8;

__host__ __device__ __forceinline__ int lds_byte(int r, int c) { const int st = (r >> 4) * 2 + (c >> 5), rr = r & 15, cc = c & 31, ob = rr * 64 + cc * 2; return st * 1024 + (ob ^ (((ob >> 9) & 1) << 5)); }
__host__ __device__ __forceinline__ void stage_rc(int b, int& R, int& C) { const int st = b / 1024, sb = b % 1024, swz = sb ^ (((sb >> 9) & 1) << 5); R = (st >> 1) * 16 + swz / 64; C = (st & 1) * 32 + (swz % 64) / 2; }
__host__ __device__ __forceinline__ int perm32(int rho) { const int n = rho >> 4, i = rho & 15; return 8 * (i >> 2) + 4 * n + (i & 3); }

struct Unit { int pm, pn; };
struct Gemm { const bf16_t* A; const bf16_t* Bt; int M, N, K; };

struct StaticOrder {
    int nM, nN, nwg, G, c;
    __host__ __device__ void init(int M, int N, int G_, int c_) { nM = M / BM; nN = N / BM; nwg = nM * nN; G = G_; c = c_; }
    __host__ __device__ bool next(int i, Unit& u) const {
        const long L = (long)i * G + c; if (L >= nwg) return false;
        int wgid = (int)L; { const int q = nwg / NXCD, r = nwg % NXCD, xcd = wgid % NXCD, off = wgid / NXCD; wgid = (xcd < r ? xcd * (q + 1) : r * (q + 1) + (xcd - r) * q) + off; }
        const int nig = WGM * nN, gid = wgid / nig, fm = gid * WGM, gsz = (nM - fm) < WGM ? (nM - fm) : WGM;
        u.pm = fm + ((wgid % nig) % gsz); u.pn = (wgid % nig) / gsz; return true;
    }
    __device__ __forceinline__ void a_ready(const Unit&) const {}
    __device__ __forceinline__ void done(const Unit&) const {}
};

__device__ __forceinline__ unsigned cvt_pk_bf16(float lo, float hi) { unsigned r; asm volatile("v_cvt_pk_bf16_f32 %0, %1, %2" : "=v"(r) : "v"(lo), "v"(hi)); return r; }

template <class Epi, class Sched, bool ALIGN_EPI = false, bool SP2 = false>
__device__ __forceinline__ void gemm_phase(PG8_LAS unsigned char* lds, const Gemm g, const Sched& S, const Epi& E) {
    int tid_o = threadIdx.x; asm volatile("" : "+v"(tid_o));
    const int tid = tid_o, wid = __builtin_amdgcn_readfirstlane(tid >> 6), lane = tid & 63, wr = wid >> 2, wc = wid & 3, fr = lane & 15, fq = lane >> 4;
    const int K = g.K, nt = K / BK;
    unsigned voffA[2], voffB[2];
#pragma unroll
    for (int i = 0; i < 2; ++i) { int R, C; stage_rc(tid * 16 + i * 8192, R, C); const int Rb = Epi::PERM ? ((R & ~31) + perm32(R & 31)) : R;
        voffA[i] = (unsigned)(R * K + C) * 2u; voffB[i] = (unsigned)(Rb * K + C) * 2u; }
    const size_t kstep = (size_t)(BK * 2);
    const size_t hstep = (size_t)HALF * K * 2;
    const size_t tstep = 2 * hstep;
    const unsigned ldsw = (unsigned)wid * 1024u;
    const int aoff = lds_byte(wr * 64 + fr, fq * 8), boff = lds_byte(wc * 32 + fr, fq * 8);
#define PG8_SA(b, h) (((b) * 2 + (h)) * HTB)
#define PG8_SB(b, h) ((4 + (b) * 2 + (h)) * HTB)
#define PG8_STAGE(bufoff, gbase, voff) do { _Pragma("unroll") for (int _i = 0; _i < 2; ++_i) \
        __builtin_amdgcn_global_load_lds((const unsigned*)((const char*)(gbase) + (voff)[_i]), (PG8_LAS unsigned*)(lds + (bufoff) + ldsw + _i * 8192), 16, 0, 0); } while (0)
#define PG8_LDA(dst, b, h) do { _Pragma("unroll") for (int m = 0; m < 4; ++m) _Pragma("unroll") for (int k = 0; k < 2; ++k) dst[m][k] = *(const PG8_LAS bf16x8*)(lds + PG8_SA(b, h) + aoff + m * 2048 + k * 1024); } while (0)
#define PG8_LDB(dst, b, h) do { _Pragma("unroll") for (int n = 0; n < 2; ++n) _Pragma("unroll") for (int k = 0; k < 2; ++k) dst[n][k] = *(const PG8_LAS bf16x8*)(lds + PG8_SB(b, h) + boff + n * 2048 + k * 1024); } while (0)
#define PG8_MMA(ai, bj, At, Bt) do { __builtin_amdgcn_s_setprio(1); _Pragma("unroll") for (int m = 0; m < 4; ++m) _Pragma("unroll") for (int n = 0; n < 2; ++n) _Pragma("unroll") for (int k = 0; k < 2; ++k) \
        acc[ai][bj][m][n] = __builtin_amdgcn_mfma_f32_16x16x32_bf16(Bt[n][k], At[m][k], acc[ai][bj][m][n], 0, 0, 0); __builtin_amdgcn_s_setprio(0); } while (0)
#define PG8_WAIT_V(n) asm volatile("s_waitcnt vmcnt(" #n ")" ::: "memory")
#define PG8_WAIT_L(n) asm volatile("s_waitcnt lgkmcnt(" #n ")" ::: "memory")
#define PG8_BAR __builtin_amdgcn_s_barrier()
#define PG8_SCHED __builtin_amdgcn_sched_barrier(0)
    Unit cur, nxt; int ui = 0;
    if (!S.next(0, cur)) return;
    f32x4 acc[2][2][4][2];
#pragma unroll
    for (int a = 0; a < 2; ++a)
#pragma unroll
        for (int b = 0; b < 2; ++b)
#pragma unroll
            for (int m = 0; m < 4; ++m)
#pragma unroll
                for (int n = 0; n < 2; ++n) acc[a][b][m][n] = (f32x4){0.f, 0.f, 0.f, 0.f};
    bf16x8 At[4][2], B0[2][2], B1[2][2];
    const char* cA = (const char*)g.A + (size_t)cur.pm * tstep; const char* cB = (const char*)g.Bt + (size_t)cur.pn * tstep;
    S.a_ready(cur);
    if constexpr (SP2) {
        PG8_STAGE(PG8_SB(0, 0), cB, voffB); PG8_STAGE(PG8_SB(0, 1), cB + hstep, voffB); PG8_STAGE(PG8_SA(0, 0), cA, voffA); PG8_STAGE(PG8_SA(0, 1), cA + hstep, voffA);
        if (wr == 1) PG8_BAR;
        PG8_WAIT_V(2); PG8_BAR;
        PG8_STAGE(PG8_SB(1, 0), cB + kstep, voffB); PG8_STAGE(PG8_SA(1, 0), cA + kstep, voffA); PG8_STAGE(PG8_SB(1, 1), cB + hstep + kstep, voffB);
        PG8_WAIT_V(6); PG8_BAR;
    } else {
        PG8_STAGE(PG8_SB(0, 0), cB, voffB); PG8_STAGE(PG8_SA(0, 0), cA, voffA); PG8_STAGE(PG8_SB(0, 1), cB + hstep, voffB); PG8_STAGE(PG8_SA(0, 1), cA + hstep, voffA);
        if (wr == 1) PG8_BAR;
        PG8_WAIT_V(4); PG8_BAR;
        PG8_STAGE(PG8_SB(1, 0), cB + kstep, voffB); PG8_STAGE(PG8_SA(1, 0), cA + kstep, voffA); PG8_STAGE(PG8_SB(1, 1), cB + hstep + kstep, voffB);
        PG8_WAIT_V(6); PG8_BAR;
    }
    for (;;) {
        const bool has_next = S.next(ui + 1, nxt);
        const char* nA = has_next ? (const char*)g.A + (size_t)nxt.pm * tstep : cA; const char* nB = has_next ? (const char*)g.Bt + (size_t)nxt.pn * tstep : cB;
        for (int t = 0; t < nt; t += 2) {
            const bool last = (t == nt - 2);
            const char* a1 = cA + (size_t)(t + 1) * kstep;
            const char* a2 = last ? nA : cA + (size_t)(t + 2) * kstep; const char* b2 = last ? nB : cB + (size_t)(t + 2) * kstep;
            const char* a3 = a2 + kstep; const char* b3 = b2 + kstep;
            if (last && has_next) S.a_ready(nxt);
            if constexpr (SP2) {
            PG8_LDB(B0, 0, 0); PG8_LDB(B1, 0, 1); PG8_SCHED; PG8_LDA(At, 0, 0); PG8_STAGE(PG8_SA(1, 1), a1 + hstep, voffA);
            PG8_WAIT_V(8); PG8_WAIT_L(0); PG8_BAR; PG8_MMA(0, 0, At, B0); PG8_MMA(0, 1, At, B1); PG8_BAR; PG8_SCHED;
            PG8_LDA(At, 0, 1); PG8_STAGE(PG8_SB(0, 0), b2, voffB); PG8_STAGE(PG8_SB(0, 1), b2 + hstep, voffB); PG8_STAGE(PG8_SA(0, 0), a2, voffA);
            PG8_WAIT_V(8); PG8_WAIT_L(0); PG8_BAR; PG8_MMA(1, 0, At, B0); PG8_MMA(1, 1, At, B1); PG8_BAR; PG8_SCHED;
            PG8_LDB(B0, 1, 0); PG8_LDB(B1, 1, 1); PG8_SCHED; PG8_LDA(At, 1, 0); PG8_STAGE(PG8_SA(0, 1), a2 + hstep, voffA);
            PG8_WAIT_V(8); PG8_WAIT_L(0); PG8_BAR; PG8_MMA(0, 0, At, B0); PG8_MMA(0, 1, At, B1); PG8_BAR; PG8_SCHED;
            PG8_LDA(At, 1, 1); PG8_STAGE(PG8_SB(1, 0), b3, voffB); PG8_STAGE(PG8_SB(1, 1), b3 + hstep, voffB); PG8_STAGE(PG8_SA(1, 0), a3, voffA);
            PG8_WAIT_V(8); PG8_WAIT_L(0); PG8_BAR; PG8_MMA(1, 0, At, B0); PG8_MMA(1, 1, At, B1); PG8_BAR; PG8_SCHED;
            } else {
            PG8_LDB(B0, 0, 0); PG8_SCHED; PG8_LDA(At, 0, 0); PG8_STAGE(PG8_SA(1, 1), a1 + hstep, voffA);
            PG8_WAIT_L(8); PG8_BAR; PG8_WAIT_L(0); PG8_MMA(0, 0, At, B0); PG8_BAR; PG8_SCHED;
            PG8_LDB(B1, 0, 1); PG8_STAGE(PG8_SB(0, 0), b2, voffB);
            PG8_BAR; PG8_WAIT_L(0); PG8_MMA(0, 1, At, B1); PG8_BAR;
            PG8_LDA(At, 0, 1); PG8_STAGE(PG8_SA(0, 0), a2, voffA);
            PG8_BAR; PG8_WAIT_L(0); PG8_MMA(1, 0, At, B0); PG8_BAR; PG8_SCHED;
            PG8_STAGE(PG8_SB(0, 1), b2 + hstep, voffB);
            PG8_WAIT_V(6); PG8_BAR; PG8_MMA(1, 1, At, B1); PG8_BAR;
            PG8_LDB(B0, 1, 0); PG8_SCHED; PG8_LDA(At, 1, 0); PG8_STAGE(PG8_SA(0, 1), a2 + hstep, voffA);
            PG8_WAIT_L(8); PG8_BAR; PG8_WAIT_L(0); PG8_MMA(0, 0, At, B0); PG8_BAR; PG8_SCHED;
            PG8_LDB(B1, 1, 1); PG8_STAGE(PG8_SB(1, 0), b3, voffB);
            PG8_BAR; PG8_WAIT_L(0); PG8_MMA(0, 1, At, B1); PG8_BAR;
            PG8_LDA(At, 1, 1); PG8_STAGE(PG8_SA(1, 0), a3, voffA);
            PG8_BAR; PG8_WAIT_L(0); PG8_MMA(1, 0, At, B0); PG8_BAR; PG8_SCHED;
            PG8_STAGE(PG8_SB(1, 1), b3 + hstep, voffB);
            PG8_WAIT_V(6); PG8_BAR; PG8_MMA(1, 1, At, B1); PG8_BAR;
            }
        }
        if constexpr (ALIGN_EPI) { if (wr == 0) PG8_BAR; }
        if constexpr (!Epi::AFTER_DRAIN) { E(acc, cur, wr, wc, fr, fq); S.done(cur); }
        if (!has_next) break;
#pragma unroll
        for (int a = 0; a < 2; ++a)
#pragma unroll
            for (int b = 0; b < 2; ++b)
#pragma unroll
                for (int m = 0; m < 4; ++m)
#pragma unroll
                    for (int n = 0; n < 2; ++n) acc[a][b][m][n] = (f32x4){0.f, 0.f, 0.f, 0.f};
        cur = nxt; cA = nA; cB = nB; ++ui;
        if constexpr (ALIGN_EPI) { if (wr == 1) PG8_BAR; }
    }
    PG8_WAIT_V(0);
    if constexpr (!ALIGN_EPI) { if (wr == 0) PG8_BAR; }
    PG8_BAR;
    if constexpr (Epi::AFTER_DRAIN) { E.fused(acc, cur, wr, wc, fr, fq, lds, wid, lane); S.done(cur); }
#undef PG8_SA
#undef PG8_SB
#undef PG8_STAGE
#undef PG8_LDA
#undef PG8_LDB
#undef PG8_MMA
#undef PG8_WAIT_V
#undef PG8_WAIT_L
#undef PG8_BAR
#undef PG8_SCHED
}
}
namespace pg8 {
struct EpiRowScaleBf16 {
    static constexpr bool PERM = true, AFTER_DRAIN = false;
    bf16_t* O; int ldc; const float* rs;
    __device__ __forceinline__ void operator()(const f32x4 (&acc)[2][2][4][2], const Unit& u, int wr, int wc, int fr, int fq) const {
        const int row0 = u.pm * BM + wr * 64 + fr; const int col0 = u.pn * BM + wc * 32 + 8 * fq;
#pragma unroll
        for (int ai = 0; ai < 2; ++ai)
#pragma unroll
            for (int m = 0; m < 4; ++m) { const int row = row0 + ai * HALF + m * 16; const float sc = rs[row]; bf16_t* rowp = O + (size_t)row * ldc + col0;
#pragma unroll
                for (int bj = 0; bj < 2; ++bj) { f32x4 v0 = acc[ai][bj][m][0] * sc, v1 = acc[ai][bj][m][1] * sc;
                    u32x4 w; w.x = cvt_pk_bf16(v0[0], v0[1]); w.y = cvt_pk_bf16(v0[2], v0[3]); w.z = cvt_pk_bf16(v1[0], v1[1]); w.w = cvt_pk_bf16(v1[2], v1[3]);
                    *(u32x4*)(rowp + bj * HALF) = w; } }
    }
};
struct EpiResF32 {
    static constexpr bool PERM = false, AFTER_DRAIN = false;
    const float* base; float* out; int ldc;
    __device__ __forceinline__ void operator()(const f32x4 (&acc)[2][2][4][2], const Unit& u, int wr, int wc, int fr, int fq) const {
        const int col0 = u.pn * BM + wc * 32 + 4 * fq;
#pragma unroll
        for (int ai = 0; ai < 2; ++ai)
#pragma unroll
            for (int m = 0; m < 4; ++m) { const int r = u.pm * BM + ai * HALF + wr * 64 + m * 16 + fr; const size_t off = (size_t)r * ldc + col0;
#pragma unroll
                for (int bj = 0; bj < 2; ++bj)
#pragma unroll
                    for (int n = 0; n < 2; ++n) { const f32x4 bs = *(const f32x4*)(base + off + bj * HALF + n * 16); *(f32x4*)(out + off + bj * HALF + n * 16) = bs + acc[ai][bj][m][n]; } }
    }
};
}

constexpr int NB = 4, T = 8192, D = 1024, M = NB * T;
constexpr int NP = 3584;
constexpr int W_IN_COLS = 3596;
constexpr int C_R = 0, C_K = 512, C_V = 1024, C_G = 1536, C_WD = 2048, C_AD = 2112, C_NQ = 2176, C_NG = 2432, C_KC = 2688, C_VC = 2752,
              C_KS = 2816, C_VS = 2880, C_KW = 2944, C_VW = 3008, C_MQ = 3072, C_MG = 3328;
constexpr int GLOG_SRC = 2688;
constexpr int NCMP = 511, NSEL = 128, MEML = 256;

constexpr size_t MiB = 1u << 20;
constexpr size_t WS_CTL = 0, CTL_ZERO_BYTES = 1 * MiB;
constexpr size_t WS_WIN = 1 * MiB, WS_WOUT = 8 * MiB;
constexpr size_t WS_ROPE = 10 * MiB, WS_RS = 10 * MiB + 512 * 1024, WS_KCMP = 11 * MiB, WS_VCMP = 11 * MiB + 512 * 1024, WS_MEMKV = 12 * MiB, WS_GLOG = 14 * MiB;
constexpr size_t WS_P = 16 * MiB, WS_XB = 240 * MiB, WS_YR = 240 * MiB, WS_Y = 304 * MiB, WS_KK = 368 * MiB, WS_KA = 400 * MiB, WS_BB = 432 * MiB, WS_WD = 464 * MiB, WS_END = 496 * MiB;
constexpr int CW_BAR = 4096;

constexpr int RING_BYTES = 131072, LDSCTL_OFF = RING_BYTES, MISC_OFF = LDSCTL_OFF + 320, LDS_BYTES = 147456;
constexpr int NWAVES = 8;

#define GAS __attribute__((address_space(1)))
#define LAS __attribute__((address_space(3)))
typedef unsigned short bf16;
typedef unsigned v4u __attribute__((ext_vector_type(4)));
typedef unsigned v2u __attribute__((ext_vector_type(2)));
typedef float f32x4 __attribute__((ext_vector_type(4)));
#define LDS_WAIT() asm volatile("s_waitcnt lgkmcnt(0)" ::: "memory")
__device__ __forceinline__ unsigned f2bf(float f) { unsigned u = __builtin_bit_cast(unsigned, f); return (u + 0x7fffu + ((u >> 16) & 1u)) >> 16; }
__device__ __forceinline__ unsigned pk2(float lo, float hi) { return f2bf(lo) | (f2bf(hi) << 16); }
__device__ __forceinline__ float bf2f(unsigned short h) { return __builtin_bit_cast(float, (unsigned)h << 16); }
__device__ __forceinline__ float bflo(unsigned u) { return __builtin_bit_cast(float, u << 16); }
__device__ __forceinline__ float bfhi(unsigned u) { return __builtin_bit_cast(float, u & 0xffff0000u); }
__device__ __forceinline__ void unpack8(const v4u v, float (&f)[8]) { f[0] = bflo(v.x); f[1] = bfhi(v.x); f[2] = bflo(v.y); f[3] = bfhi(v.y); f[4] = bflo(v.z); f[5] = bfhi(v.z); f[6] = bflo(v.w); f[7] = bfhi(v.w); }
__device__ __forceinline__ v4u pack8(const float (&f)[8]) { v4u o; o.x = pk2(f[0], f[1]); o.y = pk2(f[2], f[3]); o.z = pk2(f[4], f[5]); o.w = pk2(f[6], f[7]); return o; }
__device__ __forceinline__ float rdlane(float v, int l) { return __builtin_bit_cast(float, __builtin_amdgcn_readlane(__builtin_bit_cast(int, v), l)); }
template <int CTRL> __device__ __forceinline__ float dppf(float v) { return __builtin_bit_cast(float, __builtin_amdgcn_update_dpp(0, __builtin_bit_cast(int, v), CTRL, 0xf, 0xf, true)); }
__device__ __forceinline__ float sum8(float x) { x += dppf<0xB1>(x); x += dppf<0x4E>(x); x += dppf<0x141>(x); return x; }
__device__ __forceinline__ float wave_sum(float v) {
#pragma unroll
    for (int o = 1; o < 64; o <<= 1) v += __shfl_xor(v, o);
    return v;
}
__device__ __forceinline__ float wave_max(float v) {
#pragma unroll
    for (int o = 1; o < 64; o <<= 1) v = fmaxf(v, __shfl_xor(v, o));
    return v;
}
__device__ __forceinline__ float siluf(float x) { return x / (1.f + __expf(-x)); }
__device__ __forceinline__ float sigmf(float x) { return 1.f / (1.f + __expf(-x)); }

#define XB_TMO      128
#define XB_XCNT(j)  (256  + 64 * (j))
#define XB_XSUB(j)  (1280 + 64 * (j))
#define XB_XGEN(j)  (2304 + 64 * (j))
#define XB_TOP      3328
#define XB_TOPGEN   3392
#define XCD_BAR_WORDS 3456
#define XB_SPIN_CAP (1u << 20)
__device__ __forceinline__ unsigned xb_ld(unsigned* p)              { return __hip_atomic_load(p, __ATOMIC_RELAXED, __HIP_MEMORY_SCOPE_AGENT); }
__device__ __forceinline__ unsigned xb_add(unsigned* p, unsigned v) { return __hip_atomic_fetch_add(p, v, __ATOMIC_RELAXED, __HIP_MEMORY_SCOPE_AGENT); }
__device__ __forceinline__ unsigned xb_xcc_id() { return (unsigned)__builtin_amdgcn_s_getreg((3 << 11) | 20) & 0xFu; }
#define XB_SPIN(cond, bar) do { unsigned _sp = 0; while (cond) { __builtin_amdgcn_s_sleep(1); \
    if ((++_sp & 255u) == 0u) { if (xb_ld(&(bar)[XB_TMO])) break; if (_sp > XB_SPIN_CAP) { atomicAdd(&(bar)[XB_TMO], 1u); break; } } } } while (0)
struct XcdBarrier { unsigned* bar; unsigned x; volatile LAS unsigned* st; };
__device__ __forceinline__ XcdBarrier xcd_barrier_post(unsigned* bar, volatile LAS unsigned* st) {
    XcdBarrier b; b.bar = bar; b.x = xb_xcc_id(); b.st = st;
    if (threadIdx.x == 0) (void)xb_add(&bar[XB_XCNT(b.x)], 1u);
    return b;
}
__device__ __forceinline__ void xcd_barrier_complete(unsigned* bar, unsigned x, unsigned& nloc, unsigned& nx) {
    const unsigned G = gridDim.x * gridDim.y * gridDim.z;
    unsigned sum, cnt, mine, sp = 0u;
    for (;;) {
        sum = 0u; cnt = 0u; mine = 0u;
#pragma unroll
        for (unsigned j = 0; j < 16; ++j) { const unsigned c = xb_ld(&bar[XB_XCNT(j)]); sum += c; cnt += (c > 0u) ? 1u : 0u; mine = (j == x) ? c : mine; }
        if (sum == G) break;
        __builtin_amdgcn_s_sleep(1);
        if ((++sp & 255u) == 0u) { if (xb_ld(&bar[XB_TMO])) break; if (sp > XB_SPIN_CAP) { atomicAdd(&bar[XB_TMO], 1u); break; } }
    }
    nloc = mine > 0u ? mine : 1u; nx = cnt > 0u ? cnt : 1u;
}
__device__ __forceinline__ void xcd_barrier(const XcdBarrier& b) {
    asm volatile("s_waitcnt vmcnt(0)" ::: "memory");
    __syncthreads();
    if (threadIdx.x == 0) {
        unsigned* bar = b.bar;
        __builtin_amdgcn_s_waitcnt(0);
        unsigned nloc = b.st[0], nx = b.st[1];
        if (nloc == 0u) { xcd_barrier_complete(bar, b.x, nloc, nx); b.st[0] = nloc; b.st[1] = nx; }
        const unsigned old = xb_add(&bar[XB_XSUB(b.x)], 1u);
        const unsigned gen = old / nloc;
        if (old + 1u == (gen + 1u) * nloc) {
            __builtin_amdgcn_fence(__ATOMIC_RELEASE, "agent");
            asm volatile("s_waitcnt vmcnt(0)" ::: "memory");
            const unsigned og = xb_add(&bar[XB_TOP], 1u);
            const unsigned tg = og / nx;
            if (og + 1u == (tg + 1u) * nx) xb_add(&bar[XB_TOPGEN], 1u);
            else XB_SPIN(xb_ld(&bar[XB_TOPGEN]) == tg, bar);
            __builtin_amdgcn_fence(__ATOMIC_ACQUIRE, "agent");
            xb_add(&bar[XB_XGEN(b.x)], 1u);
            asm volatile("s_waitcnt vmcnt(0)" ::: "memory");
        } else {
            XB_SPIN(xb_ld(&bar[XB_XGEN(b.x)]) == gen, bar);
            __builtin_amdgcn_fence(__ATOMIC_ACQUIRE, "agent");
            asm volatile("s_waitcnt vmcnt(0)" ::: "memory");
        }
    }
    __syncthreads();
}

struct Args { const float* in[26]; float* out; unsigned char* ws; };

__device__ __forceinline__ void p0_transpose_item(const float* W, int ldw, int src_col0, const float* kscale, bf16* WT, int K, int dst_row0, int k0, LAS float* scr, int lane) {
#pragma unroll 8
    for (int i = 0; i < 32; ++i) { const int kk = 2 * i + (lane >> 5); float v = W[(size_t)(k0 + kk) * ldw + src_col0 + (lane & 31)]; if (kscale) v *= kscale[k0 + kk]; scr[kk * 33 + (lane & 31)] = v; }
    LDS_WAIT(); asm volatile("" ::: "memory");
    const int c = lane & 7;
#pragma unroll
    for (int j = 0; j < 4; ++j) { const int n = (lane >> 3) + 8 * j; const LAS float* s = scr + (8 * c) * 33 + n;
        v4u o; o.x = pk2(s[0 * 33], s[1 * 33]); o.y = pk2(s[2 * 33], s[3 * 33]); o.z = pk2(s[4 * 33], s[5 * 33]); o.w = pk2(s[6 * 33], s[7 * 33]);
        *(v4u*)(WT + (size_t)(dst_row0 + n) * K + k0 + 8 * c) = o; }
    LDS_WAIT(); asm volatile("" ::: "memory");
}
__device__ __forceinline__ double rope_inv_freq(int i) {
    return i == 0 ? 1.0 : i == 1 ? 0.19392274474868576 : i == 2 ? 0.03760603093086393 : i == 3 ? 0.007292664737217109 : i == 4 ? 0.001414213562373095 :
           i == 5 ? 0.0002742481756762073 : i == 6 ? 5.318295896944988e-05 : 1.031338537721246e-05;
}
__device__ __forceinline__ void rope_cs(int pos, int i, float& c, float& s) {
    const double ang = (double)pos * rope_inv_freq(i);
    const double n = __builtin_rint(ang * 0.15915494309189535);
    const double r = __builtin_fma(-n, 6.283185307179586, ang);
    const double kq = __builtin_rint(r * 0.6366197723675814);
    const double y = __builtin_fma(-kq, 1.5707963267948966, r);
    const double y2 = y * y;
    const double sy = y * (1.0 + y2 * (-1.0 / 6 + y2 * (1.0 / 120 + y2 * (-1.0 / 5040 + y2 * (1.0 / 362880 - y2 * (1.0 / 39916800))))));
    const double cy = 1.0 + y2 * (-0.5 + y2 * (1.0 / 24 + y2 * (-1.0 / 720 + y2 * (1.0 / 40320 + y2 * (-1.0 / 3628800 + y2 * (1.0 / 479001600))))));
    const int q = ((int)kq) & 3;
    const double cc = q == 0 ? cy : q == 1 ? -sy : q == 2 ? -cy : sy;
    const double ss = q == 0 ? sy : q == 1 ? cy : q == 2 ? -sy : -cy;
    c = (float)cc; s = (float)ss;
}

typedef short bf16x8 __attribute__((ext_vector_type(8)));
typedef short v4i16 __attribute__((ext_vector_type(4)));
#define MFMA16(a, b, c) __builtin_amdgcn_mfma_f32_16x16x32_bf16(a, b, c, 0, 0, 0)
constexpr int AT_SLOT = 16384, AT_RING = 3 * AT_SLOT, AT_IMP = AT_RING, AT_IMP_W = 8448, AT_SELM = AT_IMP + 8 * AT_IMP_W, AT_TILEM = AT_SELM + 1024, AT_LIST = AT_TILEM + 16, AT_NB = AT_LIST + 544;
constexpr float SM_C = 0.125f * 1.4426950408889634f;
#define AT_WAITBAR(N) asm volatile("s_waitcnt vmcnt(" #N ") lgkmcnt(0)\n\ts_barrier" ::: "memory")

struct Grp { bf16x8 q[2]; f32x4 o[4]; float m, l; };

__device__ __forceinline__ void at_dma(const bf16* kb, size_t kpitch, const bf16* vb, size_t vpitch, LAS unsigned char* slot, int tid, int wave, bool withV) {
    const int r = tid >> 3, c = (tid & 7) ^ (2 * ((r >> 1) & 3));
    __builtin_amdgcn_global_load_lds((const unsigned*)(kb + (size_t)r * kpitch + c * 8), (LAS unsigned*)(slot + wave * 1024), 16, 0, 0);
    if (withV) __builtin_amdgcn_global_load_lds((const unsigned*)(vb + (size_t)r * vpitch + c * 8), (LAS unsigned*)(slot + 8192 + wave * 1024), 16, 0, 0);
}
__device__ __forceinline__ unsigned cvtpk(float lo, float hi) { typedef float f2 __attribute__((ext_vector_type(2))); typedef __bf16 b2 __attribute__((ext_vector_type(2))); f2 v = {lo, hi}; b2 b = __builtin_convertvector(v, b2); return __builtin_bit_cast(unsigned, b); }
__device__ __forceinline__ float fmax3(float a, float b, float c) { return fmaxf(fmaxf(a, b), c); }

template <int NG, int MODE>
__device__ __forceinline__ void at_block(Grp (&G)[NG], LAS const unsigned char* slot, int koff0, int koff1, const int (&vdt)[4], int g, const int (&lo)[NG], const int (&hi)[NG], const bool (&need)[NG], bool partial,
                                         LAS float* impA, LAS float* impB, int sb0, int lane) {
    bf16x8 kf[4][2];
#pragma unroll
    for (int kt = 0; kt < 4; ++kt) { kf[kt][0] = *(const LAS bf16x8*)(slot + kt * 2048 + koff0); kf[kt][1] = *(const LAS bf16x8*)(slot + kt * 2048 + koff1); }
    bf16x8 pf[NG][2];
#pragma unroll
    for (int gi = 0; gi < NG; ++gi) {
        if (!need[gi]) continue;
        f32x4 s[4];
#pragma unroll
        for (int kt = 0; kt < 4; ++kt) { s[kt] = (f32x4){0.f, 0.f, 0.f, 0.f}; s[kt] = MFMA16(kf[kt][0], G[gi].q[0], s[kt]); s[kt] = MFMA16(kf[kt][1], G[gi].q[1], s[kt]); }
        if (partial) {
#pragma unroll
            for (int kt = 0; kt < 4; ++kt)
#pragma unroll
                for (int r = 0; r < 4; ++r) { const int kl = 16 * kt + 4 * g + r; if (kl < lo[gi] || kl > hi[gi]) s[kt][r] = -INFINITY; }
        }
        float mref;
        if (MODE != 1) {
            float mx = fmax3(s[0][0], s[0][1], s[0][2]); mx = fmax3(mx, s[0][3], s[1][0]); mx = fmax3(mx, s[1][1], s[1][2]); mx = fmax3(mx, s[1][3], s[2][0]);
            mx = fmax3(mx, s[2][1], s[2][2]); mx = fmax3(mx, s[2][3], s[3][0]); mx = fmax3(mx, s[3][1], s[3][2]); mx = fmaxf(mx, s[3][3]);
            mx = fmaxf(mx, __shfl_xor(mx, 16)); mx = fmaxf(mx, __shfl_xor(mx, 32));
            const float mn = fmaxf(G[gi].m, mx * SM_C);
            const float alpha = __builtin_amdgcn_exp2f(G[gi].m - mn);
            G[gi].m = mn; mref = mn;
            if (__builtin_amdgcn_ballot_w64(alpha != 1.0f)) {
                G[gi].l *= alpha;
                if (MODE == 2) {
#pragma unroll
                    for (int dt = 0; dt < 4; ++dt) G[gi].o[dt] *= alpha; }
            }
        } else mref = G[gi].m;
        float lsum = 0.f;
#pragma unroll
        for (int kt = 0; kt < 4; ++kt)
#pragma unroll
            for (int r = 0; r < 4; ++r) { const float p = __builtin_amdgcn_exp2f(__builtin_fmaf(s[kt][r], SM_C, -mref)); s[kt][r] = p; lsum += p; }
        if (MODE != 1) G[gi].l += lsum;
        if (MODE == 1) {
            const float il = G[gi].l;
#pragma unroll
            for (int kt = 0; kt < 4; ++kt) { s[kt] *= il;
                float a = s[kt][0] + s[kt][1] + s[kt][2] + 0.5f * s[kt][3], b = 0.5f * s[kt][3];
                a += dppf<0xB1>(a); a += dppf<0x4E>(a); b += dppf<0xB1>(b); b += dppf<0x4E>(b);
                if ((lane & 3) == 0) { const int q8 = gi * 4 + ((lane & 15) >> 2); impA[q8 * 132 + sb0 + 4 * kt + g] = a; impB[q8 * 132 + sb0 + 4 * kt + g + 1] = b; } }
        }
        if (MODE != 0) {
            pf[gi][0] = __builtin_bit_cast(bf16x8, (v4u){cvtpk(s[0][0], s[0][1]), cvtpk(s[0][2], s[0][3]), cvtpk(s[1][0], s[1][1]), cvtpk(s[1][2], s[1][3])});
            pf[gi][1] = __builtin_bit_cast(bf16x8, (v4u){cvtpk(s[2][0], s[2][1]), cvtpk(s[2][2], s[2][3]), cvtpk(s[3][0], s[3][1]), cvtpk(s[3][2], s[3][3])});
        }
    }
    if (MODE != 0) {
        LAS const unsigned char* vs = slot + 8192;
#pragma unroll
        for (int dt = 0; dt < 4; ++dt) {
            bf16x8 vf[2];
#pragma unroll
            for (int kp = 0; kp < 2; ++kp) {
                const v4i16 a = __builtin_amdgcn_ds_read_tr16_b64_v4i16((LAS v4i16*)(vs + vdt[dt] + (2 * kp) * 2048));
                const v4i16 b = __builtin_amdgcn_ds_read_tr16_b64_v4i16((LAS v4i16*)(vs + vdt[dt] + (2 * kp + 1) * 2048));
                vf[kp] = (bf16x8){a[0], a[1], a[2], a[3], b[0], b[1], b[2], b[3]};
            }
#pragma unroll
            for (int gi = 0; gi < NG; ++gi) if (need[gi]) { G[gi].o[dt] = MFMA16(vf[0], pf[gi][0], G[gi].o[dt]); G[gi].o[dt] = MFMA16(vf[1], pf[gi][1], G[gi].o[dt]); }
        }
    }
}

template <bool WITHV, class Src, class Body>
__device__ __forceinline__ void at_ring(LAS unsigned char* ring, int nb, int tid, int wave, const Src& src, Body& body) {
    const bf16 *kb = nullptr, *vb = nullptr; size_t kp = 0, vp = 0;
    if (nb > 0) { src(0, kb, kp, vb, vp); at_dma(kb, kp, vb, vp, ring, tid, wave, WITHV); }
    if (nb > 1) { src(1, kb, kp, vb, vp); at_dma(kb, kp, vb, vp, ring + AT_SLOT, tid, wave, WITHV); }
    for (int i = 0; i < nb; ++i) {
        if (i + 1 < nb) { if (WITHV) AT_WAITBAR(2); else AT_WAITBAR(1); } else AT_WAITBAR(0);
        if (i + 2 < nb) { src(i + 2, kb, kp, vb, vp); at_dma(kb, kp, vb, vp, ring + ((i + 2) % 3) * AT_SLOT, tid, wave, WITHV); }
        body(i, ring + (i % 3) * AT_SLOT);
    }
    AT_WAITBAR(0);
}

struct LaneGeo { int lane, i16, g, koff0, koff1; int vdt[4]; };
__device__ __forceinline__ LaneGeo make_geo(int lane) {
    LaneGeo L; L.lane = lane; L.i16 = lane & 15; L.g = lane >> 4;
    const int swz = 2 * ((L.i16 >> 1) & 3);
    L.koff0 = L.i16 * 128 + (((0 ^ (swz >> 2)) * 4 + (L.g ^ (swz & 3))) * 16);
    L.koff1 = L.i16 * 128 + (((1 ^ (swz >> 2)) * 4 + (L.g ^ (swz & 3))) * 16);
    const int sv = (2 * L.g + (L.i16 >> 3)) & 3; const int vbase = (4 * L.g + (L.i16 >> 2)) * 128 + 8 * (L.i16 & 1) + ((L.i16 & 3) >> 1) * 16;
#pragma unroll
    for (int dt = 0; dt < 4; ++dt) L.vdt[dt] = vbase + ((dt ^ sv) << 5);
    return L;
}
__device__ __forceinline__ float xg_sum(float v) { v += __shfl_xor(v, 16); v += __shfl_xor(v, 32); return v; }

struct SrcCmp { const bf16* K; const bf16* V; int b; __device__ __forceinline__ void operator()(int i, const bf16*& kb, size_t& kp, const bf16*& vb, size_t& vp) const {
    kb = K + (size_t)(b * 512 + 64 * i) * 64; kp = 64; vb = V + (size_t)(b * 512 + 64 * i) * 64; vp = 64; } };
struct SrcSel { const bf16* P; LAS const unsigned* list; bool use_list; int b; int kcol, vcol; int s0;
    __device__ __forceinline__ void operator()(int i, const bf16*& kb, size_t& kp, const bf16*& vb, size_t& vp) const {
        const int s = use_list ? (int)__builtin_amdgcn_readfirstlane(list[i]) : s0 + i; const bf16* base = P + (size_t)(b * T + 64 * s) * NP; kb = base + kcol; vb = base + vcol; kp = NP; vp = NP; } };

struct BodyCmp0 { Grp (&G)[2]; const LaneGeo& L; const int (&nv)[2];
    __device__ __forceinline__ void operator()(int i, LAS const unsigned char* slot) {
        const int lo[2] = {0, 0}; const int hi[2] = {nv[0] - 64 * i - 1, nv[1] - 64 * i - 1}; const bool need[2] = {true, true};
        const bool partial = __builtin_amdgcn_ballot_w64(hi[0] < 63 || hi[1] < 63) != 0ull;
        at_block<2, 0>(G, slot, L.koff0, L.koff1, L.vdt, L.g, lo, hi, need, partial, nullptr, nullptr, 0, L.lane); } };
struct BodyCmp1 { Grp (&G)[2]; const LaneGeo& L; const int (&nv)[2]; LAS float* impA; LAS float* impB;
    __device__ __forceinline__ void operator()(int i, LAS const unsigned char* slot) {
        const int lo[2] = {0, 0}; const int hi[2] = {nv[0] - 64 * i - 1, nv[1] - 64 * i - 1}; const bool need[2] = {true, true};
        const bool partial = __builtin_amdgcn_ballot_w64(hi[0] < 63 || hi[1] < 63) != 0ull;
        at_block<2, 1>(G, slot, L.koff0, L.koff1, L.vdt, L.g, lo, hi, need, partial, impA, impB, 16 * i, L.lane); } };
struct BodySel { Grp (&G)[2]; const LaneGeo& L; LAS const unsigned* list; LAS const unsigned* selm; const int (&tql)[2]; int cur;
    __device__ __forceinline__ void operator()(int i, LAS const unsigned char* slot) {
        const int s = (int)__builtin_amdgcn_readfirstlane(list[i]); const int w = s >> 5, bit = s & 31;
        int lo[2] = {0, 0}, hi[2]; bool need[2];
#pragma unroll
        for (int gi = 0; gi < 2; ++gi) { const unsigned word = selm[tql[gi] * 4 + w]; const bool on = (word >> bit) & 1u;
            hi[gi] = on ? (s == cur ? tql[gi] : 63) : -1; need[gi] = __builtin_amdgcn_ballot_w64(on) != 0ull; }
        if (!need[0] && !need[1]) return;
        const bool partial = __builtin_amdgcn_ballot_w64((need[0] && hi[0] < 63) || (need[1] && hi[1] < 63)) != 0ull;
        at_block<2, 2>(G, slot, L.koff0, L.koff1, L.vdt, L.g, lo, hi, need, partial, nullptr, nullptr, 0, L.lane); } };
struct BodyWin { Grp (&G)[2]; const LaneGeo& L; const int (&tql)[2]; int cur, s0;
    __device__ __forceinline__ void operator()(int i, LAS const unsigned char* slot) {
        const int s = s0 + i; int lo[2], hi[2]; const bool need[2] = {true, true};
#pragma unroll
        for (int gi = 0; gi < 2; ++gi) { lo[gi] = (s == cur - 8) ? tql[gi] + 1 : 0; hi[gi] = (s == cur) ? tql[gi] : 63; }
        const bool partial = (s == cur) || (s == cur - 8);
        at_block<2, 2>(G, slot, L.koff0, L.koff1, L.vdt, L.g, lo, hi, need, partial, nullptr, nullptr, 0, L.lane); } };

__device__ __forceinline__ void grp_reset(Grp& g) { g.m = -1e30f; g.l = 0.f;
#pragma unroll
    for (int dt = 0; dt < 4; ++dt) g.o[dt] = (f32x4){0.f, 0.f, 0.f, 0.f}; }

__device__ __forceinline__ void nsa_unit(int b, int cur, LAS unsigned char* lds, int tid, int wave, int lane, const bf16* P, const bf16* KCMPb, const bf16* VCMPb, const float* GLOG, const float* gate_b,
                                         const float* nsa_out_g, const float* ROPE, bf16* Y) {
    LAS unsigned char* ring = lds;
    LAS float* impA = (LAS float*)(lds + AT_IMP + wave * AT_IMP_W); LAS float* impB = impA + 8 * 132;
    LAS unsigned* selm = (LAS unsigned*)(lds + AT_SELM); LAS unsigned* tilem = (LAS unsigned*)(lds + AT_TILEM); LAS unsigned* blist = (LAS unsigned*)(lds + AT_LIST); LAS unsigned* nbw = (LAS unsigned*)(lds + AT_NB);
    const LaneGeo L = make_geo(lane);
    const int t0 = cur * 64; const size_t m0 = (size_t)b * T + t0;
    const int h = L.i16 & 3;
    int tql[2]; tql[0] = 8 * wave + (L.i16 >> 2); tql[1] = tql[0] + 4;
    if (tid < 4) tilem[tid] = 0u;
    Grp G[2]; int nv[2];
    LAS float* otp = impA + lane;
#pragma unroll
    for (int gi = 0; gi < 2; ++gi) {
        const bf16* qp = P + (m0 + tql[gi]) * NP + C_NQ + h * 64 + 8 * L.g;
        G[gi].q[0] = *(const bf16x8*)qp; G[gi].q[1] = *(const bf16x8*)(qp + 32);
        const int tq = t0 + tql[gi]; nv[gi] = tq >= 31 ? min((tq - 31) / 16 + 1, NCMP) : 0;
        grp_reset(G[gi]);
    }
    for (int i = lane; i < 2 * 8 * 132; i += 64) impA[i] = 0.f;
    const int nvmax = (t0 + 63 >= 31) ? min((t0 + 63 - 31) / 16 + 1, NCMP) : 0; const int nblk = (nvmax + 63) >> 6;
    { SrcCmp src{KCMPb, VCMPb, b}; BodyCmp0 body{G, L, nv}; at_ring<false>(ring, nblk, tid, wave, src, body); }
#pragma unroll
    for (int gi = 0; gi < 2; ++gi) { const float lt = xg_sum(G[gi].l); G[gi].l = 1.0f / fmaxf(lt, 1e-30f); }
    { SrcCmp src{KCMPb, VCMPb, b}; BodyCmp1 body{G, L, nv, impA, impB}; at_ring<true>(ring, nblk, tid, wave, src, body); }
    {
        unsigned long long accA = 0ull, accB = 0ull;
        const unsigned long long validA = cur >= 63 ? ~0ull : ((1ull << (cur + 1)) - 1ull), validB = cur < 64 ? 0ull : (cur >= 127 ? ~0ull : ((1ull << (cur - 63)) - 1ull));
#pragma unroll 1
        for (int q8 = 0; q8 < 8; ++q8) {
            const float fa = impA[q8 * 132 + lane] + impB[q8 * 132 + lane], fb = impA[q8 * 132 + 64 + lane] + impB[q8 * 132 + 64 + lane];
            const int sa = lane, sb = lane + 64;
            unsigned va = __builtin_bit_cast(unsigned, fa), vb = __builtin_bit_cast(unsigned, fb);
            if (sa == 0 || sa == cur || sa == cur - 1) va = 0x7f000000u; else if (sa > cur) va = 0u;
            if (sb == cur || sb == cur - 1) vb = 0x7f000000u; else if (sb > cur) vb = 0u;
            unsigned tau = 0u;
#pragma unroll 1
            for (int bit = 30; bit >= 0; --bit) { const unsigned cand = tau | (1u << bit);
                const int cnt = __builtin_popcountll(__builtin_amdgcn_ballot_w64(va >= cand)) + __builtin_popcountll(__builtin_amdgcn_ballot_w64(vb >= cand));
                if (cnt >= 16) tau = cand; }
            const unsigned long long gtA = __builtin_amdgcn_ballot_w64(va > tau), gtB = __builtin_amdgcn_ballot_w64(vb > tau);
            const unsigned long long eqA = __builtin_amdgcn_ballot_w64(va == tau), eqB = __builtin_amdgcn_ballot_w64(vb == tau);
            const int needn = 16 - __builtin_popcountll(gtA) - __builtin_popcountll(gtB); const int nA = __builtin_popcountll(eqA);
            const int takeA = min(needn, nA), takeB = needn - takeA;
            const int rA = __builtin_amdgcn_mbcnt_hi((unsigned)(eqA >> 32), __builtin_amdgcn_mbcnt_lo((unsigned)eqA, 0));
            const int rB = __builtin_amdgcn_mbcnt_hi((unsigned)(eqB >> 32), __builtin_amdgcn_mbcnt_lo((unsigned)eqB, 0));
            const unsigned long long selA = (gtA | __builtin_amdgcn_ballot_w64(va == tau && rA < takeA)) & validA;
            const unsigned long long selB = (gtB | __builtin_amdgcn_ballot_w64(vb == tau && rB < takeB)) & validB;
            if (lane == 0) { LAS unsigned* d = selm + (8 * wave + q8) * 4; d[0] = (unsigned)selA; d[1] = (unsigned)(selA >> 32); d[2] = (unsigned)selB; d[3] = (unsigned)(selB >> 32); }
            accA |= selA; accB |= selB;
        }
        if (lane == 0) { atomicOr((unsigned*)&tilem[0], (unsigned)accA); atomicOr((unsigned*)&tilem[1], (unsigned)(accA >> 32)); atomicOr((unsigned*)&tilem[2], (unsigned)accB); atomicOr((unsigned*)&tilem[3], (unsigned)(accB >> 32)); }
    }
    AT_WAITBAR(0);
    if (wave == 0) {
        const unsigned long long mA = (unsigned long long)tilem[0] | ((unsigned long long)tilem[1] << 32), mB = (unsigned long long)tilem[2] | ((unsigned long long)tilem[3] << 32);
        const int rA = __builtin_amdgcn_mbcnt_hi((unsigned)(mA >> 32), __builtin_amdgcn_mbcnt_lo((unsigned)mA, 0));
        const int rB = __builtin_amdgcn_mbcnt_hi((unsigned)(mB >> 32), __builtin_amdgcn_mbcnt_lo((unsigned)mB, 0));
        const int nA = __builtin_popcountll(mA);
        if ((mA >> lane) & 1ull) blist[rA] = (unsigned)lane;
        if ((mB >> lane) & 1ull) blist[nA + rB] = (unsigned)(64 + lane);
        if (lane == 0) nbw[0] = (unsigned)(nA + __builtin_popcountll(mB));
    }
    AT_WAITBAR(0);
    const int nsel = (int)__builtin_amdgcn_readfirstlane(nbw[0]);
#pragma unroll
    for (int gi = 0; gi < 2; ++gi) { const float gt = sigmf(GLOG[(m0 + tql[gi]) * 12 + h * 3 + 0] + gate_b[h * 3 + 0]);
#pragma unroll
        for (int dt = 0; dt < 4; ++dt)
#pragma unroll
            for (int r = 0; r < 4; ++r) otp[((gi * 4 + dt) * 4 + r) * 64] = G[gi].o[dt][r] * gt; }
#pragma unroll
    for (int gi = 0; gi < 2; ++gi) {
        const int tq = t0 + tql[gi];
        float xf[8]; unpack8(__builtin_bit_cast(v4u, G[gi].q[0]), xf);
        float of[8];
#pragma unroll
        for (int j = 0; j < 8; ++j) of[j] = __shfl_xor(xf[j], 16);
        if (L.g < 2) {
            const f32x4 c0 = *(const f32x4*)(ROPE + tq * 16), c1 = *(const f32x4*)(ROPE + tq * 16 + 4), s0 = *(const f32x4*)(ROPE + tq * 16 + 8), s1 = *(const f32x4*)(ROPE + tq * 16 + 12);
            const float cs[8] = {c0.x, c0.y, c0.z, c0.w, c1.x, c1.y, c1.z, c1.w}, sn[8] = {s0.x, s0.y, s0.z, s0.w, s1.x, s1.y, s1.z, s1.w};
#pragma unroll
            for (int j = 0; j < 8; ++j) xf[j] = (L.g == 0) ? (xf[j] * cs[j] - of[j] * sn[j]) : (xf[j] * cs[j] + of[j] * sn[j]);
        }
        G[gi].q[0] = __builtin_bit_cast(bf16x8, pack8(xf));
        grp_reset(G[gi]);
    }
    { SrcSel src{P, blist, true, b, C_KS, C_VS, 0}; BodySel body{G, L, blist, selm, tql, cur}; at_ring<true>(ring, nsel, tid, wave, src, body); }
#pragma unroll
    for (int gi = 0; gi < 2; ++gi) { const float il = sigmf(GLOG[(m0 + tql[gi]) * 12 + h * 3 + 1] + gate_b[h * 3 + 1]) / fmaxf(xg_sum(G[gi].l), 1e-30f);
#pragma unroll
        for (int dt = 0; dt < 4; ++dt)
#pragma unroll
            for (int r = 0; r < 4; ++r) otp[((gi * 4 + dt) * 4 + r) * 64] += G[gi].o[dt][r] * il;
        grp_reset(G[gi]); }
    { const int s0 = max(0, cur - 8); SrcSel src{P, blist, false, b, C_KW, C_VW, s0}; BodyWin body{G, L, tql, cur, s0}; at_ring<true>(ring, cur - s0 + 1, tid, wave, src, body); }
#pragma unroll
    for (int gi = 0; gi < 2; ++gi) { const float il = sigmf(GLOG[(m0 + tql[gi]) * 12 + h * 3 + 2] + gate_b[h * 3 + 2]) / fmaxf(xg_sum(G[gi].l), 1e-30f);
#pragma unroll
        for (int dt = 0; dt < 4; ++dt)
#pragma unroll
            for (int r = 0; r < 4; ++r) G[gi].o[dt][r] = otp[((gi * 4 + dt) * 4 + r) * 64] + G[gi].o[dt][r] * il; }
#pragma unroll
    for (int gi = 0; gi < 2; ++gi) {
        float ss = 0.f;
#pragma unroll
        for (int dt = 0; dt < 4; ++dt) ss += G[gi].o[dt].x * G[gi].o[dt].x + G[gi].o[dt].y * G[gi].o[dt].y + G[gi].o[dt].z * G[gi].o[dt].z + G[gi].o[dt].w * G[gi].o[dt].w;
        ss = xg_sum(ss); const float sc = 1.0f / sqrtf(ss * (1.f / 64.f) + 1e-6f);
        const size_t mq = m0 + tql[gi];
#pragma unroll
        for (int dt = 0; dt < 4; ++dt) { const int d = h * 64 + 16 * dt + 4 * L.g;
            const f32x4 gn = *(const f32x4*)(nsa_out_g + d); const v2u gt = *(const v2u*)(P + mq * NP + C_NG + d);
            const float o0 = G[gi].o[dt].x * sc * gn.x * siluf(bflo(gt.x)), o1 = G[gi].o[dt].y * sc * gn.y * siluf(bfhi(gt.x)), o2 = G[gi].o[dt].z * sc * gn.z * siluf(bflo(gt.y)), o3 = G[gi].o[dt].w * sc * gn.w * siluf(bfhi(gt.y));
            *(v2u*)(Y + mq * D + 512 + d) = (v2u){pk2(o0, o1), pk2(o2, o3)}; }
    }
}

struct SrcMem { const bf16* KV; int b; __device__ __forceinline__ void operator()(int i, const bf16*& kb, size_t& kp, const bf16*& vb, size_t& vp) const {
    const int hh = i >> 2, blk = i & 3; kb = KV + (size_t)(b * MEML + 64 * blk) * 512 + hh * 64; vb = kb + 256; kp = 512; vp = 512; } };
struct BodyMem { Grp (&G)[1]; const LaneGeo& L; const bf16* P; bf16* Y; const float* og; size_t mq;
    __device__ __forceinline__ void operator()(int i, LAS const unsigned char* slot) {
        const int hh = i >> 2, blk = i & 3;
        if (blk == 0) { const bf16* qp = P + mq * NP + C_MQ + hh * 64 + 8 * L.g; G[0].q[0] = *(const bf16x8*)qp; G[0].q[1] = *(const bf16x8*)(qp + 32); grp_reset(G[0]); }
        const int lo[1] = {0}, hi[1] = {63}; const bool need[1] = {true};
        at_block<1, 2>(G, slot, L.koff0, L.koff1, L.vdt, L.g, lo, hi, need, false, nullptr, nullptr, 0, L.lane);
        if (blk == 3) {
            const float il = 1.0f / fmaxf(xg_sum(G[0].l), 1e-30f); float ss = 0.f;
#pragma unroll
            for (int dt = 0; dt < 4; ++dt) { G[0].o[dt] *= il; ss += G[0].o[dt].x * G[0].o[dt].x + G[0].o[dt].y * G[0].o[dt].y + G[0].o[dt].z * G[0].o[dt].z + G[0].o[dt].w * G[0].o[dt].w; }
            ss = xg_sum(ss); const float sc = 1.0f / sqrtf(ss * (1.f / 64.f) + 1e-6f);
#pragma unroll
            for (int dt = 0; dt < 4; ++dt) { const int d = hh * 64 + 16 * dt + 4 * L.g;
                const f32x4 gn = *(const f32x4*)(og + d); const v2u gt = *(const v2u*)(P + mq * NP + C_MG + d); const f32x4 o = G[0].o[dt];
                const float o0 = o.x * sc * gn.x * siluf(bflo(gt.x)), o1 = o.y * sc * gn.y * siluf(bfhi(gt.x)), o2 = o.z * sc * gn.z * siluf(bflo(gt.y)), o3 = o.w * sc * gn.w * siluf(bfhi(gt.y));
                *(v2u*)(Y + mq * D + 768 + d) = (v2u){pk2(o0, o1), pk2(o2, o3)}; }
        }
    } };

#ifndef PHASES
#define PHASES 0x3ff
#endif
__global__ void __launch_bounds__(NWAVES * 64, 2) hymba_fwd(Args args) {
    extern __shared__ __attribute__((aligned(16))) unsigned char lds_raw[];
    LAS unsigned char* lds = (LAS unsigned char*)lds_raw;
    volatile LAS unsigned* MISC = (volatile LAS unsigned*)(lds + MISC_OFF);
    const int tid = threadIdx.x, lane = tid & 63, wave = __builtin_amdgcn_readfirstlane(tid >> 6);
    const int G = gridDim.x; const int bx = blockIdx.x; const int vcu = (G % 8 == 0) ? (bx % 8) * (G / 8) + bx / 8 : bx;
    const int gw = vcu * NWAVES + wave, NGW = G * NWAVES;
    unsigned char* ws = args.ws;
    unsigned* ctl = (unsigned*)(ws + WS_CTL);
    const float* x = args.in[0]; const float* mem = args.in[1]; const float* norm_in_g = args.in[2]; const float* w_in = args.in[3];
    const float* mu = args.in[4]; const float* w0 = args.in[5]; const float* w_up = args.in[6]; const float* a0 = args.in[7]; const float* a_up = args.in[8];
    const float* k_k = args.in[9]; const float* k_a = args.in[10]; const float* r_k = args.in[11]; const float* ln_w = args.in[12]; const float* ln_b = args.in[13];
    const float* cmp_pos = args.in[14]; const float* ck_w1 = args.in[15]; const float* ck_w2 = args.in[16]; const float* cv_w1 = args.in[17]; const float* cv_w2 = args.in[18];
    const float* gate_b = args.in[19]; const float* nsa_out_g = args.in[20]; const float* mem_norm_g = args.in[21]; const float* w_mem_kv = args.in[22];
    const float* mem_out_g = args.in[23]; const float* w_out = args.in[24]; const float* norm_final_g = args.in[25];
    float* out = args.out;
    bf16* WT_IN = (bf16*)(ws + WS_WIN); bf16* WT_OUT = (bf16*)(ws + WS_WOUT);
    float* ROPE = (float*)(ws + WS_ROPE); float* RS = (float*)(ws + WS_RS); bf16* KCMP = (bf16*)(ws + WS_KCMP); bf16* VCMP = (bf16*)(ws + WS_VCMP);
    bf16* MEMKV = (bf16*)(ws + WS_MEMKV); float* GLOG = (float*)(ws + WS_GLOG);
    bf16* P = (bf16*)(ws + WS_P); bf16* XB = (bf16*)(ws + WS_XB); float* YR = (float*)(ws + WS_YR); bf16* Y = (bf16*)(ws + WS_Y);
    bf16* KK = (bf16*)(ws + WS_KK); bf16* KA = (bf16*)(ws + WS_KA); bf16* BB = (bf16*)(ws + WS_BB); bf16* WDc = (bf16*)(ws + WS_WD);

    for (int u = tid; u < (LDS_BYTES - LDSCTL_OFF) / 4; u += NWAVES * 64) ((LAS unsigned*)(lds + LDSCTL_OFF))[u] = 0u;
    __syncthreads();
    XcdBarrier bar = xcd_barrier_post(ctl + CW_BAR, MISC + 8);

    if (PHASES & 1) {
        LAS float* wgt = (LAS float*)(lds + 81920);
        for (int i = tid; i < D * 12; i += NWAVES * 64) { const int k = i / 12, c = i % 12; wgt[i] = norm_in_g[k] * w_in[(size_t)k * W_IN_COLS + GLOG_SRC + c]; }
        __syncthreads();
        LAS float* scr = (LAS float*)(lds + wave * 8704);
        constexpr int I_IN = 16 * (NP / 32), I_OUT = 16 * (D / 32);
        for (int it = gw; it < I_IN + I_OUT; it += NGW) {
            if (it < I_IN) { const int kb = it / (NP / 32), nb = it % (NP / 32); const int src = 32 * nb + (32 * nb >= GLOG_SRC ? 12 : 0);
                p0_transpose_item(w_in, W_IN_COLS, src, norm_in_g, WT_IN, D, 32 * nb, 64 * kb, scr, lane); }
            else { const int r = it - I_IN; const int kb = r / (D / 32), nb = r % (D / 32);
                p0_transpose_item(w_out, D, 32 * nb, nullptr, WT_OUT, D, 32 * nb, 64 * kb, scr, lane); }
        }
        for (int i = gw * 64 + lane; i < T * 8; i += NGW * 64) { float c, s; rope_cs(i >> 3, i & 7, c, s); ROPE[(i >> 3) * 16 + (i & 7)] = c; ROPE[(i >> 3) * 16 + 8 + (i & 7)] = s; }
        for (int m = gw; m < M; m += NGW) {
            const f32x4* xr = (const f32x4*)(x + (size_t)m * D) + lane;
            f32x4 v[4]; float ss = 0.f;
#pragma unroll
            for (int j = 0; j < 4; ++j) { v[j] = xr[64 * j]; ss += (v[j].x * v[j].x + v[j].y * v[j].y) + (v[j].z * v[j].z + v[j].w * v[j].w); }
            ss = wave_sum(ss);
            const float rs = 1.0f / sqrtf(ss * (1.f / D) + 1e-6f);
            unsigned long long* o8 = (unsigned long long*)(XB + (size_t)m * D) + lane;
#pragma unroll
            for (int j = 0; j < 4; ++j) o8[64 * j] = (unsigned long long)pk2(v[j].x, v[j].y) | ((unsigned long long)pk2(v[j].z, v[j].w) << 32);
            float acc[12];
#pragma unroll
            for (int c = 0; c < 12; ++c) acc[c] = 0.f;
#pragma unroll
            for (int j = 0; j < 4; ++j)
#pragma unroll
                for (int e = 0; e < 4; ++e) { const int k = 256 * j + 4 * lane + e; const float xv = v[j][e];
                    const f32x4 w0v = *(const LAS f32x4*)(wgt + k * 12), w1v = *(const LAS f32x4*)(wgt + k * 12 + 4), w2v = *(const LAS f32x4*)(wgt + k * 12 + 8);
                    acc[0] += xv * w0v.x; acc[1] += xv * w0v.y; acc[2] += xv * w0v.z; acc[3] += xv * w0v.w;
                    acc[4] += xv * w1v.x; acc[5] += xv * w1v.y; acc[6] += xv * w1v.z; acc[7] += xv * w1v.w;
                    acc[8] += xv * w2v.x; acc[9] += xv * w2v.y; acc[10] += xv * w2v.z; acc[11] += xv * w2v.w; }
            float mine = 0.f;
#pragma unroll
            for (int c = 0; c < 12; ++c) { const float t = wave_sum(acc[c]); if (lane == c) mine = t; }
            if (lane < 12) GLOG[(size_t)m * 12 + lane] = mine * rs;
            if (lane == 0) RS[m] = rs;
        }
    }
    xcd_barrier(bar);

    if (PHASES & 2) {
        pg8::Gemm g{XB, WT_IN, M, NP, D}; pg8::StaticOrder S; S.init(M, NP, G, bx);
        pg8::EpiRowScaleBf16 E{P, NP, RS};
        pg8::gemm_phase<pg8::EpiRowScaleBf16, pg8::StaticOrder, true, true>(lds, g, S, E);
    }
    xcd_barrier(bar);

    if (PHASES & 4) {
        LAS bf16* wup = (LAS bf16*)lds; LAS bf16* aup = (LAS bf16*)(lds + 65536);
        for (int i = tid; i < 64 * 512; i += NWAVES * 64) { wup[i] = (bf16)f2bf(w_up[i]); aup[i] = (bf16)f2bf(a_up[i]); }
        __syncthreads();
        const int c0 = lane * 8;
        for (int m = gw; m < M; m += NGW) {
            const int t = m & (T - 1); const bool hp = t > 0;
            const bf16* pr = P + (size_t)m * NP; const bf16* pp = pr - NP;
            float wdv, adv;
            { const float c = bf2f(pr[C_WD + lane]), p = hp ? bf2f(pp[C_WD + lane]) : 0.f; wdv = c + mu[C_WD + lane] * (p - c); }
            { const float c = bf2f(pr[C_AD + lane]), p = hp ? bf2f(pp[C_AD + lane]) : 0.f; adv = c + mu[C_AD + lane] * (p - c); }
            const float tw = tanhf(wdv);
            float accw[8], acca[8];
#pragma unroll
            for (int e = 0; e < 8; ++e) { accw[e] = 0.f; acca[e] = 0.f; }
#pragma unroll 8
            for (int j = 0; j < 64; ++j) {
                const float sw = rdlane(tw, j), sa = rdlane(adv, j);
                const v4u wv = *(const LAS v4u*)(wup + j * 512 + c0), av = *(const LAS v4u*)(aup + j * 512 + c0);
                float wf[8], af[8]; unpack8(wv, wf); unpack8(av, af);
#pragma unroll
                for (int e = 0; e < 8; ++e) { accw[e] += sw * wf[e]; acca[e] += sa * af[e]; }
            }
            float kc[8], kp[8];
            { const v4u a = *(const v4u*)(pr + C_K + c0); unpack8(a, kc); if (hp) { const v4u b = *(const v4u*)(pp + C_K + c0); unpack8(b, kp); } else {
#pragma unroll
                for (int e = 0; e < 8; ++e) kp[e] = 0.f; } }
            float kkv[8], kav[8], bbv[8], wdo[8]; float ss = 0.f;
#pragma unroll
            for (int e = 0; e < 8; ++e) {
                const int c = c0 + e;
                const float k = kc[e] + mu[C_K + c] * (kp[e] - kc[e]);
                const float lw = w0[c] + accw[e];
                const float nx = -lw; const float sp = fmaxf(nx, 0.f) + log1pf(__expf(-fabsf(nx)));
                const float wlog = -sp - 0.5f;
                const float ew = __expf(wlog);
                wdo[e] = -expm1f(-ew);
                const float a = sigmf(a0[c] + acca[e]);
                kkv[e] = k * k_k[c]; ss += kkv[e] * kkv[e];
                kav[e] = k * (1.f + (a - 1.f) * k_a[c]);
                bbv[e] = a;
            }
            ss = sum8(ss);
            const float inv = 1.f / fmaxf(sqrtf(ss), 1e-12f);
#pragma unroll
            for (int e = 0; e < 8; ++e) { kkv[e] *= inv; bbv[e] *= kkv[e]; }
            *(v4u*)(KK + (size_t)m * 512 + c0) = pack8(kkv); *(v4u*)(KA + (size_t)m * 512 + c0) = pack8(kav);
            *(v4u*)(BB + (size_t)m * 512 + c0) = pack8(bbv); *(v4u*)(WDc + (size_t)m * 512 + c0) = pack8(wdo);
            if (lane < 16) { const int i = lane & 7; const int cb = (lane < 8) ? C_KS : C_KW; bf16* q = P + (size_t)m * NP + cb;
                const float x1 = bf2f(q[i]), x2 = bf2f(q[8 + i]); const float cs = ROPE[t * 16 + i], sn = ROPE[t * 16 + 8 + i];
                q[i] = (bf16)f2bf(x1 * cs - x2 * sn); q[8 + i] = (bf16)f2bf(x2 * cs + x1 * sn); }
        }
        for (int u = gw; u < NB * 512 * 2; u += NGW) {
            const int kv = u & 1, bc = u >> 1, b = bc >> 9, c = bc & 511;
            bf16* dst = (kv ? VCMP : KCMP) + (size_t)bc * 64;
            if (c >= NCMP) { dst[lane] = 0; continue; }
            const float* W1 = kv ? cv_w1 : ck_w1; const float* W2 = kv ? cv_w2 : ck_w2; const int col = kv ? C_VC : C_KC;
            float acc = 0.f;
            for (int l = 0; l < 32; ++l) {
                const float uval = bf2f(P[(size_t)(b * T + 16 * c + l) * NP + col + lane]) + cmp_pos[l * 64 + lane];
                const float* wr = W1 + (size_t)(l * 64) * 64 + lane;
#pragma unroll 16
                for (int d = 0; d < 64; ++d) acc += rdlane(uval, d) * wr[d * 64];
            }
            const float hv = siluf(acc);
            float o = 0.f;
#pragma unroll 16
            for (int n = 0; n < 64; ++n) o += rdlane(hv, n) * W2[n * 64 + lane];
            dst[lane] = (bf16)f2bf(o);
        }
        for (int u = gw; u < NB * MEML * 8; u += NGW) {
            const int r = u >> 3, cb = u & 7;
            float v[16]; float ss = 0.f;
#pragma unroll
            for (int i = 0; i < 16; ++i) { v[i] = mem[(size_t)r * D + 64 * i + lane]; ss += v[i] * v[i]; }
            ss = wave_sum(ss); const float rs = 1.0f / sqrtf(ss * (1.f / D) + 1e-6f);
#pragma unroll
            for (int i = 0; i < 16; ++i) v[i] *= rs * mem_norm_g[64 * i + lane];
            float acc = 0.f;
#pragma unroll
            for (int i = 0; i < 16; ++i) { const float* wr = w_mem_kv + (size_t)(64 * i) * 512 + cb * 64 + lane;
#pragma unroll 16
                for (int j = 0; j < 64; ++j) acc += rdlane(v[i], j) * wr[j * 512]; }
            MEMKV[(size_t)r * 512 + cb * 64 + lane] = (bf16)f2bf(acc);
        }
    }
    xcd_barrier(bar);

    if (!(PHASES & 8)) {} else if (wave == 0) {
        if (PHASES & 128) for (int u = bx; u < 256; u += G) {
            const int bh = u >> 3, rg = u & 7, b = bh >> 3, h = bh & 7;
            const int r = lane >> 3, q = lane & 7;
            const int vch = h * 64 + rg * 8 + r, kc0 = h * 64 + q * 8;
            float s[8], mur[8], prev_r[8];
#pragma unroll
            for (int e = 0; e < 8; ++e) { s[e] = 0.f; mur[e] = mu[C_R + kc0 + e]; prev_r[e] = 0.f; }
            const float muv = mu[C_V + vch]; float prev_v = 0.f;
            const size_t m0 = (size_t)b * T;
            v4u n_r = *(const v4u*)(P + m0 * NP + C_R + kc0); unsigned short n_v = P[m0 * NP + C_V + vch];
            v4u n_kk = *(const v4u*)(KK + m0 * 512 + kc0), n_ka = *(const v4u*)(KA + m0 * 512 + kc0), n_bb = *(const v4u*)(BB + m0 * 512 + kc0), n_wd = *(const v4u*)(WDc + m0 * 512 + kc0);
            for (int t = 0; t < T; ++t) {
                const size_t m = m0 + t;
                const v4u c_r = n_r, c_kk = n_kk, c_ka = n_ka, c_bb = n_bb, c_wd = n_wd; const unsigned short c_v = n_v;
                if (t + 1 < T) { const size_t mn = m + 1;
                    n_r = *(const v4u*)(P + mn * NP + C_R + kc0); n_v = P[mn * NP + C_V + vch];
                    n_kk = *(const v4u*)(KK + mn * 512 + kc0); n_ka = *(const v4u*)(KA + mn * 512 + kc0); n_bb = *(const v4u*)(BB + mn * 512 + kc0); n_wd = *(const v4u*)(WDc + mn * 512 + kc0); }
                float pr[8], kk[8], ka[8], bb[8], wd[8]; unpack8(c_r, pr); unpack8(c_kk, kk); unpack8(c_ka, ka); unpack8(c_bb, bb); unpack8(c_wd, wd);
                const float pv = bf2f(c_v); const float vv = pv + muv * (prev_v - pv); prev_v = pv;
                float sa = 0.f;
#pragma unroll
                for (int e = 0; e < 8; ++e) sa -= s[e] * kk[e];
                sa = sum8(sa);
                float y = 0.f;
#pragma unroll
                for (int e = 0; e < 8; ++e) { const float rr = pr[e] + mur[e] * (prev_r[e] - pr[e]); prev_r[e] = pr[e];
                    s[e] = s[e] * (1.f - wd[e]) + sa * bb[e] + vv * ka[e]; y += s[e] * rr; }
                y = sum8(y);
                if (q == 0) YR[m * 512 + vch] = y;
            }
        }
    }
    if (PHASES & 256) {
        for (int pr = vcu; pr < 256; pr += G)
#pragma unroll 1
            for (int half = 0; half < 2; ++half)
                nsa_unit(pr >> 6, half ? 127 - (pr & 63) : (pr & 63), lds, tid, wave, lane, P, KCMP, VCMP, GLOG, gate_b, nsa_out_g, ROPE, Y);
    }
    if (PHASES & 512) {
        for (int u = vcu; u < 256; u += G) {
            const int b = u >> 6; const size_t m0 = (size_t)b * T + 128 * (u & 63);
            Grp GM[1]; const LaneGeo L = make_geo(lane);
            SrcMem src{MEMKV, b}; BodyMem body{GM, L, P, Y, mem_out_g, m0 + 16 * wave + L.i16};
            at_ring<true>(lds, 16, tid, wave, src, body);
        }
    }
    xcd_barrier(bar);

    if (PHASES & 16) {
        const int c0 = lane * 8, h = lane >> 3;
        for (int m = gw; m < M; m += NGW) {
            const int t = m & (T - 1); const bool hp = t > 0;
            const bf16* pr = P + (size_t)m * NP; const bf16* pp = pr - NP;
            const f32x4 ya = *(const f32x4*)(YR + (size_t)m * 512 + c0), yb = *(const f32x4*)(YR + (size_t)m * 512 + c0 + 4);
            float y[8] = {ya.x, ya.y, ya.z, ya.w, yb.x, yb.y, yb.z, yb.w};
            float s = 0.f;
#pragma unroll
            for (int e = 0; e < 8; ++e) s += y[e];
            const float mean = sum8(s) * (1.f / 64.f);
            float q = 0.f;
#pragma unroll
            for (int e = 0; e < 8; ++e) { y[e] -= mean; q += y[e] * y[e]; }
            const float rstd = 1.0f / sqrtf(sum8(q) * (1.f / 64.f) + 64e-5f);
            float rc[8], rp[8], vc[8], vp[8], gc[8], gp[8], ka[8];
            unpack8(*(const v4u*)(pr + C_R + c0), rc); unpack8(*(const v4u*)(pr + C_V + c0), vc); unpack8(*(const v4u*)(pr + C_G + c0), gc);
            if (hp) { unpack8(*(const v4u*)(pp + C_R + c0), rp); unpack8(*(const v4u*)(pp + C_V + c0), vp); unpack8(*(const v4u*)(pp + C_G + c0), gp); }
            else {
#pragma unroll
                for (int e = 0; e < 8; ++e) { rp[e] = 0.f; vp[e] = 0.f; gp[e] = 0.f; } }
            unpack8(*(const v4u*)(KA + (size_t)m * 512 + c0), ka);
            float bon = 0.f; float vv[8], gg[8];
#pragma unroll
            for (int e = 0; e < 8; ++e) { const int c = c0 + e;
                const float r = rc[e] + mu[C_R + c] * (rp[e] - rc[e]); vv[e] = vc[e] + mu[C_V + c] * (vp[e] - vc[e]); gg[e] = gc[e] + mu[C_G + c] * (gp[e] - gc[e]);
                bon += r * ka[e] * r_k[h * 64 + (c & 63)]; }
            bon = sum8(bon);
            float o[8];
#pragma unroll
            for (int e = 0; e < 8; ++e) { const int c = c0 + e; o[e] = (y[e] * rstd * ln_w[c] + ln_b[c] + bon * vv[e]) * siluf(gg[e]); }
            *(v4u*)(Y + (size_t)m * D + c0) = pack8(o);
        }
    }
    xcd_barrier(bar);

    if (PHASES & 32) {
        pg8::Gemm g{Y, WT_OUT, M, D, D}; pg8::StaticOrder S; S.init(M, D, G, bx);
        pg8::EpiResF32 E{x, out, D};
        pg8::gemm_phase<pg8::EpiResF32, pg8::StaticOrder, true, true>(lds, g, S, E);
    }
    xcd_barrier(bar);

    if (PHASES & 64) for (int m = gw; m < M; m += NGW) {
        f32x4* xr = (f32x4*)(out + (size_t)m * D) + lane;
        f32x4 v[4]; float ss = 0.f;
#pragma unroll
        for (int j = 0; j < 4; ++j) { v[j] = xr[64 * j]; ss += (v[j].x * v[j].x + v[j].y * v[j].y) + (v[j].z * v[j].z + v[j].w * v[j].w); }
        ss = wave_sum(ss);
        const float rs = 1.0f / sqrtf(ss * (1.f / D) + 1e-6f);
#pragma unroll
        for (int j = 0; j < 4; ++j) { const f32x4 g = *((const f32x4*)norm_final_g + 64 * j + lane); xr[64 * j] = v[j] * rs * g; }
    }
}

extern "C" void kernel_launch(void* const* d_in, const int* in_sizes, int n_in, void* d_out, int out_size, void* d_ws, size_t ws_size, hipStream_t stream) {
    static int grid = 0;
    if (grid == 0) {
        if (n_in != 26 || in_sizes[0] != M * D || out_size != M * D || ws_size < WS_END) { fprintf(stderr, "kernel_launch: unexpected shapes (n_in %d, in0 %d, out %d, ws %zu); nothing launched\n", n_in, n_in > 0 ? in_sizes[0] : -1, out_size, ws_size); grid = -1; return; }
        int dev = 0, cus = 0;
        if (hipGetDevice(&dev) != hipSuccess || hipDeviceGetAttribute(&cus, hipDeviceAttributeMultiprocessorCount, dev) != hipSuccess) { grid = -1; return; }
        if (hipFuncSetAttribute((const void*)hymba_fwd, hipFuncAttributeMaxDynamicSharedMemorySize, LDS_BYTES) != hipSuccess) { fprintf(stderr, "kernel_launch: hipFuncSetAttribute failed\n"); grid = -1; return; }
        (void)hipGetLastError();
        grid = cus;
    }
    if (grid < 0) return;
    (void)hipMemsetAsync((char*)d_ws + WS_CTL, 0, CTL_ZERO_BYTES, stream);
    Args a{};
    for (int i = 0; i < 26; ++i) a.in[i] = (const float*)d_in[i];
    a.out = (float*)d_out; a.ws = (unsigned char*)d_ws;
    hipLaunchKernelGGL(hymba_fwd, dim3(grid), dim3(NWAVES * 64), LDS_BYTES, stream, a);
}
```

```cpp
#include <hip/hip_runtime.h>
#include <cstdio>
#include <cstdint>
namespace pg8 {
#define PG8_LAS __attribute__((address_space(3)))
typedef unsigned short bf16_t;
typedef short bf16x8 __attribute__((ext_vector_type(8)));
typedef float f32x4 __attribute__((ext_vector_type(4)));
typedef unsigned u32x4 __attribute__((ext_vector_type(4)));
constexpr int BM = 256, BK = 64, HALF = 128, HTB = HALF * BK * 2  , STAGE_BYTES = 8 * HTB, NXCD = 8, WGM = 8;

__host__ __device__ __forceinline__ int lds_byte(int r, int c) { const int st = (r >> 4) * 2 + (c >> 5), rr = r & 15, cc = c & 31, ob = rr * 64 + cc * 2; return st * 1024 + (ob ^ (((ob >> 9) & 1) << 5)); }
__host__ __device__ __forceinline__ void stage_rc(int b, int& R, int& C) { const int st = b / 1024, sb = b % 1024, swz = sb ^ (((sb >> 9) & 1) << 5); R = (st >> 1) * 16 + swz / 64; C = (st & 1) * 32 + (swz % 64) / 2; }
__host__ __device__ __forceinline__ int perm32(int rho) { const int n = rho >> 4, i = rho & 15; return 8 * (i >> 2) + 4 * n + (i & 3); }

struct Unit { int pm, pn; };
struct Gemm { const bf16_t* A; const bf16_t* Bt; int M, N, K; };

struct StaticOrder {
    int nM, nN, nwg, G, c;
    __host__ __device__ void init(int M, int N, int G_, int c_) { nM = M / BM; nN = N / BM; nwg = nM * nN; G = G_; c = c_; }
    __host__ __device__ bool next(int i, Unit& u) const {
        const long L = (long)i * G + c; if (L >= nwg) return false;
        int wgid = (int)L; { const int q = nwg / NXCD, r = nwg % NXCD, xcd = wgid % NXCD, off = wgid / NXCD; wgid = (xcd < r ? xcd * (q + 1) : r * (q + 1) + (xcd - r) * q) + off; }
        const int nig = WGM * nN, gid = wgid / nig, fm = gid * WGM, gsz = (nM - fm) < WGM ? (nM - fm) : WGM;
        u.pm = fm + ((wgid % nig) % gsz); u.pn = (wgid % nig) / gsz; return true;
    }
    __device__ __forceinline__ void a_ready(const Unit&) const {}
    __device__ __forceinline__ void done(const Unit&) const {}
};

__device__ __forceinline__ unsigned cvt_pk_bf16(float lo, float hi) { unsigned r; asm volatile("v_cvt_pk_bf16_f32 %0, %1, %2" : "=v"(r) : "v"(lo), "v"(hi)); return r; }

template <class Epi, class Sched, bool ALIGN_EPI = false, bool SP2 = false>
__device__ __forceinline__ void gemm_phase(PG8_LAS unsigned char* lds, const Gemm g, const Sched& S, const Epi& E) {
    int tid_o = threadIdx.x; asm volatile("" : "+v"(tid_o));
    const int tid = tid_o, wid = __builtin_amdgcn_readfirstlane(tid >> 6), lane = tid & 63, wr = wid >> 2, wc = wid & 3, fr = lane & 15, fq = lane >> 4;
    const int K = g.K, nt = K / BK;
    unsigned voffA[2], voffB[2];
#pragma unroll
    for (int i = 0; i < 2; ++i) { int R, C; stage_rc(tid * 16 + i * 8192, R, C); const int Rb = Epi::PERM ? ((R & ~31) + perm32(R & 31)) : R;
        voffA[i] = (unsigned)(R * K + C) * 2u; voffB[i] = (unsigned)(Rb * K + C) * 2u; }
    const size_t kstep = (size_t)(BK * 2);
    const size_t hstep = (size_t)HALF * K * 2;
    const size_t tstep = 2 * hstep;
    const unsigned ldsw = (unsigned)wid * 1024u;
    const int aoff = lds_byte(wr * 64 + fr, fq * 8), boff = lds_byte(wc * 32 + fr, fq * 8);
#define PG8_SA(b, h) (((b) * 2 + (h)) * HTB)
#define PG8_SB(b, h) ((4 + (b) * 2 + (h)) * HTB)
#define PG8_STAGE(bufoff, gbase, voff) do { _Pragma("unroll") for (int _i = 0; _i < 2; ++_i) \
        __builtin_amdgcn_global_load_lds((const unsigned*)((const char*)(gbase) + (voff)[_i]), (PG8_LAS unsigned*)(lds + (bufoff) + ldsw + _i * 8192), 16, 0, 0); } while (0)
#define PG8_LDA(dst, b, h) do { _Pragma("unroll") for (int m = 0; m < 4; ++m) _Pragma("unroll") for (int k = 0; k < 2; ++k) dst[m][k] = *(const PG8_LAS bf16x8*)(lds + PG8_SA(b, h) + aoff + m * 2048 + k * 1024); } while (0)
#define PG8_LDB(dst, b, h) do { _Pragma("unroll") for (int n = 0; n < 2; ++n) _Pragma("unroll") for (int k = 0; k < 2; ++k) dst[n][k] = *(const PG8_LAS bf16x8*)(lds + PG8_SB(b, h) + boff + n * 2048 + k * 1024); } while (0)
#define PG8_MMA(ai, bj, At, Bt) do { __builtin_amdgcn_s_setprio(1); _Pragma("unroll") for (int m = 0; m < 4; ++m) _Pragma("unroll") for (int n = 0; n < 2; ++n) _Pragma("unroll") for (int k = 0; k < 2; ++k) \
        acc[ai][bj][m][n] = __builtin_amdgcn_mfma_f32_16x16x32_bf16(Bt[n][k], At[m][k], acc[ai][bj][m][n], 0, 0, 0); __builtin_amdgcn_s_setprio(0); } while (0)
#define PG8_WAIT_V(n) asm volatile("s_waitcnt vmcnt(" #n ")" ::: "memory")
#define PG8_WAIT_L(n) asm volatile("s_waitcnt lgkmcnt(" #n ")" ::: "memory")
#define PG8_BAR __builtin_amdgcn_s_barrier()
#define PG8_SCHED __builtin_amdgcn_sched_barrier(0)
    Unit cur, nxt; int ui = 0;
    if (!S.next(0, cur)) return;
    f32x4 acc[2][2][4][2];
#pragma unroll
    for (int a = 0; a < 2; ++a)
#pragma unroll
        for (int b = 0; b < 2; ++b)
#pragma unroll
            for (int m = 0; m < 4; ++m)
#pragma unroll
                for (int n = 0; n < 2; ++n) acc[a][b][m][n] = (f32x4){0.f, 0.f, 0.f, 0.f};
    bf16x8 At[4][2], B0[2][2], B1[2][2];
    const char* cA = (const char*)g.A + (size_t)cur.pm * tstep; const char* cB = (const char*)g.Bt + (size_t)cur.pn * tstep;
    S.a_ready(cur);
    if constexpr (SP2) {
        PG8_STAGE(PG8_SB(0, 0), cB, voffB); PG8_STAGE(PG8_SB(0, 1), cB + hstep, voffB); PG8_STAGE(PG8_SA(0, 0), cA, voffA); PG8_STAGE(PG8_SA(0, 1), cA + hstep, voffA);
        if (wr == 1) PG8_BAR;
        PG8_WAIT_V(2); PG8_BAR;
        PG8_STAGE(PG8_SB(1, 0), cB + kstep, voffB); PG8_STAGE(PG8_SA(1, 0), cA + kstep, voffA); PG8_STAGE(PG8_SB(1, 1), cB + hstep + kstep, voffB);
        PG8_WAIT_V(6); PG8_BAR;
    } else {
        PG8_STAGE(PG8_SB(0, 0), cB, voffB); PG8_STAGE(PG8_SA(0, 0), cA, voffA); PG8_STAGE(PG8_SB(0, 1), cB + hstep, voffB); PG8_STAGE(PG8_SA(0, 1), cA + hstep, voffA);
        if (wr == 1) PG8_BAR;
        PG8_WAIT_V(4); PG8_BAR;
        PG8_STAGE(PG8_SB(1, 0), cB + kstep, voffB); PG8_STAGE(PG8_SA(1, 0), cA + kstep, voffA); PG8_STAGE(PG8_SB(1, 1), cB + hstep + kstep, voffB);
        PG8_WAIT_V(6); PG8_BAR;
    }
    for (;;) {
        const bool has_next = S.next(ui + 1, nxt);
        const char* nA = has_next ? (const char*)g.A + (size_t)nxt.pm * tstep : cA; const char* nB = has_next ? (const char*)g.Bt + (size_t)nxt.pn * tstep : cB;
        for (int t = 0; t < nt; t += 2) {
            const bool last = (t == nt - 2);
            const char* a1 = cA + (size_t)(t + 1) * kstep;
            const char* a2 = last ? nA : cA + (size_t)(t + 2) * kstep; const char* b2 = last ? nB : cB + (size_t)(t + 2) * kstep;
            const char* a3 = a2 + kstep; const char* b3 = b2 + kstep;
            if (last && has_next) S.a_ready(nxt);
            if constexpr (SP2) {
            PG8_LDB(B0, 0, 0); PG8_LDB(B1, 0, 1); PG8_SCHED; PG8_LDA(At, 0, 0); PG8_STAGE(PG8_SA(1, 1), a1 + hstep, voffA);
            PG8_WAIT_V(8); PG8_WAIT_L(0); PG8_BAR; PG8_MMA(0, 0, At, B0); PG8_MMA(0, 1, At, B1); PG8_BAR; PG8_SCHED;
            PG8_LDA(At, 0, 1); PG8_STAGE(PG8_SB(0, 0), b2, voffB); PG8_STAGE(PG8_SB(0, 1), b2 + hstep, voffB); PG8_STAGE(PG8_SA(0, 0), a2, voffA);
            PG8_WAIT_V(8); PG8_WAIT_L(0); PG8_BAR; PG8_MMA(1, 0, At, B0); PG8_MMA(1, 1, At, B1); PG8_BAR; PG8_SCHED;
            PG8_LDB(B0, 1, 0); PG8_LDB(B1, 1, 1); PG8_SCHED; PG8_LDA(At, 1, 0); PG8_STAGE(PG8_SA(0, 1), a2 + hstep, voffA);
            PG8_WAIT_V(8); PG8_WAIT_L(0); PG8_BAR; PG8_MMA(0, 0, At, B0); PG8_MMA(0, 1, At, B1); PG8_BAR; PG8_SCHED;
            PG8_LDA(At, 1, 1); PG8_STAGE(PG8_SB(1, 0), b3, voffB); PG8_STAGE(PG8_SB(1, 1), b3 + hstep, voffB); PG8_STAGE(PG8_SA(1, 0), a3, voffA);
            PG8_WAIT_V(8); PG8_WAIT_L(0); PG8_BAR; PG8_MMA(1, 0, At, B0); PG8_MMA(1, 1, At, B1); PG8_BAR; PG8_SCHED;
            } else {
            PG8_LDB(B0, 0, 0); PG8_SCHED; PG8_LDA(At, 0, 0); PG8_STAGE(PG8_SA(1, 1), a1 + hstep, voffA);
            PG8_WAIT_L(8); PG8_BAR; PG8_WAIT_L(0); PG8_MMA(0, 0, At, B0); PG8_BAR; PG8_SCHED;
            PG8_LDB(B1, 0, 1); PG8_STAGE(PG8_SB(0, 0), b2, voffB);
            PG8_BAR; PG8_WAIT_L(0); PG8_MMA(0, 1, At, B1); PG8_BAR;
            PG8_LDA(At, 0, 1); PG8_STAGE(PG8_SA(0, 0), a2, voffA);
            PG8_BAR; PG8_WAIT_L(0); PG8_MMA(1, 0, At, B0); PG8_BAR; PG8_SCHED;
            PG8_STAGE(PG8_SB(0, 1), b2 + hstep, voffB);
            PG8_WAIT_V(6); PG8_BAR; PG8_MMA(1, 1, At, B1); PG8_BAR;
            PG8_LDB(B0, 1, 0); PG8_SCHED; PG8_LDA(At, 1, 0); PG8_STAGE(PG8_SA(0, 1), a2 + hstep, voffA);
            PG8_WAIT_L(8); PG8_BAR; PG8_WAIT_L(0); PG8_MMA(0, 0, At, B0); PG8_BAR; PG8_SCHED;
            PG8_LDB(B1, 1, 1); PG8_STAGE(PG8_SB(1, 0), b3, voffB);
            PG8_BAR; PG8_WAIT_L(0); PG8_MMA(0, 1, At, B1); PG8_BAR;
            PG8_LDA(At, 1, 1); PG8_STAGE(PG8_SA(1, 0), a3, voffA);
            PG8_BAR; PG8_WAIT_L(0); PG8_MMA(1, 0, At, B0); PG8_BAR; PG8_SCHED;
            PG8_STAGE(PG8_SB(1, 1), b3 + hstep, voffB);
            PG8_WAIT_V(6); PG8_BAR; PG8_MMA(1, 1, At, B1); PG8_BAR;
            }
        }
        if constexpr (ALIGN_EPI) { if (wr == 0) PG8_BAR; }
        if constexpr (!Epi::AFTER_DRAIN) { E(acc, cur, wr, wc, fr, fq); S.done(cur); }
        if (!has_next) break;
#pragma unroll
        for (int a = 0; a < 2; ++a)
#pragma unroll
            for (int b = 0; b < 2; ++b)
#pragma unroll
                for (int m = 0; m < 4; ++m)
#pragma unroll
                    for (int n = 0; n < 2; ++n) acc[a][b][m][n] = (f32x4){0.f, 0.f, 0.f, 0.f};
        cur = nxt; cA = nA; cB = nB; ++ui;
        if constexpr (ALIGN_EPI) { if (wr == 1) PG8_BAR; }
    }
    PG8_WAIT_V(0);
    if constexpr (!ALIGN_EPI) { if (wr == 0) PG8_BAR; }
    PG8_BAR;
    if constexpr (Epi::AFTER_DRAIN) { E.fused(acc, cur, wr, wc, fr, fq, lds, wid, lane); S.done(cur); }
#undef PG8_SA
#undef PG8_SB
#undef PG8_STAGE
#undef PG8_LDA
#undef PG8_LDB
#undef PG8_MMA
#undef PG8_WAIT_V
#undef PG8_WAIT_L
#undef PG8_BAR
#undef PG8_SCHED
}
}
namespace pg8 {
struct EpiRowScaleBf16 {
    static constexpr bool PERM = true, AFTER_DRAIN = false;
    bf16_t* O; int ldc; const float* rs;
    __device__ __forceinline__ void operator()(const f32x4 (&acc)[2][2][4][2], const Unit& u, int wr, int wc, int fr, int fq) const {
        const int row0 = u.pm * BM + wr * 64 + fr; const int col0 = u.pn * BM + wc * 32 + 8 * fq;
#pragma unroll
        for (int ai = 0; ai < 2; ++ai)
#pragma unroll
            for (int m = 0; m < 4; ++m) { const int row = row0 + ai * HALF + m * 16; const float sc = rs[row]; bf16_t* rowp = O + (size_t)row * ldc + col0;
#pragma unroll
                for (int bj = 0; bj < 2; ++bj) { f32x4 v0 = acc[ai][bj][m][0] * sc, v1 = acc[ai][bj][m][1] * sc;
                    u32x4 w; w.x = cvt_pk_bf16(v0[0], v0[1]); w.y = cvt_pk_bf16(v0[2], v0[3]); w.z = cvt_pk_bf16(v1[0], v1[1]); w.w = cvt_pk_bf16(v1[2], v1[3]);
                    *(u32x4*)(rowp + bj * HALF) = w; } }
    }
};
struct EpiResF32 {
    static constexpr bool PERM = false, AFTER_DRAIN = false;
    const float* base; float* out; int ldc;
    __device__ __forceinline__ void operator()(const f32x4 (&acc)[2][2][4][2], const Unit& u, int wr, int wc, int fr, int fq) const {
        const int col0 = u.pn * BM + wc * 32 + 4 * fq;
#pragma unroll
        for (int ai = 0; ai < 2; ++ai)
#pragma unroll
            for (int m = 0; m < 4; ++m) { const int r = u.pm * BM + ai * HALF + wr * 64 + m * 16 + fr; const size_t off = (size_t)r * ldc + col0;
#pragma unroll
                for (int bj = 0; bj < 2; ++bj)
#pragma unroll
                    for (int n = 0; n < 2; ++n) { const f32x4 bs = *(const f32x4*)(base + off + bj * HALF + n * 16); *(f32x4*)(out + off + bj * HALF + n * 16) = bs + acc[ai][bj][m][n]; } }
    }
};
}

constexpr int NB = 4, T = 8192, D = 1024, M = NB * T;
constexpr int NP = 3584;
constexpr int W_IN_COLS = 3596;
constexpr int C_R = 0, C_K = 512, C_V = 1024, C_G = 1536, C_WD = 2048, C_AD = 2112, C_NQ = 2176, C_NG = 2432, C_KC = 2688, C_VC = 2752,
              C_KS = 2816, C_VS = 2880, C_KW = 2944, C_VW = 3008, C_MQ = 3072, C_MG = 3328;
constexpr int GLOG_SRC = 2688;
constexpr int NCMP = 511, NSEL = 128, MEML = 256;

constexpr size_t MiB = 1u << 20;
constexpr size_t WS_CTL = 0, CTL_ZERO_BYTES = 1 * MiB;
constexpr size_t WS_WIN = 1 * MiB, WS_WOUT = 8 * MiB;
constexpr size_t WS_ROPE = 10 * MiB, WS_RS = 10 * MiB + 512 * 1024, WS_KCMP = 11 * MiB, WS_VCMP = 11 * MiB + 512 * 1024, WS_MEMKV = 12 * MiB, WS_GLOG = 14 * MiB;
constexpr size_t WS_P = 16 * MiB, WS_XB = 240 * MiB, WS_CHK_PR = 240 * MiB, WS_Y = 304 * MiB, WS_A = 368 * MiB, WS_CHK_S = 368 * MiB, WS_LW = 400 * MiB, WS_CHK_QY = 432 * MiB, WS_BONUS = 496 * MiB, WS_END = 497 * MiB;
constexpr int CW_BAR = 4096;

constexpr int RING_BYTES = 131072, LDSCTL_OFF = RING_BYTES, MISC_OFF = LDSCTL_OFF + 320, LDS_BYTES = 147456;
constexpr int NWAVES = 8;

#define GAS __attribute__((address_space(1)))
#define LAS __attribute__((address_space(3)))
typedef unsigned short bf16;
typedef unsigned v4u __attribute__((ext_vector_type(4)));
typedef unsigned v2u __attribute__((ext_vector_type(2)));
typedef float f32x4 __attribute__((ext_vector_type(4)));
#define LDS_WAIT() asm volatile("s_waitcnt lgkmcnt(0)" ::: "memory")
__device__ __forceinline__ unsigned f2bf(float f) { unsigned u = __builtin_bit_cast(unsigned, f); return (u + 0x7fffu + ((u >> 16) & 1u)) >> 16; }
__device__ __forceinline__ unsigned pk2(float lo, float hi) { return f2bf(lo) | (f2bf(hi) << 16); }
__device__ __forceinline__ float bf2f(unsigned short h) { return __builtin_bit_cast(float, (unsigned)h << 16); }
__device__ __forceinline__ float bflo(unsigned u) { return __builtin_bit_cast(float, u << 16); }
__device__ __forceinline__ float bfhi(unsigned u) { return __builtin_bit_cast(float, u & 0xffff0000u); }
__device__ __forceinline__ void unpack8(const v4u v, float (&f)[8]) { f[0] = bflo(v.x); f[1] = bfhi(v.x); f[2] = bflo(v.y); f[3] = bfhi(v.y); f[4] = bflo(v.z); f[5] = bfhi(v.z); f[6] = bflo(v.w); f[7] = bfhi(v.w); }
__device__ __forceinline__ v4u pack8(const float (&f)[8]) { v4u o; o.x = pk2(f[0], f[1]); o.y = pk2(f[2], f[3]); o.z = pk2(f[4], f[5]); o.w = pk2(f[6], f[7]); return o; }
__device__ __forceinline__ float rdlane(float v, int l) { return __builtin_bit_cast(float, __builtin_amdgcn_readlane(__builtin_bit_cast(int, v), l)); }
template <int CTRL> __device__ __forceinline__ float dppf(float v) { return __builtin_bit_cast(float, __builtin_amdgcn_update_dpp(0, __builtin_bit_cast(int, v), CTRL, 0xf, 0xf, true)); }
__device__ __forceinline__ float sum8(float x) { x += dppf<0xB1>(x); x += dppf<0x4E>(x); x += dppf<0x141>(x); return x; }
__device__ __forceinline__ float wave_sum(float v) {
#pragma unroll
    for (int o = 1; o < 64; o <<= 1) v += __shfl_xor(v, o);
    return v;
}
__device__ __forceinline__ float wave_max(float v) {
#pragma unroll
    for (int o = 1; o < 64; o <<= 1) v = fmaxf(v, __shfl_xor(v, o));
    return v;
}
__device__ __forceinline__ float siluf(float x) { return x / (1.f + __expf(-x)); }
__device__ __forceinline__ float sigmf(float x) { return 1.f / (1.f + __expf(-x)); }

#define XB_TMO      128
#define XB_XCNT(j)  (256  + 64 * (j))
#define XB_XSUB(j)  (1280 + 64 * (j))
#define XB_XGEN(j)  (2304 + 64 * (j))
#define XB_TOP      3328
#define XB_TOPGEN   3392
#define XCD_BAR_WORDS 3456
#define XB_SPIN_CAP (1u << 20)
__device__ __forceinline__ unsigned xb_ld(unsigned* p)              { return __hip_atomic_load(p, __ATOMIC_RELAXED, __HIP_MEMORY_SCOPE_AGENT); }
__device__ __forceinline__ unsigned xb_add(unsigned* p, unsigned v) { return __hip_atomic_fetch_add(p, v, __ATOMIC_RELAXED, __HIP_MEMORY_SCOPE_AGENT); }
__device__ __forceinline__ unsigned xb_xcc_id() { return (unsigned)__builtin_amdgcn_s_getreg((3 << 11) | 20) & 0xFu; }
#define XB_SPIN(cond, bar) do { unsigned _sp = 0; while (cond) { __builtin_amdgcn_s_sleep(1); \
    if ((++_sp & 255u) == 0u) { if (xb_ld(&(bar)[XB_TMO])) break; if (_sp > XB_SPIN_CAP) { atomicAdd(&(bar)[XB_TMO], 1u); break; } } } } while (0)
struct XcdBarrier { unsigned* bar; unsigned x; volatile LAS unsigned* st; };
__device__ __forceinline__ XcdBarrier xcd_barrier_post(unsigned* bar, volatile LAS unsigned* st) {
    XcdBarrier b; b.bar = bar; b.x = xb_xcc_id(); b.st = st;
    if (threadIdx.x == 0) (void)xb_add(&bar[XB_XCNT(b.x)], 1u);
    return b;
}
__device__ __forceinline__ void xcd_barrier_complete(unsigned* bar, unsigned x, unsigned& nloc, unsigned& nx) {
    const unsigned G = gridDim.x * gridDim.y * gridDim.z;
    unsigned sum, cnt, mine, sp = 0u;
    for (;;) {
        sum = 0u; cnt = 0u; mine = 0u;
#pragma unroll
        for (unsigned j = 0; j < 16; ++j) { const unsigned c = xb_ld(&bar[XB_XCNT(j)]); sum += c; cnt += (c > 0u) ? 1u : 0u; mine = (j == x) ? c : mine; }
        if (sum == G) break;
        __builtin_amdgcn_s_sleep(1);
        if ((++sp & 255u) == 0u) { if (xb_ld(&bar[XB_TMO])) break; if (sp > XB_SPIN_CAP) { atomicAdd(&bar[XB_TMO], 1u); break; } }
    }
    nloc = mine > 0u ? mine : 1u; nx = cnt > 0u ? cnt : 1u;
}
__device__ __forceinline__ void xcd_barrier(const XcdBarrier& b) {
    asm volatile("s_waitcnt vmcnt(0)" ::: "memory");
    __syncthreads();
    if (threadIdx.x == 0) {
        unsigned* bar = b.bar;
        __builtin_amdgcn_s_waitcnt(0);
        unsigned nloc = b.st[0], nx = b.st[1];
        if (nloc == 0u) { xcd_barrier_complete(bar, b.x, nloc, nx); b.st[0] = nloc; b.st[1] = nx; }
        const unsigned old = xb_add(&bar[XB_XSUB(b.x)], 1u);
        const unsigned gen = old / nloc;
        if (old + 1u == (gen + 1u) * nloc) {
            __builtin_amdgcn_fence(__ATOMIC_RELEASE, "agent");
            asm volatile("s_waitcnt vmcnt(0)" ::: "memory");
            const unsigned og = xb_add(&bar[XB_TOP], 1u);
            const unsigned tg = og / nx;
            if (og + 1u == (tg + 1u) * nx) xb_add(&bar[XB_TOPGEN], 1u);
            else XB_SPIN(xb_ld(&bar[XB_TOPGEN]) == tg, bar);
            __builtin_amdgcn_fence(__ATOMIC_ACQUIRE, "agent");
            xb_add(&bar[XB_XGEN(b.x)], 1u);
            asm volatile("s_waitcnt vmcnt(0)" ::: "memory");
        } else {
            XB_SPIN(xb_ld(&bar[XB_XGEN(b.x)]) == gen, bar);
            __builtin_amdgcn_fence(__ATOMIC_ACQUIRE, "agent");
            asm volatile("s_waitcnt vmcnt(0)" ::: "memory");
        }
    }
    __syncthreads();
}

struct Args { const float* in[26]; float* out; unsigned char* ws; };

__device__ __forceinline__ void p0_transpose_item(const float* W, int ldw, int src_col0, const float* kscale, bf16* WT, int K, int dst_row0, int k0, LAS float* scr, int lane) {
#pragma unroll 8
    for (int i = 0; i < 32; ++i) { const int kk = 2 * i + (lane >> 5); float v = W[(size_t)(k0 + kk) * ldw + src_col0 + (lane & 31)]; if (kscale) v *= kscale[k0 + kk]; scr[kk * 33 + (lane & 31)] = v; }
    LDS_WAIT(); asm volatile("" ::: "memory");
    const int c = lane & 7;
#pragma unroll
    for (int j = 0; j < 4; ++j) { const int n = (lane >> 3) + 8 * j; const LAS float* s = scr + (8 * c) * 33 + n;
        v4u o; o.x = pk2(s[0 * 33], s[1 * 33]); o.y = pk2(s[2 * 33], s[3 * 33]); o.z = pk2(s[4 * 33], s[5 * 33]); o.w = pk2(s[6 * 33], s[7 * 33]);
        *(v4u*)(WT + (size_t)(dst_row0 + n) * K + k0 + 8 * c) = o; }
    LDS_WAIT(); asm volatile("" ::: "memory");
}
__device__ __forceinline__ double rope_inv_freq(int i) {
    return i == 0 ? 1.0 : i == 1 ? 0.19392274474868576 : i == 2 ? 0.03760603093086393 : i == 3 ? 0.007292664737217109 : i == 4 ? 0.001414213562373095 :
           i == 5 ? 0.0002742481756762073 : i == 6 ? 5.318295896944988e-05 : 1.031338537721246e-05;
}
__device__ __forceinline__ void rope_cs(int pos, int i, float& c, float& s) {
    const double ang = (double)pos * rope_inv_freq(i);
    const double n = __builtin_rint(ang * 0.15915494309189535);
    const double r = __builtin_fma(-n, 6.283185307179586, ang);
    const double kq = __builtin_rint(r * 0.6366197723675814);
    const double y = __builtin_fma(-kq, 1.5707963267948966, r);
    const double y2 = y * y;
    const double sy = y * (1.0 + y2 * (-1.0 / 6 + y2 * (1.0 / 120 + y2 * (-1.0 / 5040 + y2 * (1.0 / 362880 - y2 * (1.0 / 39916800))))));
    const double cy = 1.0 + y2 * (-0.5 + y2 * (1.0 / 24 + y2 * (-1.0 / 720 + y2 * (1.0 / 40320 + y2 * (-1.0 / 3628800 + y2 * (1.0 / 479001600))))));
    const int q = ((int)kq) & 3;
    const double cc = q == 0 ? cy : q == 1 ? -sy : q == 2 ? -cy : sy;
    const double ss = q == 0 ? sy : q == 1 ? cy : q == 2 ? -sy : -cy;
    c = (float)cc; s = (float)ss;
}

typedef short bf16x8 __attribute__((ext_vector_type(8)));
typedef short v4i16 __attribute__((ext_vector_type(4)));
#define MFMA16(a, b, c) __builtin_amdgcn_mfma_f32_16x16x32_bf16(a, b, c, 0, 0, 0)
constexpr int AT_SLOT = 16384, AT_RING = 3 * AT_SLOT, AT_IMP = AT_RING, AT_IMP_W = 8448, AT_SELM = AT_IMP + 8 * AT_IMP_W, AT_TILEM = AT_SELM + 1024, AT_LIST = AT_TILEM + 16, AT_NB = AT_LIST + 544;
constexpr float SM_C = 0.125f * 1.4426950408889634f;
#define AT_WAITBAR(N) asm volatile("s_waitcnt vmcnt(" #N ") lgkmcnt(0)\n\ts_barrier" ::: "memory")

struct Grp { bf16x8 q[2]; f32x4 o[4]; float m, l; };

__device__ __forceinline__ void at_dma(const bf16* kb, size_t kpitch, const bf16* vb, size_t vpitch, LAS unsigned char* slot, int tid, int wave, bool withV) {
    const int r = tid >> 3, c = (tid & 7) ^ (2 * ((r >> 1) & 3));
    __builtin_amdgcn_global_load_lds((const unsigned*)(kb + (size_t)r * kpitch + c * 8), (LAS unsigned*)(slot + wave * 1024), 16, 0, 0);
    if (withV) __builtin_amdgcn_global_load_lds((const unsigned*)(vb + (size_t)r * vpitch + c * 8), (LAS unsigned*)(slot + 8192 + wave * 1024), 16, 0, 0);
}
__device__ __forceinline__ unsigned cvtpk(float lo, float hi) { typedef float f2 __attribute__((ext_vector_type(2))); typedef __bf16 b2 __attribute__((ext_vector_type(2))); f2 v = {lo, hi}; b2 b = __builtin_convertvector(v, b2); return __builtin_bit_cast(unsigned, b); }
__device__ __forceinline__ float fmax3(float a, float b, float c) { return fmaxf(fmaxf(a, b), c); }

template <int NG, int MODE>
__device__ __forceinline__ void at_block(Grp (&G)[NG], LAS const unsigned char* slot, int koff0, int koff1, const int (&vdt)[4], int g, const int (&lo)[NG], const int (&hi)[NG], const bool (&need)[NG], bool partial,
                                         LAS float* impA, LAS float* impB, int sb0, int lane) {
    bf16x8 kf[4][2];
#pragma unroll
    for (int kt = 0; kt < 4; ++kt) { kf[kt][0] = *(const LAS bf16x8*)(slot + kt * 2048 + koff0); kf[kt][1] = *(const LAS bf16x8*)(slot + kt * 2048 + koff1); }
    bf16x8 pf[NG][2];
#pragma unroll
    for (int gi = 0; gi < NG; ++gi) {
        if (!need[gi]) continue;
        f32x4 s[4];
#pragma unroll
        for (int kt = 0; kt < 4; ++kt) { s[kt] = (f32x4){0.f, 0.f, 0.f, 0.f}; s[kt] = MFMA16(kf[kt][0], G[gi].q[0], s[kt]); s[kt] = MFMA16(kf[kt][1], G[gi].q[1], s[kt]); }
        if (partial) {
#pragma unroll
            for (int kt = 0; kt < 4; ++kt)
#pragma unroll
                for (int r = 0; r < 4; ++r) { const int kl = 16 * kt + 4 * g + r; if (kl < lo[gi] || kl > hi[gi]) s[kt][r] = -INFINITY; }
        }
        float mref;
        if (MODE != 1) {
            float mx = fmax3(s[0][0], s[0][1], s[0][2]); mx = fmax3(mx, s[0][3], s[1][0]); mx = fmax3(mx, s[1][1], s[1][2]); mx = fmax3(mx, s[1][3], s[2][0]);
            mx = fmax3(mx, s[2][1], s[2][2]); mx = fmax3(mx, s[2][3], s[3][0]); mx = fmax3(mx, s[3][1], s[3][2]); mx = fmaxf(mx, s[3][3]);
            mx = fmaxf(mx, __shfl_xor(mx, 16)); mx = fmaxf(mx, __shfl_xor(mx, 32));
            const float mn = fmaxf(G[gi].m, mx * SM_C);
            const float alpha = __builtin_amdgcn_exp2f(G[gi].m - mn);
            G[gi].m = mn; mref = mn;
            if (__builtin_amdgcn_ballot_w64(alpha != 1.0f)) {
                G[gi].l *= alpha;
                if (MODE == 2) {
#pragma unroll
                    for (int dt = 0; dt < 4; ++dt) G[gi].o[dt] *= alpha; }
            }
        } else mref = G[gi].m;
        float lsum = 0.f;
#pragma unroll
        for (int kt = 0; kt < 4; ++kt)
#pragma unroll
            for (int r = 0; r < 4; ++r) { const float p = __builtin_amdgcn_exp2f(__builtin_fmaf(s[kt][r], SM_C, -mref)); s[kt][r] = p; lsum += p; }
        if (MODE != 1) G[gi].l += lsum;
        if (MODE == 1) {
            const float il = G[gi].l;
#pragma unroll
            for (int kt = 0; kt < 4; ++kt) { s[kt] *= il;
                float a = s[kt][0] + s[kt][1] + s[kt][2] + 0.5f * s[kt][3], b = 0.5f * s[kt][3];
                a += dppf<0xB1>(a); a += dppf<0x4E>(a); b += dppf<0xB1>(b); b += dppf<0x4E>(b);
                if ((lane & 3) == 0) { const int q8 = gi * 4 + ((lane & 15) >> 2); impA[q8 * 132 + sb0 + 4 * kt + g] = a; impB[q8 * 132 + sb0 + 4 * kt + g + 1] = b; } }
        }
        if (MODE != 0) {
            pf[gi][0] = __builtin_bit_cast(bf16x8, (v4u){cvtpk(s[0][0], s[0][1]), cvtpk(s[0][2], s[0][3]), cvtpk(s[1][0], s[1][1]), cvtpk(s[1][2], s[1][3])});
            pf[gi][1] = __builtin_bit_cast(bf16x8, (v4u){cvtpk(s[2][0], s[2][1]), cvtpk(s[2][2], s[2][3]), cvtpk(s[3][0], s[3][1]), cvtpk(s[3][2], s[3][3])});
        }
    }
    if (MODE != 0) {
        LAS const unsigned char* vs = slot + 8192;
#pragma unroll
        for (int dt = 0; dt < 4; ++dt) {
            bf16x8 vf[2];
#pragma unroll
            for (int kp = 0; kp < 2; ++kp) {
                const v4i16 a = __builtin_amdgcn_ds_read_tr16_b64_v4i16((LAS v4i16*)(vs + vdt[dt] + (2 * kp) * 2048));
                const v4i16 b = __builtin_amdgcn_ds_read_tr16_b64_v4i16((LAS v4i16*)(vs + vdt[dt] + (2 * kp + 1) * 2048));
                vf[kp] = (bf16x8){a[0], a[1], a[2], a[3], b[0], b[1], b[2], b[3]};
            }
#pragma unroll
            for (int gi = 0; gi < NG; ++gi) if (need[gi]) { G[gi].o[dt] = MFMA16(vf[0], pf[gi][0], G[gi].o[dt]); G[gi].o[dt] = MFMA16(vf[1], pf[gi][1], G[gi].o[dt]); }
        }
    }
}

template <bool WITHV, class Src, class Body>
__device__ __forceinline__ void at_ring(LAS unsigned char* ring, int nb, int tid, int wave, const Src& src, Body& body) {
    const bf16 *kb = nullptr, *vb = nullptr; size_t kp = 0, vp = 0;
    if (nb > 0) { src(0, kb, kp, vb, vp); at_dma(kb, kp, vb, vp, ring, tid, wave, WITHV); }
    if (nb > 1) { src(1, kb, kp, vb, vp); at_dma(kb, kp, vb, vp, ring + AT_SLOT, tid, wave, WITHV); }
    for (int i = 0; i < nb; ++i) {
        if (i + 1 < nb) { if (WITHV) AT_WAITBAR(2); else AT_WAITBAR(1); } else AT_WAITBAR(0);
        if (i + 2 < nb) { src(i + 2, kb, kp, vb, vp); at_dma(kb, kp, vb, vp, ring + ((i + 2) % 3) * AT_SLOT, tid, wave, WITHV); }
        body(i, ring + (i % 3) * AT_SLOT);
    }
    AT_WAITBAR(0);
}

struct LaneGeo { int lane, i16, g, koff0, koff1; int vdt[4]; };
__device__ __forceinline__ LaneGeo make_geo(int lane) {
    LaneGeo L; L.lane = lane; L.i16 = lane & 15; L.g = lane >> 4;
    const int swz = 2 * ((L.i16 >> 1) & 3);
    L.koff0 = L.i16 * 128 + (((0 ^ (swz >> 2)) * 4 + (L.g ^ (swz & 3))) * 16);
    L.koff1 = L.i16 * 128 + (((1 ^ (swz >> 2)) * 4 + (L.g ^ (swz & 3))) * 16);
    const int sv = (2 * L.g + (L.i16 >> 3)) & 3; const int vbase = (4 * L.g + (L.i16 >> 2)) * 128 + 8 * (L.i16 & 1) + ((L.i16 & 3) >> 1) * 16;
#pragma unroll
    for (int dt = 0; dt < 4; ++dt) L.vdt[dt] = vbase + ((dt ^ sv) << 5);
    return L;
}
__device__ __forceinline__ float xg_sum(float v) { v += __shfl_xor(v, 16); v += __shfl_xor(v, 32); return v; }

struct SrcCmp { const bf16* K; const bf16* V; int b; __device__ __forceinline__ void operator()(int i, const bf16*& kb, size_t& kp, const bf16*& vb, size_t& vp) const {
    kb = K + (size_t)(b * 512 + 64 * i) * 64; kp = 64; vb = V + (size_t)(b * 512 + 64 * i) * 64; vp = 64; } };
struct SrcSel { const bf16* P; LAS const unsigned* list; bool use_list; int b; int kcol, vcol; int s0;
    __device__ __forceinline__ void operator()(int i, const bf16*& kb, size_t& kp, const bf16*& vb, size_t& vp) const {
        const int s = use_list ? (int)__builtin_amdgcn_readfirstlane(list[i]) : s0 + i; const bf16* base = P + (size_t)(b * T + 64 * s) * NP; kb = base + kcol; vb = base + vcol; kp = NP; vp = NP; } };

struct BodyCmp0 { Grp (&G)[2]; const LaneGeo& L; const int (&nv)[2];
    __device__ __forceinline__ void operator()(int i, LAS const unsigned char* slot) {
        const int lo[2] = {0, 0}; const int hi[2] = {nv[0] - 64 * i - 1, nv[1] - 64 * i - 1}; const bool need[2] = {true, true};
        const bool partial = __builtin_amdgcn_ballot_w64(hi[0] < 63 || hi[1] < 63) != 0ull;
        at_block<2, 0>(G, slot, L.koff0, L.koff1, L.vdt, L.g, lo, hi, need, partial, nullptr, nullptr, 0, L.lane); } };
struct BodyCmp1 { Grp (&G)[2]; const LaneGeo& L; const int (&nv)[2]; LAS float* impA; LAS float* impB;
    __device__ __forceinline__ void operator()(int i, LAS const unsigned char* slot) {
        const int lo[2] = {0, 0}; const int hi[2] = {nv[0] - 64 * i - 1, nv[1] - 64 * i - 1}; const bool need[2] = {true, true};
        const bool partial = __builtin_amdgcn_ballot_w64(hi[0] < 63 || hi[1] < 63) != 0ull;
        at_block<2, 1>(G, slot, L.koff0, L.koff1, L.vdt, L.g, lo, hi, need, partial, impA, impB, 16 * i, L.lane); } };
struct BodySel { Grp (&G)[2]; const LaneGeo& L; LAS const unsigned* list; LAS const unsigned* selm; const int (&tql)[2]; int cur;
    __device__ __forceinline__ void operator()(int i, LAS const unsigned char* slot) {
        const int s = (int)__builtin_amdgcn_readfirstlane(list[i]); const int w = s >> 5, bit = s & 31;
        int lo[2] = {0, 0}, hi[2]; bool need[2];
#pragma unroll
        for (int gi = 0; gi < 2; ++gi) { const unsigned word = selm[tql[gi] * 4 + w]; const bool on = (word >> bit) & 1u;
            hi[gi] = on ? (s == cur ? tql[gi] : 63) : -1; need[gi] = __builtin_amdgcn_ballot_w64(on) != 0ull; }
        if (!need[0] && !need[1]) return;
        const bool partial = __builtin_amdgcn_ballot_w64((need[0] && hi[0] < 63) || (need[1] && hi[1] < 63)) != 0ull;
        at_block<2, 2>(G, slot, L.koff0, L.koff1, L.vdt, L.g, lo, hi, need, partial, nullptr, nullptr, 0, L.lane); } };
struct BodyWin { Grp (&G)[2]; const LaneGeo& L; const int (&tql)[2]; int cur, s0;
    __device__ __forceinline__ void operator()(int i, LAS const unsigned char* slot) {
        const int s = s0 + i; int lo[2], hi[2]; const bool need[2] = {true, true};
#pragma unroll
        for (int gi = 0; gi < 2; ++gi) { lo[gi] = (s == cur - 8) ? tql[gi] + 1 : 0; hi[gi] = (s == cur) ? tql[gi] : 63; }
        const bool partial = (s == cur) || (s == cur - 8);
        at_block<2, 2>(G, slot, L.koff0, L.koff1, L.vdt, L.g, lo, hi, need, partial, nullptr, nullptr, 0, L.lane); } };

__device__ __forceinline__ void grp_reset(Grp& g) { g.m = -1e30f; g.l = 0.f;
#pragma unroll
    for (int dt = 0; dt < 4; ++dt) g.o[dt] = (f32x4){0.f, 0.f, 0.f, 0.f}; }

__device__ __forceinline__ void nsa_unit(int b, int cur, LAS unsigned char* lds, int tid, int wave, int lane, const bf16* P, const bf16* KCMPb, const bf16* VCMPb, const float* GLOG, const float* gate_b,
                                         const float* nsa_out_g, const float* ROPE, bf16* Y) {
    LAS unsigned char* ring = lds;
    LAS float* impA = (LAS float*)(lds + AT_IMP + wave * AT_IMP_W); LAS float* impB = impA + 8 * 132;
    LAS unsigned* selm = (LAS unsigned*)(lds + AT_SELM); LAS unsigned* tilem = (LAS unsigned*)(lds + AT_TILEM); LAS unsigned* blist = (LAS unsigned*)(lds + AT_LIST); LAS unsigned* nbw = (LAS unsigned*)(lds + AT_NB);
    const LaneGeo L = make_geo(lane);
    const int t0 = cur * 64; const size_t m0 = (size_t)b * T + t0;
    const int h = L.i16 & 3;
    int tql[2]; tql[0] = 8 * wave + (L.i16 >> 2); tql[1] = tql[0] + 4;
    if (tid < 4) tilem[tid] = 0u;
    Grp G[2]; int nv[2];
    LAS float* otp = impA + lane;
#pragma unroll
    for (int gi = 0; gi < 2; ++gi) {
        const bf16* qp = P + (m0 + tql[gi]) * NP + C_NQ + h * 64 + 8 * L.g;
        G[gi].q[0] = *(const bf16x8*)qp; G[gi].q[1] = *(const bf16x8*)(qp + 32);
        const int tq = t0 + tql[gi]; nv[gi] = tq >= 31 ? min((tq - 31) / 16 + 1, NCMP) : 0;
        grp_reset(G[gi]);
    }
    for (int i = lane; i < 2 * 8 * 132; i += 64) impA[i] = 0.f;
    const int nvmax = (t0 + 63 >= 31) ? min((t0 + 63 - 31) / 16 + 1, NCMP) : 0; const int nblk = (nvmax + 63) >> 6;
    { SrcCmp src{KCMPb, VCMPb, b}; BodyCmp0 body{G, L, nv}; at_ring<false>(ring, nblk, tid, wave, src, body); }
#pragma unroll
    for (int gi = 0; gi < 2; ++gi) { const float lt = xg_sum(G[gi].l); G[gi].l = 1.0f / fmaxf(lt, 1e-30f); }
    { SrcCmp src{KCMPb, VCMPb, b}; BodyCmp1 body{G, L, nv, impA, impB}; at_ring<true>(ring, nblk, tid, wave, src, body); }
    {
        unsigned long long accA = 0ull, accB = 0ull;
        const unsigned long long validA = cur >= 63 ? ~0ull : ((1ull << (cur + 1)) - 1ull), validB = cur < 64 ? 0ull : (cur >= 127 ? ~0ull : ((1ull << (cur - 63)) - 1ull));
#pragma unroll 1
        for (int q8 = 0; q8 < 8; ++q8) {
            const float fa = impA[q8 * 132 + lane] + impB[q8 * 132 + lane], fb = impA[q8 * 132 + 64 + lane] + impB[q8 * 132 + 64 + lane];
            const int sa = lane, sb = lane + 64;
            unsigned va = __builtin_bit_cast(unsigned, fa), vb = __builtin_bit_cast(unsigned, fb);
            if (sa == 0 || sa == cur || sa == cur - 1) va = 0x7f000000u; else if (sa > cur) va = 0u;
            if (sb == cur || sb == cur - 1) vb = 0x7f000000u; else if (sb > cur) vb = 0u;
            unsigned tau = 0u;
#pragma unroll 1
            for (int bit = 30; bit >= 0; --bit) { const unsigned cand = tau | (1u << bit);
                const int cnt = __builtin_popcountll(__builtin_amdgcn_ballot_w64(va >= cand)) + __builtin_popcountll(__builtin_amdgcn_ballot_w64(vb >= cand));
                if (cnt >= 16) tau = cand; }
            const unsigned long long gtA = __builtin_amdgcn_ballot_w64(va > tau), gtB = __builtin_amdgcn_ballot_w64(vb > tau);
            const unsigned long long eqA = __builtin_amdgcn_ballot_w64(va == tau), eqB = __builtin_amdgcn_ballot_w64(vb == tau);
            const int needn = 16 - __builtin_popcountll(gtA) - __builtin_popcountll(gtB); const int nA = __builtin_popcountll(eqA);
            const int takeA = min(needn, nA), takeB = needn - takeA;
            const int rA = __builtin_amdgcn_mbcnt_hi((unsigned)(eqA >> 32), __builtin_amdgcn_mbcnt_lo((unsigned)eqA, 0));
            const int rB = __builtin_amdgcn_mbcnt_hi((unsigned)(eqB >> 32), __builtin_amdgcn_mbcnt_lo((unsigned)eqB, 0));
            const unsigned long long selA = (gtA | __builtin_amdgcn_ballot_w64(va == tau && rA < takeA)) & validA;
            const unsigned long long selB = (gtB | __builtin_amdgcn_ballot_w64(vb == tau && rB < takeB)) & validB;
            if (lane == 0) { LAS unsigned* d = selm + (8 * wave + q8) * 4; d[0] = (unsigned)selA; d[1] = (unsigned)(selA >> 32); d[2] = (unsigned)selB; d[3] = (unsigned)(selB >> 32); }
            accA |= selA; accB |= selB;
        }
        if (lane == 0) { atomicOr((unsigned*)&tilem[0], (unsigned)accA); atomicOr((unsigned*)&tilem[1], (unsigned)(accA >> 32)); atomicOr((unsigned*)&tilem[2], (unsigned)accB); atomicOr((unsigned*)&tilem[3], (unsigned)(accB >> 32)); }
    }
    AT_WAITBAR(0);
    if (wave == 0) {
        const unsigned long long mA = (unsigned long long)tilem[0] | ((unsigned long long)tilem[1] << 32), mB = (unsigned long long)tilem[2] | ((unsigned long long)tilem[3] << 32);
        const int rA = __builtin_amdgcn_mbcnt_hi((unsigned)(mA >> 32), __builtin_amdgcn_mbcnt_lo((unsigned)mA, 0));
        const int rB = __builtin_amdgcn_mbcnt_hi((unsigned)(mB >> 32), __builtin_amdgcn_mbcnt_lo((unsigned)mB, 0));
        const int nA = __builtin_popcountll(mA);
        if ((mA >> lane) & 1ull) blist[rA] = (unsigned)lane;
        if ((mB >> lane) & 1ull) blist[nA + rB] = (unsigned)(64 + lane);
        if (lane == 0) nbw[0] = (unsigned)(nA + __builtin_popcountll(mB));
    }
    AT_WAITBAR(0);
    const int nsel = (int)__builtin_amdgcn_readfirstlane(nbw[0]);
#pragma unroll
    for (int gi = 0; gi < 2; ++gi) { const float gt = sigmf(GLOG[(m0 + tql[gi]) * 12 + h * 3 + 0] + gate_b[h * 3 + 0]);
#pragma unroll
        for (int dt = 0; dt < 4; ++dt)
#pragma unroll
            for (int r = 0; r < 4; ++r) otp[((gi * 4 + dt) * 4 + r) * 64] = G[gi].o[dt][r] * gt; }
#pragma unroll
    for (int gi = 0; gi < 2; ++gi) {
        const int tq = t0 + tql[gi];
        float xf[8]; unpack8(__builtin_bit_cast(v4u, G[gi].q[0]), xf);
        float of[8];
#pragma unroll
        for (int j = 0; j < 8; ++j) of[j] = __shfl_xor(xf[j], 16);
        if (L.g < 2) {
            const f32x4 c0 = *(const f32x4*)(ROPE + tq * 16), c1 = *(const f32x4*)(ROPE + tq * 16 + 4), s0 = *(const f32x4*)(ROPE + tq * 16 + 8), s1 = *(const f32x4*)(ROPE + tq * 16 + 12);
            const float cs[8] = {c0.x, c0.y, c0.z, c0.w, c1.x, c1.y, c1.z, c1.w}, sn[8] = {s0.x, s0.y, s0.z, s0.w, s1.x, s1.y, s1.z, s1.w};
#pragma unroll
            for (int j = 0; j < 8; ++j) xf[j] = (L.g == 0) ? (xf[j] * cs[j] - of[j] * sn[j]) : (xf[j] * cs[j] + of[j] * sn[j]);
        }
        G[gi].q[0] = __builtin_bit_cast(bf16x8, pack8(xf));
        grp_reset(G[gi]);
    }
    { SrcSel src{P, blist, true, b, C_KS, C_VS, 0}; BodySel body{G, L, blist, selm, tql, cur}; at_ring<true>(ring, nsel, tid, wave, src, body); }
#pragma unroll
    for (int gi = 0; gi < 2; ++gi) { const float il = sigmf(GLOG[(m0 + tql[gi]) * 12 + h * 3 + 1] + gate_b[h * 3 + 1]) / fmaxf(xg_sum(G[gi].l), 1e-30f);
#pragma unroll
        for (int dt = 0; dt < 4; ++dt)
#pragma unroll
            for (int r = 0; r < 4; ++r) otp[((gi * 4 + dt) * 4 + r) * 64] += G[gi].o[dt][r] * il;
        grp_reset(G[gi]); }
    { const int s0 = max(0, cur - 8); SrcSel src{P, blist, false, b, C_KW, C_VW, s0}; BodyWin body{G, L, tql, cur, s0}; at_ring<true>(ring, cur - s0 + 1, tid, wave, src, body); }
#pragma unroll
    for (int gi = 0; gi < 2; ++gi) { const float il = sigmf(GLOG[(m0 + tql[gi]) * 12 + h * 3 + 2] + gate_b[h * 3 + 2]) / fmaxf(xg_sum(G[gi].l), 1e-30f);
#pragma unroll
        for (int dt = 0; dt < 4; ++dt)
#pragma unroll
            for (int r = 0; r < 4; ++r) G[gi].o[dt][r] = otp[((gi * 4 + dt) * 4 + r) * 64] + G[gi].o[dt][r] * il; }
#pragma unroll
    for (int gi = 0; gi < 2; ++gi) {
        float ss = 0.f;
#pragma unroll
        for (int dt = 0; dt < 4; ++dt) ss += G[gi].o[dt].x * G[gi].o[dt].x + G[gi].o[dt].y * G[gi].o[dt].y + G[gi].o[dt].z * G[gi].o[dt].z + G[gi].o[dt].w * G[gi].o[dt].w;
        ss = xg_sum(ss); const float sc = 1.0f / sqrtf(ss * (1.f / 64.f) + 1e-6f);
        const size_t mq = m0 + tql[gi];
#pragma unroll
        for (int dt = 0; dt < 4; ++dt) { const int d = h * 64 + 16 * dt + 4 * L.g;
            const f32x4 gn = *(const f32x4*)(nsa_out_g + d); const v2u gt = *(const v2u*)(P + mq * NP + C_NG + d);
            const float o0 = G[gi].o[dt].x * sc * gn.x * siluf(bflo(gt.x)), o1 = G[gi].o[dt].y * sc * gn.y * siluf(bfhi(gt.x)), o2 = G[gi].o[dt].z * sc * gn.z * siluf(bflo(gt.y)), o3 = G[gi].o[dt].w * sc * gn.w * siluf(bfhi(gt.y));
            *(v2u*)(Y + mq * D + 512 + d) = (v2u){pk2(o0, o1), pk2(o2, o3)}; }
    }
}

struct SrcMem { const bf16* KV; int b; __device__ __forceinline__ void operator()(int i, const bf16*& kb, size_t& kp, const bf16*& vb, size_t& vp) const {
    const int hh = i >> 2, blk = i & 3; kb = KV + (size_t)(b * MEML + 64 * blk) * 512 + hh * 64; vb = kb + 256; kp = 512; vp = 512; } };
struct BodyMem { Grp (&G)[1]; const LaneGeo& L; const bf16* P; bf16* Y; const float* og; size_t mq;
    __device__ __forceinline__ void operator()(int i, LAS const unsigned char* slot) {
        const int hh = i >> 2, blk = i & 3;
        if (blk == 0) { const bf16* qp = P + mq * NP + C_MQ + hh * 64 + 8 * L.g; G[0].q[0] = *(const bf16x8*)qp; G[0].q[1] = *(const bf16x8*)(qp + 32); grp_reset(G[0]); }
        const int lo[1] = {0}, hi[1] = {63}; const bool need[1] = {true};
        at_block<1, 2>(G, slot, L.koff0, L.koff1, L.vdt, L.g, lo, hi, need, false, nullptr, nullptr, 0, L.lane);
        if (blk == 3) {
            const float il = 1.0f / fmaxf(xg_sum(G[0].l), 1e-30f); float ss = 0.f;
#pragma unroll
            for (int dt = 0; dt < 4; ++dt) { G[0].o[dt] *= il; ss += G[0].o[dt].x * G[0].o[dt].x + G[0].o[dt].y * G[0].o[dt].y + G[0].o[dt].z * G[0].o[dt].z + G[0].o[dt].w * G[0].o[dt].w; }
            ss = xg_sum(ss); const float sc = 1.0f / sqrtf(ss * (1.f / 64.f) + 1e-6f);
#pragma unroll
            for (int dt = 0; dt < 4; ++dt) { const int d = hh * 64 + 16 * dt + 4 * L.g;
                const f32x4 gn = *(const f32x4*)(og + d); const v2u gt = *(const v2u*)(P + mq * NP + C_MG + d); const f32x4 o = G[0].o[dt];
                const float o0 = o.x * sc * gn.x * siluf(bflo(gt.x)), o1 = o.y * sc * gn.y * siluf(bfhi(gt.x)), o2 = o.z * sc * gn.z * siluf(bflo(gt.y)), o3 = o.w * sc * gn.w * siluf(bfhi(gt.y));
                *(v2u*)(Y + mq * D + 768 + d) = (v2u){pk2(o0, o1), pk2(o2, o3)}; }
        }
    } };

constexpr int RW_PITCH = 144, RW_MAT = 64 * RW_PITCH;
constexpr int RW_KKT = 0 * RW_MAT, RW_KD = 1 * RW_MAT, RW_U = 1 * RW_MAT, RW_BD = 2 * RW_MAT, RW_TII = 2 * RW_MAT, RW_RT = 3 * RW_MAT, RW_KH = 4 * RW_MAT, RW_BH = 5 * RW_MAT, RW_V = 6 * RW_MAT,
              RW_ABK = 7 * RW_MAT, RW_AVK = 8 * RW_MAT, RW_ARK = 9 * RW_MAT, RW_ARB = 10 * RW_MAT, RW_M1 = 11 * RW_MAT, RW_M2 = 12 * RW_MAT, RW_WC = 13 * RW_MAT;
typedef short s16x4 __attribute__((ext_vector_type(4)));
#define MFMA16K16(a, b, c) __builtin_amdgcn_mfma_f32_16x16x16bf16_1k(a, b, c, 0, 0, 0)
__device__ __forceinline__ s16x4 ds_tr(LAS const unsigned char* p) { return __builtin_bit_cast(s16x4, __builtin_amdgcn_ds_read_tr16_b64_v4i16((LAS v4i16*)p)); }
__device__ __forceinline__ bf16x8 frag_rm(LAS const unsigned char* X, int row0, int k0, int i16, int g) { return *(const LAS bf16x8*)(X + (row0 + i16) * RW_PITCH + (k0 + 8 * g) * 2); }
__device__ __forceinline__ bf16x8 frag_tr(LAS const unsigned char* X, int k0, int col0, int i16, int g) {
    LAS const unsigned char* p = X + (k0 + 8 * g + (i16 >> 2)) * RW_PITCH + (col0 + 4 * (i16 & 3)) * 2;
    const s16x4 a = ds_tr(p), b = ds_tr(p + 4 * RW_PITCH);
    return (bf16x8){a[0], a[1], a[2], a[3], b[0], b[1], b[2], b[3]};
}
__device__ __forceinline__ f32x4 bf4_to_f32(s16x4 v) { return (f32x4){bf2f((unsigned short)v[0]), bf2f((unsigned short)v[1]), bf2f((unsigned short)v[2]), bf2f((unsigned short)v[3])}; }
__device__ __forceinline__ v2u f32_to_bf4(f32x4 v) { return (v2u){cvtpk(v.x, v.y), cvtpk(v.z, v.w)}; }

__device__ __forceinline__ void rwkv_chunk_unit(int u, LAS unsigned char* lds, int wave, int lane, const bf16* P, const bf16* Aarr, const bf16* LW, const float* mu, const float* k_k, const float* k_a,
                                                const float* r_k, float* BONUS, unsigned char* CHK_PR, unsigned char* CHK_QY) {
    const int bh = u >> 7, c = u & 127, b = bh >> 3, h = bh & 7;
    const size_t m0 = (size_t)b * T + 64 * c;
    const int i16 = lane & 15, g = lane >> 4;
    {
        const int ch = h * 64 + lane;
        float pre = 0.f, tot = 0.f;
#pragma unroll 8
        for (int t = 0; t < 64; ++t) { const float l = bf2f(LW[(m0 + t) * 512 + ch]); tot += l; if (t < 8 * wave) pre += l; }
        const float mur = mu[C_R + ch], muk = mu[C_K + ch], muv = mu[C_V + ch], kkc = k_k[ch], kac = k_a[ch], rkc = r_k[ch];
        float pr_p = 0.f, pk_p = 0.f, pv_p = 0.f;
        { const int t = 8 * wave; if (64 * c + t > 0) { const bf16* pp = P + (m0 + t - 1) * NP; pr_p = bf2f(pp[C_R + ch]); pk_p = bf2f(pp[C_K + ch]); pv_p = bf2f(pp[C_V + ch]); } }
        float cl = pre;
#pragma unroll 2
        for (int tt = 0; tt < 8; ++tt) {
            const int t = 8 * wave + tt; const size_t m = m0 + t; const bf16* pc = P + m * NP;
            const float prc = bf2f(pc[C_R + ch]), pkc = bf2f(pc[C_K + ch]), pvc = bf2f(pc[C_V + ch]);
            const float r = prc + mur * (pr_p - prc), k = pkc + muk * (pk_p - pkc), v = pvc + muv * (pv_p - pvc);
            pr_p = prc; pk_p = pkc; pv_p = pvc;
            const float a = bf2f(Aarr[m * 512 + ch]), lw = bf2f(LW[m * 512 + ch]);
            float kk = k * kkc; const float ss = wave_sum(kk * kk); kk *= 1.f / fmaxf(sqrtf(ss), 1e-12f);
            const float ka = k * (1.f + (a - 1.f) * kac), bb = kk * a;
            const float bon = wave_sum(r * ka * rkc); if (lane == 0) BONUS[m * 8 + h] = bon;
            const float Wp = __expf(cl); cl += lw; const float Wt = __expf(cl), iW = __expf(-cl), hW = __expf(tot - cl);
            LAS unsigned short* row = (LAS unsigned short*)(lds + t * RW_PITCH) + lane;
            row[RW_KKT / 2] = (unsigned short)f2bf(kk * Wp); row[RW_KD / 2] = (unsigned short)f2bf(ka * iW); row[RW_BD / 2] = (unsigned short)f2bf(bb * iW); row[RW_RT / 2] = (unsigned short)f2bf(r * Wt);
            row[RW_KH / 2] = (unsigned short)f2bf(ka * hW); row[RW_BH / 2] = (unsigned short)f2bf(bb * hW); row[RW_V / 2] = (unsigned short)f2bf(v);
        }
        if (wave == 0) ((LAS float*)(lds + RW_WC))[lane] = __expf(tot);
    }
    __syncthreads();
    {
        const int mb = wave & 3; const bool top = wave < 4;
        LAS const unsigned char* Am = lds + (top ? RW_KKT : RW_RT);
        const bf16x8 a0 = frag_rm(Am, 16 * mb, 0, i16, g), a1 = frag_rm(Am, 16 * mb, 32, i16, g);
#pragma unroll
        for (int nb = 0; nb < 8; ++nb) {
            const int jb = nb & 3; LAS const unsigned char* Bm = lds + (nb < 4 ? RW_BD : RW_KD);
            f32x4 d = {0.f, 0.f, 0.f, 0.f};
            if (jb <= mb) { d = MFMA16(a0, frag_rm(Bm, 16 * jb, 0, i16, g), d); d = MFMA16(a1, frag_rm(Bm, 16 * jb, 32, i16, g), d); }
            const int j = 16 * jb + i16, s0 = 16 * mb + 4 * g;
#pragma unroll
            for (int r = 0; r < 4; ++r) { const bool keep = top ? (j < s0 + r) : (j <= s0 + r); if (!keep) d[r] = 0.f; }
            LAS unsigned char* dst = lds + (top ? (nb < 4 ? RW_ABK : RW_AVK) : (nb < 4 ? RW_ARB : RW_ARK));
            *(LAS v2u*)(dst + j * RW_PITCH + s0 * 2) = f32_to_bf4(d);
        }
    }
    __syncthreads();
    if (wave == 0) {
        const int blk = g, cc = i16;
        float Tv[16];
#pragma unroll
        for (int s = 0; s < 16; ++s) Tv[s] = (s == cc) ? 1.f : 0.f;
#pragma unroll
        for (int j = 0; j < 15; ++j) {
            LAS const unsigned char* rowp = lds + RW_ABK + (16 * blk + j) * RW_PITCH + (16 * blk) * 2;
            float L[16]; { float t8[8]; unpack8(*(const LAS v4u*)rowp, t8);
#pragma unroll
                for (int e = 0; e < 8; ++e) L[e] = t8[e];
                unpack8(*(const LAS v4u*)(rowp + 16), t8);
#pragma unroll
                for (int e = 0; e < 8; ++e) L[8 + e] = t8[e]; }
            const float Tj = Tv[j];
#pragma unroll
            for (int s = j + 1; s < 16; ++s) Tv[s] -= L[s] * Tj;
        }
#pragma unroll
        for (int s = 0; s < 16; ++s) *(LAS unsigned short*)(lds + RW_TII + blk * 512 + s * 32 + cc * 2) = (unsigned short)f2bf(Tv[s]);
    } else if (wave <= 4) {
        const int mb = wave - 1;
        const bf16x8 a0 = frag_tr(lds + RW_AVK, 0, 16 * mb, i16, g), a1 = frag_tr(lds + RW_AVK, 32, 16 * mb, i16, g);
#pragma unroll
        for (int vt = 0; vt < 4; ++vt) {
            f32x4 d = {0.f, 0.f, 0.f, 0.f};
            d = MFMA16(a0, frag_tr(lds + RW_V, 0, 16 * vt, i16, g), d); d = MFMA16(a1, frag_tr(lds + RW_V, 32, 16 * vt, i16, g), d);
            *(LAS v2u*)(lds + RW_U + (16 * vt + i16) * RW_PITCH + (16 * mb + 4 * g) * 2) = f32_to_bf4(d);
        }
    }
    __syncthreads();
    {
        const int c0 = 16 * (wave & 3); const bool top = wave < 4;
        s16x4 Xb[4];
#pragma unroll
        for (int i = 0; i < 4; ++i) {
            f32x4 rhs;
            if (top) rhs = bf4_to_f32(ds_tr(lds + RW_KKT + (16 * i + 4 * g + (i16 >> 2)) * RW_PITCH + (c0 + 4 * (i16 & 3)) * 2));
            else { const v2u w2 = *(const LAS v2u*)(lds + RW_U + (c0 + i16) * RW_PITCH + (16 * i + 4 * g) * 2); rhs = (f32x4){bflo(w2.x), bfhi(w2.x), bflo(w2.y), bfhi(w2.y)}; }
            f32x4 acc = {0.f, 0.f, 0.f, 0.f};
#pragma unroll
            for (int k = 0; k < 4; ++k) if (k < i) {
                const s16x4 al = ds_tr(lds + RW_ABK + (16 * k + 4 * g + (i16 >> 2)) * RW_PITCH + (16 * i + 4 * (i16 & 3)) * 2);
                acc = MFMA16K16(al, Xb[k], acc); }
            rhs -= acc;
            const s16x4 rb = __builtin_bit_cast(s16x4, f32_to_bf4(rhs));
            const s16x4 at = __builtin_bit_cast(s16x4, *(const LAS v2u*)(lds + RW_TII + i * 512 + i16 * 32 + 8 * g));
            f32x4 X = {0.f, 0.f, 0.f, 0.f}; X = MFMA16K16(at, rb, X);
            Xb[i] = __builtin_bit_cast(s16x4, f32_to_bf4(X));
            *(LAS v2u*)(lds + (top ? RW_M1 : RW_M2) + (c0 + i16) * RW_PITCH + (16 * i + 4 * g) * 2) = f32_to_bf4(-X);
        }
    }
    __syncthreads();
    {
        const int nt = wave & 3;
        unsigned char* gpr = CHK_PR + (size_t)u * 16384; unsigned char* gqy = CHK_QY + (size_t)u * 16384;
        if (wave < 4) {
            const bf16x8 bh0 = frag_tr(lds + RW_BH, 0, 16 * nt, i16, g), bh1 = frag_tr(lds + RW_BH, 32, 16 * nt, i16, g);
            f32x4 d[4];
#pragma unroll
            for (int kt = 0; kt < 4; ++kt) { d[kt] = (f32x4){0.f, 0.f, 0.f, 0.f};
                d[kt] = MFMA16(frag_rm(lds + RW_M1, 16 * kt, 0, i16, g), bh0, d[kt]); d[kt] = MFMA16(frag_rm(lds + RW_M1, 16 * kt, 32, i16, g), bh1, d[kt]);
                if (kt == nt) {
#pragma unroll
                    for (int r = 0; r < 4; ++r) if (4 * g + r == i16) d[kt][r] += ((const LAS float*)(lds + RW_WC))[16 * kt + 4 * g + r]; } }
#pragma unroll
            for (int ks = 0; ks < 2; ++ks) { const v2u lo = f32_to_bf4(d[2 * ks]), hi = f32_to_bf4(d[2 * ks + 1]); *(v4u*)(gpr + (nt * 2 + ks) * 1024 + lane * 16) = (v4u){lo.x, lo.y, hi.x, hi.y}; }
            const bf16x8 kh0 = frag_tr(lds + RW_KH, 0, 16 * nt, i16, g), kh1 = frag_tr(lds + RW_KH, 32, 16 * nt, i16, g);
#pragma unroll
            for (int vt = 0; vt < 4; ++vt) { f32x4 q = {0.f, 0.f, 0.f, 0.f};
                q = MFMA16(kh0, frag_tr(lds + RW_V, 0, 16 * vt, i16, g), q); q = MFMA16(kh1, frag_tr(lds + RW_V, 32, 16 * vt, i16, g), q);
                q = MFMA16(bh0, frag_rm(lds + RW_M2, 16 * vt, 0, i16, g), q); q = MFMA16(bh1, frag_rm(lds + RW_M2, 16 * vt, 32, i16, g), q);
                *(v2u*)(gqy + ((vt * 4 + nt) * 64 + lane) * 8) = f32_to_bf4(q); }
        } else {
            const bf16x8 ab0 = frag_tr(lds + RW_ARB, 0, 16 * nt, i16, g), ab1 = frag_tr(lds + RW_ARB, 32, 16 * nt, i16, g);
            f32x4 d[4];
#pragma unroll
            for (int kt = 0; kt < 4; ++kt) { const v2u w2 = *(const LAS v2u*)(lds + RW_RT + (16 * nt + i16) * RW_PITCH + (16 * kt + 4 * g) * 2);
                d[kt] = (f32x4){bflo(w2.x), bfhi(w2.x), bflo(w2.y), bfhi(w2.y)};
                d[kt] = MFMA16(frag_rm(lds + RW_M1, 16 * kt, 0, i16, g), ab0, d[kt]); d[kt] = MFMA16(frag_rm(lds + RW_M1, 16 * kt, 32, i16, g), ab1, d[kt]); }
#pragma unroll
            for (int ks = 0; ks < 2; ++ks) { const v2u lo = f32_to_bf4(d[2 * ks]), hi = f32_to_bf4(d[2 * ks + 1]); *(v4u*)(gpr + 8192 + (nt * 2 + ks) * 1024 + lane * 16) = (v4u){lo.x, lo.y, hi.x, hi.y}; }
            const bf16x8 ak0 = frag_tr(lds + RW_ARK, 0, 16 * nt, i16, g), ak1 = frag_tr(lds + RW_ARK, 32, 16 * nt, i16, g);
#pragma unroll
            for (int vt = 0; vt < 4; ++vt) { f32x4 q = {0.f, 0.f, 0.f, 0.f};
                q = MFMA16(ak0, frag_tr(lds + RW_V, 0, 16 * vt, i16, g), q); q = MFMA16(ak1, frag_tr(lds + RW_V, 32, 16 * vt, i16, g), q);
                q = MFMA16(ab0, frag_rm(lds + RW_M2, 16 * vt, 0, i16, g), q); q = MFMA16(ab1, frag_rm(lds + RW_M2, 16 * vt, 32, i16, g), q);
                *(v2u*)(gqy + 8192 + ((vt * 4 + nt) * 64 + lane) * 8) = f32_to_bf4(q); }
        }
    }
    __syncthreads();
}

__device__ __forceinline__ void rwkv_scan_unit(int unit, int lane, const unsigned char* CHK_PR, const unsigned char* CHK_QY, unsigned char* CHK_S) {
    const int bh = unit >> 2, vt = unit & 3;
    f32x4 S[4];
#pragma unroll
    for (int kt = 0; kt < 4; ++kt) S[kt] = (f32x4){0.f, 0.f, 0.f, 0.f};
    constexpr int PD = 4;
    v4u pf[PD][8]; v2u qf[PD][4];
#pragma unroll
    for (int d = 0; d < PD; ++d) { const size_t u = (size_t)bh * 128 + d;
#pragma unroll
        for (int f = 0; f < 8; ++f) pf[d][f] = *(const v4u*)(CHK_PR + u * 16384 + f * 1024 + lane * 16);
#pragma unroll
        for (int mt = 0; mt < 4; ++mt) qf[d][mt] = *(const v2u*)(CHK_QY + u * 16384 + ((vt * 4 + mt) * 64 + lane) * 8); }
#pragma unroll 1
    for (int c0 = 0; c0 < 128; c0 += PD) {
#pragma unroll
        for (int d = 0; d < PD; ++d) {
            const int c = c0 + d; const size_t u = (size_t)bh * 128 + c;
            const v2u s0 = f32_to_bf4(S[0]), s1 = f32_to_bf4(S[1]), s2 = f32_to_bf4(S[2]), s3 = f32_to_bf4(S[3]);
            const v4u b0 = {s0.x, s0.y, s1.x, s1.y}, b1 = {s2.x, s2.y, s3.x, s3.y};
            *(v4u*)(CHK_S + u * 8192 + ((vt * 2 + 0) * 64 + lane) * 16) = b0; *(v4u*)(CHK_S + u * 8192 + ((vt * 2 + 1) * 64 + lane) * 16) = b1;
#pragma unroll
            for (int mt = 0; mt < 4; ++mt) { f32x4 acc = {bflo(qf[d][mt].x), bfhi(qf[d][mt].x), bflo(qf[d][mt].y), bfhi(qf[d][mt].y)};
                acc = MFMA16(__builtin_bit_cast(bf16x8, pf[d][mt * 2 + 0]), __builtin_bit_cast(bf16x8, b0), acc);
                acc = MFMA16(__builtin_bit_cast(bf16x8, pf[d][mt * 2 + 1]), __builtin_bit_cast(bf16x8, b1), acc); S[mt] = acc; }
            if (c + PD < 128) { const size_t un = u + PD;
#pragma unroll
                for (int f = 0; f < 8; ++f) pf[d][f] = *(const v4u*)(CHK_PR + un * 16384 + f * 1024 + lane * 16);
#pragma unroll
                for (int mt = 0; mt < 4; ++mt) qf[d][mt] = *(const v2u*)(CHK_QY + un * 16384 + ((vt * 4 + mt) * 64 + lane) * 8); }
        }
    }
}

__device__ __forceinline__ void rwkv_out_unit(int u, LAS unsigned char* wl  , int lane, const bf16* P, const unsigned char* CHK_PR, const unsigned char* CHK_QY, const unsigned char* CHK_S,
                                              const float* BONUS, const float* mu, const float* ln_w, const float* ln_b, bf16* Y) {
    const int bh = u >> 7, c = u & 127, b = bh >> 3, h = bh & 7;
    const size_t m0 = (size_t)b * T + 64 * c;
    const int i16 = lane & 15, g = lane >> 4;
    bf16x8 sf[4][2];
#pragma unroll
    for (int vt = 0; vt < 4; ++vt)
#pragma unroll
        for (int ks = 0; ks < 2; ++ks) sf[vt][ks] = *(const bf16x8*)(CHK_S + (size_t)u * 8192 + ((vt * 2 + ks) * 64 + lane) * 16);
#pragma unroll
    for (int tt = 0; tt < 4; ++tt) {
        const bf16x8 r0 = *(const bf16x8*)(CHK_PR + (size_t)u * 16384 + 8192 + (tt * 2 + 0) * 1024 + lane * 16), r1 = *(const bf16x8*)(CHK_PR + (size_t)u * 16384 + 8192 + (tt * 2 + 1) * 1024 + lane * 16);
        f32x4 y[4];
#pragma unroll
        for (int vt = 0; vt < 4; ++vt) { const v2u w2 = *(const v2u*)(CHK_QY + (size_t)u * 16384 + 8192 + ((vt * 4 + tt) * 64 + lane) * 8);
            y[vt] = (f32x4){bflo(w2.x), bfhi(w2.x), bflo(w2.y), bfhi(w2.y)};
            y[vt] = MFMA16(r0, sf[vt][0], y[vt]); y[vt] = MFMA16(r1, sf[vt][1], y[vt]); }
#pragma unroll
        for (int r = 0; r < 4; ++r) {
            float s = (y[0][r] + y[1][r]) + (y[2][r] + y[3][r]);
            s += dppf<0xB1>(s); s += dppf<0x4E>(s); s += dppf<0x141>(s); s += dppf<0x140>(s);
            const float mean = s * (1.f / 64.f);
            float q = 0.f;
#pragma unroll
            for (int vt = 0; vt < 4; ++vt) { y[vt][r] -= mean; q += y[vt][r] * y[vt][r]; }
            q += dppf<0xB1>(q); q += dppf<0x4E>(q); q += dppf<0x141>(q); q += dppf<0x140>(q);
            const float rstd = 1.0f / sqrtf(q * (1.f / 64.f) + 64e-5f);
#pragma unroll
            for (int vt = 0; vt < 4; ++vt) *(LAS unsigned short*)(wl + (16 * tt + 4 * g + r) * 132 + (16 * vt + i16) * 2) = (unsigned short)f2bf(y[vt][r] * rstd);
        }
    }
    const int ch = h * 64 + lane;
    const float muv = mu[C_V + ch], mug = mu[C_G + ch], lw = ln_w[ch], lb = ln_b[ch];
    float pv_p = 0.f, pg_p = 0.f;
    if (64 * c > 0) { const bf16* pp = P + (m0 - 1) * NP; pv_p = bf2f(pp[C_V + ch]); pg_p = bf2f(pp[C_G + ch]); }
#pragma unroll 4
    for (int t = 0; t < 64; ++t) {
        const size_t m = m0 + t; const bf16* pc = P + m * NP;
        const float pvc = bf2f(pc[C_V + ch]), pgc = bf2f(pc[C_G + ch]);
        const float v = pvc + muv * (pv_p - pvc), gt = pgc + mug * (pg_p - pgc); pv_p = pvc; pg_p = pgc;
        const float yn = bf2f(*(const LAS unsigned short*)(wl + t * 132 + lane * 2));
        const float o = (yn * lw + lb + BONUS[m * 8 + h] * v) * siluf(gt);
        Y[m * D + ch] = (bf16)f2bf(o);
    }
}

#ifndef PHASES
#define PHASES 0x3ff
#endif
__global__ void __launch_bounds__(NWAVES * 64, 2) hymba_fwd(Args args) {
    extern __shared__ __attribute__((aligned(16))) unsigned char lds_raw[];
    LAS unsigned char* lds = (LAS unsigned char*)lds_raw;
    volatile LAS unsigned* MISC = (volatile LAS unsigned*)(lds + MISC_OFF);
    const int tid = threadIdx.x, lane = tid & 63, wave = __builtin_amdgcn_readfirstlane(tid >> 6);
    const int G = gridDim.x; const int bx = blockIdx.x; const int vcu = (G % 8 == 0) ? (bx % 8) * (G / 8) + bx / 8 : bx;
    const int gw = vcu * NWAVES + wave, NGW = G * NWAVES;
    unsigned char* ws = args.ws;
    unsigned* ctl = (unsigned*)(ws + WS_CTL);
    const float* x = args.in[0]; const float* mem = args.in[1]; const float* norm_in_g = args.in[2]; const float* w_in = args.in[3];
    const float* mu = args.in[4]; const float* w0 = args.in[5]; const float* w_up = args.in[6]; const float* a0 = args.in[7]; const float* a_up = args.in[8];
    const float* k_k = args.in[9]; const float* k_a = args.in[10]; const float* r_k = args.in[11]; const float* ln_w = args.in[12]; const float* ln_b = args.in[13];
    const float* cmp_pos = args.in[14]; const float* ck_w1 = args.in[15]; const float* ck_w2 = args.in[16]; const float* cv_w1 = args.in[17]; const float* cv_w2 = args.in[18];
    const float* gate_b = args.in[19]; const float* nsa_out_g = args.in[20]; const float* mem_norm_g = args.in[21]; const float* w_mem_kv = args.in[22];
    const float* mem_out_g = args.in[23]; const float* w_out = args.in[24]; const float* norm_final_g = args.in[25];
    float* out = args.out;
    bf16* WT_IN = (bf16*)(ws + WS_WIN); bf16* WT_OUT = (bf16*)(ws + WS_WOUT);
    float* ROPE = (float*)(ws + WS_ROPE); float* RS = (float*)(ws + WS_RS); bf16* KCMP = (bf16*)(ws + WS_KCMP); bf16* VCMP = (bf16*)(ws + WS_VCMP);
    bf16* MEMKV = (bf16*)(ws + WS_MEMKV); float* GLOG = (float*)(ws + WS_GLOG);
    bf16* P = (bf16*)(ws + WS_P); bf16* XB = (bf16*)(ws + WS_XB); bf16* Y = (bf16*)(ws + WS_Y);
    bf16* AA = (bf16*)(ws + WS_A); bf16* LWA = (bf16*)(ws + WS_LW); float* BONUS = (float*)(ws + WS_BONUS);
    unsigned char* CHK_PR = ws + WS_CHK_PR; unsigned char* CHK_QY = ws + WS_CHK_QY; unsigned char* CHK_S = ws + WS_CHK_S;

    for (int u = tid; u < (LDS_BYTES - LDSCTL_OFF) / 4; u += NWAVES * 64) ((LAS unsigned*)(lds + LDSCTL_OFF))[u] = 0u;
    __syncthreads();
    XcdBarrier bar = xcd_barrier_post(ctl + CW_BAR, MISC + 8);

    if (PHASES & 1) {
        LAS float* wgt = (LAS float*)(lds + 81920);
        for (int i = tid; i < D * 12; i += NWAVES * 64) { const int k = i / 12, c = i % 12; wgt[i] = norm_in_g[k] * w_in[(size_t)k * W_IN_COLS + GLOG_SRC + c]; }
        __syncthreads();
        LAS float* scr = (LAS float*)(lds + wave * 8704);
        constexpr int I_IN = 16 * (NP / 32), I_OUT = 16 * (D / 32);
        for (int it = gw; it < I_IN + I_OUT; it += NGW) {
            if (it < I_IN) { const int kb = it / (NP / 32), nb = it % (NP / 32); const int src = 32 * nb + (32 * nb >= GLOG_SRC ? 12 : 0);
                p0_transpose_item(w_in, W_IN_COLS, src, norm_in_g, WT_IN, D, 32 * nb, 64 * kb, scr, lane); }
            else { const int r = it - I_IN; const int kb = r / (D / 32), nb = r % (D / 32);
                p0_transpose_item(w_out, D, 32 * nb, nullptr, WT_OUT, D, 32 * nb, 64 * kb, scr, lane); }
        }
        for (int i = gw * 64 + lane; i < T * 8; i += NGW * 64) { float c, s; rope_cs(i >> 3, i & 7, c, s); ROPE[(i >> 3) * 16 + (i & 7)] = c; ROPE[(i >> 3) * 16 + 8 + (i & 7)] = s; }
        for (int m = gw; m < M; m += NGW) {
            const f32x4* xr = (const f32x4*)(x + (size_t)m * D) + lane;
            f32x4 v[4]; float ss = 0.f;
#pragma unroll
            for (int j = 0; j < 4; ++j) { v[j] = xr[64 * j]; ss += (v[j].x * v[j].x + v[j].y * v[j].y) + (v[j].z * v[j].z + v[j].w * v[j].w); }
            ss = wave_sum(ss);
            const float rs = 1.0f / sqrtf(ss * (1.f / D) + 1e-6f);
            unsigned long long* o8 = (unsigned long long*)(XB + (size_t)m * D) + lane;
#pragma unroll
            for (int j = 0; j < 4; ++j) o8[64 * j] = (unsigned long long)pk2(v[j].x, v[j].y) | ((unsigned long long)pk2(v[j].z, v[j].w) << 32);
            float acc[12];
#pragma unroll
            for (int c = 0; c < 12; ++c) acc[c] = 0.f;
#pragma unroll
            for (int j = 0; j < 4; ++j)
#pragma unroll
                for (int e = 0; e < 4; ++e) { const int k = 256 * j + 4 * lane + e; const float xv = v[j][e];
                    const f32x4 w0v = *(const LAS f32x4*)(wgt + k * 12), w1v = *(const LAS f32x4*)(wgt + k * 12 + 4), w2v = *(const LAS f32x4*)(wgt + k * 12 + 8);
                    acc[0] += xv * w0v.x; acc[1] += xv * w0v.y; acc[2] += xv * w0v.z; acc[3] += xv * w0v.w;
                    acc[4] += xv * w1v.x; acc[5] += xv * w1v.y; acc[6] += xv * w1v.z; acc[7] += xv * w1v.w;
                    acc[8] += xv * w2v.x; acc[9] += xv * w2v.y; acc[10] += xv * w2v.z; acc[11] += xv * w2v.w; }
            float mine = 0.f;
#pragma unroll
            for (int c = 0; c < 12; ++c) { const float t = wave_sum(acc[c]); if (lane == c) mine = t; }
            if (lane < 12) GLOG[(size_t)m * 12 + lane] = mine * rs;
            if (lane == 0) RS[m] = rs;
        }
    }
    xcd_barrier(bar);

    if (PHASES & 2) {
        pg8::Gemm g{XB, WT_IN, M, NP, D}; pg8::StaticOrder S; S.init(M, NP, G, bx);
        pg8::EpiRowScaleBf16 E{P, NP, RS};
        pg8::gemm_phase<pg8::EpiRowScaleBf16, pg8::StaticOrder, true, true>(lds, g, S, E);
    }
    xcd_barrier(bar);

    if (PHASES & 4) {
        LAS bf16* wup = (LAS bf16*)lds; LAS bf16* aup = (LAS bf16*)(lds + 65536);
        for (int i = tid; i < 64 * 512; i += NWAVES * 64) { wup[i] = (bf16)f2bf(w_up[i]); aup[i] = (bf16)f2bf(a_up[i]); }
        __syncthreads();
        const int c0 = lane * 8;
        for (int m = gw; m < M; m += NGW) {
            const int t = m & (T - 1); const bool hp = t > 0;
            const bf16* pr = P + (size_t)m * NP; const bf16* pp = pr - NP;
            float wdv, adv;
            { const float c = bf2f(pr[C_WD + lane]), p = hp ? bf2f(pp[C_WD + lane]) : 0.f; wdv = c + mu[C_WD + lane] * (p - c); }
            { const float c = bf2f(pr[C_AD + lane]), p = hp ? bf2f(pp[C_AD + lane]) : 0.f; adv = c + mu[C_AD + lane] * (p - c); }
            const float tw = tanhf(wdv);
            float accw[8], acca[8];
#pragma unroll
            for (int e = 0; e < 8; ++e) { accw[e] = 0.f; acca[e] = 0.f; }
#pragma unroll 8
            for (int j = 0; j < 64; ++j) {
                const float sw = rdlane(tw, j), sa = rdlane(adv, j);
                const v4u wv = *(const LAS v4u*)(wup + j * 512 + c0), av = *(const LAS v4u*)(aup + j * 512 + c0);
                float wf[8], af[8]; unpack8(wv, wf); unpack8(av, af);
#pragma unroll
                for (int e = 0; e < 8; ++e) { accw[e] += sw * wf[e]; acca[e] += sa * af[e]; }
            }
            float ao[8], lwo[8];
#pragma unroll
            for (int e = 0; e < 8; ++e) {
                const int c = c0 + e;
                const float lw = w0[c] + accw[e];
                const float nx = -lw; const float sp = fmaxf(nx, 0.f) + log1pf(__expf(-fabsf(nx)));
                lwo[e] = -__expf(-sp - 0.5f);
                ao[e] = sigmf(a0[c] + acca[e]);
            }
            *(v4u*)(AA + (size_t)m * 512 + c0) = pack8(ao); *(v4u*)(LWA + (size_t)m * 512 + c0) = pack8(lwo);
            if (lane < 16) { const int i = lane & 7; const int cb = (lane < 8) ? C_KS : C_KW; bf16* q = P + (size_t)m * NP + cb;
                const float x1 = bf2f(q[i]), x2 = bf2f(q[8 + i]); const float cs = ROPE[t * 16 + i], sn = ROPE[t * 16 + 8 + i];
                q[i] = (bf16)f2bf(x1 * cs - x2 * sn); q[8 + i] = (bf16)f2bf(x2 * cs + x1 * sn); }
        }
        for (int u = gw; u < NB * 512 * 2; u += NGW) {
            const int kv = u & 1, bc = u >> 1, b = bc >> 9, c = bc & 511;
            bf16* dst = (kv ? VCMP : KCMP) + (size_t)bc * 64;
            if (c >= NCMP) { dst[lane] = 0; continue; }
            const float* W1 = kv ? cv_w1 : ck_w1; const float* W2 = kv ? cv_w2 : ck_w2; const int col = kv ? C_VC : C_KC;
            float acc = 0.f;
            for (int l = 0; l < 32; ++l) {
                const float uval = bf2f(P[(size_t)(b * T + 16 * c + l) * NP + col + lane]) + cmp_pos[l * 64 + lane];
                const float* wr = W1 + (size_t)(l * 64) * 64 + lane;
#pragma unroll 16
                for (int d = 0; d < 64; ++d) acc += rdlane(uval, d) * wr[d * 64];
            }
            const float hv = siluf(acc);
            float o = 0.f;
#pragma unroll 16
            for (int n = 0; n < 64; ++n) o += rdlane(hv, n) * W2[n * 64 + lane];
            dst[lane] = (bf16)f2bf(o);
        }
        for (int u = gw; u < NB * MEML * 8; u += NGW) {
            const int r = u >> 3, cb = u & 7;
            float v[16]; float ss = 0.f;
#pragma unroll
            for (int i = 0; i < 16; ++i) { v[i] = mem[(size_t)r * D + 64 * i + lane]; ss += v[i] * v[i]; }
            ss = wave_sum(ss); const float rs = 1.0f / sqrtf(ss * (1.f / D) + 1e-6f);
#pragma unroll
            for (int i = 0; i < 16; ++i) v[i] *= rs * mem_norm_g[64 * i + lane];
            float acc = 0.f;
#pragma unroll
            for (int i = 0; i < 16; ++i) { const float* wr = w_mem_kv + (size_t)(64 * i) * 512 + cb * 64 + lane;
#pragma unroll 16
                for (int j = 0; j < 64; ++j) acc += rdlane(v[i], j) * wr[j * 512]; }
            MEMKV[(size_t)r * 512 + cb * 64 + lane] = (bf16)f2bf(acc);
        }
    }
    xcd_barrier(bar);

    if (PHASES & 8) {
        for (int u = vcu; u < NB * 8 * 128; u += G) rwkv_chunk_unit(u, lds, wave, lane, P, AA, LWA, mu, k_k, k_a, r_k, BONUS, CHK_PR, CHK_QY);
    }
    xcd_barrier(bar);
    if ((PHASES & 128) && wave == 0) {
        for (int unit = bx; unit < NB * 8 * 4; unit += G) rwkv_scan_unit(unit, lane, CHK_PR, CHK_QY, CHK_S);
    }
    if (PHASES & 256) {
        for (int pr = vcu; pr < 256; pr += G)
#pragma unroll 1
            for (int half = 0; half < 2; ++half)
                nsa_unit(pr >> 6, half ? 127 - (pr & 63) : (pr & 63), lds, tid, wave, lane, P, KCMP, VCMP, GLOG, gate_b, nsa_out_g, ROPE, Y);
    }
    if (PHASES & 512) {
        for (int u = vcu; u < 256; u += G) {
            const int b = u >> 6; const size_t m0 = (size_t)b * T + 128 * (u & 63);
            Grp GM[1]; const LaneGeo L = make_geo(lane);
            SrcMem src{MEMKV, b}; BodyMem body{GM, L, P, Y, mem_out_g, m0 + 16 * wave + L.i16};
            at_ring<true>(lds, 16, tid, wave, src, body);
        }
    }
    xcd_barrier(bar);

    if (PHASES & 16) {
        for (int u = gw; u < NB * 8 * 128; u += NGW) rwkv_out_unit(u, lds + wave * 8448, lane, P, CHK_PR, CHK_QY, CHK_S, BONUS, mu, ln_w, ln_b, Y);
    }
    xcd_barrier(bar);

    if (PHASES & 32) {
        pg8::Gemm g{Y, WT_OUT, M, D, D}; pg8::StaticOrder S; S.init(M, D, G, bx);
        pg8::EpiResF32 E{x, out, D};
        pg8::gemm_phase<pg8::EpiResF32, pg8::StaticOrder, true, true>(lds, g, S, E);
    }
    xcd_barrier(bar);

    if (PHASES & 64) for (int m = gw; m < M; m += NGW) {
        f32x4* xr = (f32x4*)(out + (size_t)m * D) + lane;
        f32x4 v[4]; float ss = 0.f;
#pragma unroll
        for (int j = 0; j < 4; ++j) { v[j] = xr[64 * j]; ss += (v[j].x * v[j].x + v[j].y * v[j].y) + (v[j].z * v[j].z + v[j].w * v[j].w); }
        ss = wave_sum(ss);
        const float rs = 1.0f / sqrtf(ss * (1.f / D) + 1e-6f);
#pragma unroll
        for (int j = 0; j < 4; ++j) { const f32x4 g = *((const f32x4*)norm_final_g + 64 * j + lane); xr[64 * j] = v[j] * rs * g; }
    }
}

extern "C" void kernel_launch(void* const* d_in, const int* in_sizes, int n_in, void* d_out, int out_size, void* d_ws, size_t ws_size, hipStream_t stream) {
    static int grid = 0;
    if (grid == 0) {
        if (n_in != 26 || in_sizes[0] != M * D || out_size != M * D || ws_size < WS_END) { fprintf(stderr, "kernel_launch: unexpected shapes (n_in %d, in0 %d, out %d, ws %zu); nothing launched\n", n_in, n_in > 0 ? in_sizes[0] : -1, out_size, ws_size); grid = -1; return; }
        int dev = 0, cus = 0;
        if (hipGetDevice(&dev) != hipSuccess || hipDeviceGetAttribute(&cus, hipDeviceAttributeMultiprocessorCount, dev) != hipSuccess) { grid = -1; return; }
        if (hipFuncSetAttribute((const void*)hymba_fwd, hipFuncAttributeMaxDynamicSharedMemorySize, LDS_BYTES) != hipSuccess) { fprintf(stderr, "kernel_launch: hipFuncSetAttribute failed\n"); grid = -1; return; }
        (void)hipGetLastError();
        grid = cus;
    }
    if (grid < 0) return;
    (void)hipMemsetAsync((char*)d_ws + WS_CTL, 0, CTL_ZERO_BYTES, stream);
    Args a{};
    for (int i = 0; i < 26; ++i) a.in[i] = (const float*)d_in[i];
    a.out = (float*)d_out; a.ws = (unsigned char*)d_ws;
    hipLaunchKernelGGL(hymba_fwd, dim3(grid), dim3(NWAVES * 64), LDS_BYTES, stream, a);
}
```

```cpp
#define REPEAT 0
#include <hip/hip_runtime.h>
#include <cstdio>
#include <cstdint>
namespace pg8 {
#define PG8_LAS __attribute__((address_space(3)))
typedef unsigned short bf16_t;
typedef short bf16x8 __attribute__((ext_vector_type(8)));
typedef float f32x4 __attribute__((ext_vector_type(4)));
typedef unsigned u32x4 __attribute__((ext_vector_type(4)));
constexpr int BM = 256, BK = 64, HALF = 128, HTB = HALF * BK * 2  , STAGE_BYTES = 8 * HTB, NXCD = 8, WGM = 8;

__host__ __device__ __forceinline__ int lds_byte(int r, int c) { const int st = (r >> 4) * 2 + (c >> 5), rr = r & 15, cc = c & 31, ob = rr * 64 + cc * 2; return st * 1024 + (ob ^ (((ob >> 9) & 1) << 5)); }
__host__ __device__ __forceinline__ void stage_rc(int b, int& R, int& C) { const int st = b / 1024, sb = b % 1024, swz = sb ^ (((sb >> 9) & 1) << 5); R = (st >> 1) * 16 + swz / 64; C = (st & 1) * 32 + (swz % 64) / 2; }
__host__ __device__ __forceinline__ int perm32(int rho) { const int n = rho >> 4, i = rho & 15; return 8 * (i >> 2) + 4 * n + (i & 3); }

struct Unit { int pm, pn; };
struct Gemm { const bf16_t* A; const bf16_t* Bt; int M, N, K; };

struct StaticOrder {
    int nM, nN, nwg, G, c;
    __host__ __device__ void init(int M, int N, int G_, int c_) { nM = M / BM; nN = N / BM; nwg = nM * nN; G = G_; c = c_; }
    __host__ __device__ bool next(int i, Unit& u) const {
        const long L = (long)i * G + c; if (L >= nwg) return false;
        int wgid = (int)L; { const int q = nwg / NXCD, r = nwg % NXCD, xcd = wgid % NXCD, off = wgid / NXCD; wgid = (xcd < r ? xcd * (q + 1) : r * (q + 1) + (xcd - r) * q) + off; }
        const int nig = WGM * nN, gid = wgid / nig, fm = gid * WGM, gsz = (nM - fm) < WGM ? (nM - fm) : WGM;
        u.pm = fm + ((wgid % nig) % gsz); u.pn = (wgid % nig) / gsz; return true;
    }
    __device__ __forceinline__ void a_ready(const Unit&) const {}
    __device__ __forceinline__ void done(const Unit&) const {}
};

__device__ __forceinline__ unsigned cvt_pk_bf16(float lo, float hi) { unsigned r; asm volatile("v_cvt_pk_bf16_f32 %0, %1, %2" : "=v"(r) : "v"(lo), "v"(hi)); return r; }

template <class Epi, class Sched, bool ALIGN_EPI = false, bool SP2 = false>
__device__ __forceinline__ void gemm_phase(PG8_LAS unsigned char* lds, const Gemm g, const Sched& S, const Epi& E) {
    int tid_o = threadIdx.x; asm volatile("" : "+v"(tid_o));
    const int tid = tid_o, wid = __builtin_amdgcn_readfirstlane(tid >> 6), lane = tid & 63, wr = wid >> 2, wc = wid & 3, fr = lane & 15, fq = lane >> 4;
    const int K = g.K, nt = K / BK;
    unsigned voffA[2], voffB[2];
#pragma unroll
    for (int i = 0; i < 2; ++i) { int R, C; stage_rc(tid * 16 + i * 8192, R, C); const int Rb = Epi::PERM ? ((R & ~31) + perm32(R & 31)) : R;
        voffA[i] = (unsigned)(R * K + C) * 2u; voffB[i] = (unsigned)(Rb * K + C) * 2u; }
    const size_t kstep = (size_t)(BK * 2);
    const size_t hstep = (size_t)HALF * K * 2;
    const size_t tstep = 2 * hstep;
    const unsigned ldsw = (unsigned)wid * 1024u;
    const int aoff = lds_byte(wr * 64 + fr, fq * 8), boff = lds_byte(wc * 32 + fr, fq * 8);
#define PG8_SA(b, h) (((b) * 2 + (h)) * HTB)
#define PG8_SB(b, h) ((4 + (b) * 2 + (h)) * HTB)
#define PG8_STAGE(bufoff, gbase, voff) do { _Pragma("unroll") for (int _i = 0; _i < 2; ++_i) \
        __builtin_amdgcn_global_load_lds((const unsigned*)((const char*)(gbase) + (voff)[_i]), (PG8_LAS unsigned*)(lds + (bufoff) + ldsw + _i * 8192), 16, 0, 0); } while (0)
#define PG8_LDA(dst, b, h) do { _Pragma("unroll") for (int m = 0; m < 4; ++m) _Pragma("unroll") for (int k = 0; k < 2; ++k) dst[m][k] = *(const PG8_LAS bf16x8*)(lds + PG8_SA(b, h) + aoff + m * 2048 + k * 1024); } while (0)
#define PG8_LDB(dst, b, h) do { _Pragma("unroll") for (int n = 0; n < 2; ++n) _Pragma("unroll") for (int k = 0; k < 2; ++k) dst[n][k] = *(const PG8_LAS bf16x8*)(lds + PG8_SB(b, h) + boff + n * 2048 + k * 1024); } while (0)
#define PG8_MMA(ai, bj, At, Bt) do { __builtin_amdgcn_s_setprio(1); _Pragma("unroll") for (int m = 0; m < 4; ++m) _Pragma("unroll") for (int n = 0; n < 2; ++n) _Pragma("unroll") for (int k = 0; k < 2; ++k) \
        acc[ai][bj][m][n] = __builtin_amdgcn_mfma_f32_16x16x32_bf16(Bt[n][k], At[m][k], acc[ai][bj][m][n], 0, 0, 0); __builtin_amdgcn_s_setprio(0); } while (0)
#define PG8_WAIT_V(n) asm volatile("s_waitcnt vmcnt(" #n ")" ::: "memory")
#define PG8_WAIT_L(n) asm volatile("s_waitcnt lgkmcnt(" #n ")" ::: "memory")
#define PG8_BAR __builtin_amdgcn_s_barrier()
#define PG8_SCHED __builtin_amdgcn_sched_barrier(0)
    Unit cur, nxt; int ui = 0;
    if (!S.next(0, cur)) return;
    f32x4 acc[2][2][4][2];
#pragma unroll
    for (int a = 0; a < 2; ++a)
#pragma unroll
        for (int b = 0; b < 2; ++b)
#pragma unroll
            for (int m = 0; m < 4; ++m)
#pragma unroll
                for (int n = 0; n < 2; ++n) acc[a][b][m][n] = (f32x4){0.f, 0.f, 0.f, 0.f};
    bf16x8 At[4][2], B0[2][2], B1[2][2];
    const char* cA = (const char*)g.A + (size_t)cur.pm * tstep; const char* cB = (const char*)g.Bt + (size_t)cur.pn * tstep;
    S.a_ready(cur);
    if constexpr (SP2) {
        PG8_STAGE(PG8_SB(0, 0), cB, voffB); PG8_STAGE(PG8_SB(0, 1), cB + hstep, voffB); PG8_STAGE(PG8_SA(0, 0), cA, voffA); PG8_STAGE(PG8_SA(0, 1), cA + hstep, voffA);
        if (wr == 1) PG8_BAR;
        PG8_WAIT_V(2); PG8_BAR;
        PG8_STAGE(PG8_SB(1, 0), cB + kstep, voffB); PG8_STAGE(PG8_SA(1, 0), cA + kstep, voffA); PG8_STAGE(PG8_SB(1, 1), cB + hstep + kstep, voffB);
        PG8_WAIT_V(6); PG8_BAR;
    } else {
        PG8_STAGE(PG8_SB(0, 0), cB, voffB); PG8_STAGE(PG8_SA(0, 0), cA, voffA); PG8_STAGE(PG8_SB(0, 1), cB + hstep, voffB); PG8_STAGE(PG8_SA(0, 1), cA + hstep, voffA);
        if (wr == 1) PG8_BAR;
        PG8_WAIT_V(4); PG8_BAR;
        PG8_STAGE(PG8_SB(1, 0), cB + kstep, voffB); PG8_STAGE(PG8_SA(1, 0), cA + kstep, voffA); PG8_STAGE(PG8_SB(1, 1), cB + hstep + kstep, voffB);
        PG8_WAIT_V(6); PG8_BAR;
    }
    for (;;) {
        const bool has_next = S.next(ui + 1, nxt);
        const char* nA = has_next ? (const char*)g.A + (size_t)nxt.pm * tstep : cA; const char* nB = has_next ? (const char*)g.Bt + (size_t)nxt.pn * tstep : cB;
        for (int t = 0; t < nt; t += 2) {
            const bool last = (t == nt - 2);
            const char* a1 = cA + (size_t)(t + 1) * kstep;
            const char* a2 = last ? nA : cA + (size_t)(t + 2) * kstep; const char* b2 = last ? nB : cB + (size_t)(t + 2) * kstep;
            const char* a3 = a2 + kstep; const char* b3 = b2 + kstep;
            if (last && has_next) S.a_ready(nxt);
            if constexpr (SP2) {
            PG8_LDB(B0, 0, 0); PG8_LDB(B1, 0, 1); PG8_SCHED; PG8_LDA(At, 0, 0); PG8_STAGE(PG8_SA(1, 1), a1 + hstep, voffA);
            PG8_WAIT_V(8); PG8_WAIT_L(0); PG8_BAR; PG8_MMA(0, 0, At, B0); PG8_MMA(0, 1, At, B1); PG8_BAR; PG8_SCHED;
            PG8_LDA(At, 0, 1); PG8_STAGE(PG8_SB(0, 0), b2, voffB); PG8_STAGE(PG8_SB(0, 1), b2 + hstep, voffB); PG8_STAGE(PG8_SA(0, 0), a2, voffA);
            PG8_WAIT_V(8); PG8_WAIT_L(0); PG8_BAR; PG8_MMA(1, 0, At, B0); PG8_MMA(1, 1, At, B1); PG8_BAR; PG8_SCHED;
            PG8_LDB(B0, 1, 0); PG8_LDB(B1, 1, 1); PG8_SCHED; PG8_LDA(At, 1, 0); PG8_STAGE(PG8_SA(0, 1), a2 + hstep, voffA);
            PG8_WAIT_V(8); PG8_WAIT_L(0); PG8_BAR; PG8_MMA(0, 0, At, B0); PG8_MMA(0, 1, At, B1); PG8_BAR; PG8_SCHED;
            PG8_LDA(At, 1, 1); PG8_STAGE(PG8_SB(1, 0), b3, voffB); PG8_STAGE(PG8_SB(1, 1), b3 + hstep, voffB); PG8_STAGE(PG8_SA(1, 0), a3, voffA);
            PG8_WAIT_V(8); PG8_WAIT_L(0); PG8_BAR; PG8_MMA(1, 0, At, B0); PG8_MMA(1, 1, At, B1); PG8_BAR; PG8_SCHED;
            } else {
            PG8_LDB(B0, 0, 0); PG8_SCHED; PG8_LDA(At, 0, 0); PG8_STAGE(PG8_SA(1, 1), a1 + hstep, voffA);
            PG8_WAIT_L(8); PG8_BAR; PG8_WAIT_L(0); PG8_MMA(0, 0, At, B0); PG8_BAR; PG8_SCHED;
            PG8_LDB(B1, 0, 1); PG8_STAGE(PG8_SB(0, 0), b2, voffB);
            PG8_BAR; PG8_WAIT_L(0); PG8_MMA(0, 1, At, B1); PG8_BAR;
            PG8_LDA(At, 0, 1); PG8_STAGE(PG8_SA(0, 0), a2, voffA);
            PG8_BAR; PG8_WAIT_L(0); PG8_MMA(1, 0, At, B0); PG8_BAR; PG8_SCHED;
            PG8_STAGE(PG8_SB(0, 1), b2 + hstep, voffB);
            PG8_WAIT_V(6); PG8_BAR; PG8_MMA(1, 1, At, B1); PG8_BAR;
            PG8_LDB(B0, 1, 0); PG8_SCHED; PG8_LDA(At, 1, 0); PG8_STAGE(PG8_SA(0, 1), a2 + hstep, voffA);
            PG8_WAIT_L(8); PG8_BAR; PG8_WAIT_L(0); PG8_MMA(0, 0, At, B0); PG8_BAR; PG8_SCHED;
            PG8_LDB(B1, 1, 1); PG8_STAGE(PG8_SB(1, 0), b3, voffB);
            PG8_BAR; PG8_WAIT_L(0); PG8_MMA(0, 1, At, B1); PG8_BAR;
            PG8_LDA(At, 1, 1); PG8_STAGE(PG8_SA(1, 0), a3, voffA);
            PG8_BAR; PG8_WAIT_L(0); PG8_MMA(1, 0, At, B0); PG8_BAR; PG8_SCHED;
            PG8_STAGE(PG8_SB(1, 1), b3 + hstep, voffB);
            PG8_WAIT_V(6); PG8_BAR; PG8_MMA(1, 1, At, B1); PG8_BAR;
            }
        }
        if constexpr (ALIGN_EPI) { if (wr == 0) PG8_BAR; }
        if constexpr (!Epi::AFTER_DRAIN) { E(acc, cur, wr, wc, fr, fq); S.done(cur); }
        if (!has_next) break;
#pragma unroll
        for (int a = 0; a < 2; ++a)
#pragma unroll
            for (int b = 0; b < 2; ++b)
#pragma unroll
                for (int m = 0; m < 4; ++m)
#pragma unroll
                    for (int n = 0; n < 2; ++n) acc[a][b][m][n] = (f32x4){0.f, 0.f, 0.f, 0.f};
        cur = nxt; cA = nA; cB = nB; ++ui;
        if constexpr (ALIGN_EPI) { if (wr == 1) PG8_BAR; }
    }
    PG8_WAIT_V(0);
    if constexpr (!ALIGN_EPI) { if (wr == 0) PG8_BAR; }
    PG8_BAR;
    if constexpr (Epi::AFTER_DRAIN) { E.fused(acc, cur, wr, wc, fr, fq, lds, wid, lane); S.done(cur); }
#undef PG8_SA
#undef PG8_SB
#undef PG8_STAGE
#undef PG8_LDA
#undef PG8_LDB
#undef PG8_MMA
#undef PG8_WAIT_V
#undef PG8_WAIT_L
#undef PG8_BAR
#undef PG8_SCHED
}
}
namespace pg8 {
struct EpiRowScaleBf16 {
    static constexpr bool PERM = true, AFTER_DRAIN = false;
    bf16_t* O; int ldc; const float* rs;
    __device__ __forceinline__ void operator()(const f32x4 (&acc)[2][2][4][2], const Unit& u, int wr, int wc, int fr, int fq) const {
        const int row0 = u.pm * BM + wr * 64 + fr; const int col0 = u.pn * BM + wc * 32 + 8 * fq;
#pragma unroll
        for (int ai = 0; ai < 2; ++ai)
#pragma unroll
            for (int m = 0; m < 4; ++m) { const int row = row0 + ai * HALF + m * 16; const float sc = rs[row]; bf16_t* rowp = O + (size_t)row * ldc + col0;
#pragma unroll
                for (int bj = 0; bj < 2; ++bj) { f32x4 v0 = acc[ai][bj][m][0] * sc, v1 = acc[ai][bj][m][1] * sc;
                    u32x4 w; w.x = cvt_pk_bf16(v0[0], v0[1]); w.y = cvt_pk_bf16(v0[2], v0[3]); w.z = cvt_pk_bf16(v1[0], v1[1]); w.w = cvt_pk_bf16(v1[2], v1[3]);
                    *(u32x4*)(rowp + bj * HALF) = w; } }
    }
};
struct EpiResF32 {
    static constexpr bool PERM = false, AFTER_DRAIN = false;
    const float* base; float* out; int ldc;
    __device__ __forceinline__ void operator()(const f32x4 (&acc)[2][2][4][2], const Unit& u, int wr, int wc, int fr, int fq) const {
        const int col0 = u.pn * BM + wc * 32 + 4 * fq;
#pragma unroll
        for (int ai = 0; ai < 2; ++ai)
#pragma unroll
            for (int m = 0; m < 4; ++m) { const int r = u.pm * BM + ai * HALF + wr * 64 + m * 16 + fr; const size_t off = (size_t)r * ldc + col0;
#pragma unroll
                for (int bj = 0; bj < 2; ++bj)
#pragma unroll
                    for (int n = 0; n < 2; ++n) { const f32x4 bs = *(const f32x4*)(base + off + bj * HALF + n * 16); *(f32x4*)(out + off + bj * HALF + n * 16) = bs + acc[ai][bj][m][n]; } }
    }
};
}

constexpr int NB = 4, T = 8192, D = 1024, M = NB * T;
constexpr int NP = 3584;
constexpr int W_IN_COLS = 3596;
constexpr int C_R = 0, C_K = 512, C_V = 1024, C_G = 1536, C_WD = 2048, C_AD = 2112, C_NQ = 2176, C_NG = 2432, C_KC = 2688, C_VC = 2752,
              C_KS = 2816, C_VS = 2880, C_KW = 2944, C_VW = 3008, C_MQ = 3072, C_MG = 3328;
constexpr int GLOG_SRC = 2688;
constexpr int NCMP = 511, NSEL = 128, MEML = 256;

constexpr size_t MiB = 1u << 20;
constexpr size_t WS_CTL = 0, CTL_ZERO_BYTES = 1 * MiB;
constexpr size_t WS_WIN = 1 * MiB, WS_WOUT = 8 * MiB;
constexpr size_t KiB = 1024;
constexpr size_t WS_ROPE = 10 * MiB, WS_RS = 10 * MiB + 512 * KiB, WS_W1TK = 10 * MiB + 768 * KiB, WS_KCMP = 11 * MiB, WS_VCMP = 11 * MiB + 256 * KiB, WS_W1TV = 11 * MiB + 512 * KiB,
                 WS_WUPT = 11 * MiB + 768 * KiB, WS_AUPT = 11 * MiB + 832 * KiB, WS_W2TK = 11 * MiB + 896 * KiB, WS_W2TV = 11 * MiB + 904 * KiB, WS_MEMKV = 12 * MiB, WS_WKVT = 13 * MiB, WS_GLOG = 14 * MiB, WS_MEMN = 304 * MiB  ;
constexpr size_t WS_P = 16 * MiB, WS_XB = 240 * MiB, WS_CHK_PR = 240 * MiB, WS_Y = 304 * MiB, WS_A = 368 * MiB, WS_CHK_S = 368 * MiB, WS_LW = 400 * MiB, WS_CHK_QY = 432 * MiB, WS_BONUS = 496 * MiB, WS_OTP = 400 * MiB  , WS_END = 497 * MiB;
constexpr int CW_BAR = 4096;

constexpr int RING_BYTES = 131072, LDSCTL_OFF = RING_BYTES, MISC_OFF = LDSCTL_OFF + 320, LDS_BYTES = 147456;
constexpr int NWAVES = 8;

#define GAS __attribute__((address_space(1)))
#define LAS __attribute__((address_space(3)))
typedef unsigned short bf16;
typedef unsigned v4u __attribute__((ext_vector_type(4)));
typedef unsigned v2u __attribute__((ext_vector_type(2)));
typedef float f32x4 __attribute__((ext_vector_type(4)));
#define LDS_WAIT() asm volatile("s_waitcnt lgkmcnt(0)" ::: "memory")
__device__ __forceinline__ unsigned f2bf(float f) { unsigned u = __builtin_bit_cast(unsigned, f); return (u + 0x7fffu + ((u >> 16) & 1u)) >> 16; }
__device__ __forceinline__ unsigned pk2(float lo, float hi) { return f2bf(lo) | (f2bf(hi) << 16); }
__device__ __forceinline__ float bf2f(unsigned short h) { return __builtin_bit_cast(float, (unsigned)h << 16); }
__device__ __forceinline__ float bflo(unsigned u) { return __builtin_bit_cast(float, u << 16); }
__device__ __forceinline__ float bfhi(unsigned u) { return __builtin_bit_cast(float, u & 0xffff0000u); }
__device__ __forceinline__ void unpack8(const v4u v, float (&f)[8]) { f[0] = bflo(v.x); f[1] = bfhi(v.x); f[2] = bflo(v.y); f[3] = bfhi(v.y); f[4] = bflo(v.z); f[5] = bfhi(v.z); f[6] = bflo(v.w); f[7] = bfhi(v.w); }
__device__ __forceinline__ v4u pack8(const float (&f)[8]) { v4u o; o.x = pk2(f[0], f[1]); o.y = pk2(f[2], f[3]); o.z = pk2(f[4], f[5]); o.w = pk2(f[6], f[7]); return o; }
__device__ __forceinline__ float rdlane(float v, int l) { return __builtin_bit_cast(float, __builtin_amdgcn_readlane(__builtin_bit_cast(int, v), l)); }
template <int CTRL> __device__ __forceinline__ float dppf(float v) { return __builtin_bit_cast(float, __builtin_amdgcn_update_dpp(0, __builtin_bit_cast(int, v), CTRL, 0xf, 0xf, true)); }
__device__ __forceinline__ float sum8(float x) { x += dppf<0xB1>(x); x += dppf<0x4E>(x); x += dppf<0x141>(x); return x; }
__device__ __forceinline__ float wave_sum(float v) {
    v += dppf<0xB1>(v); v += dppf<0x4E>(v); v += dppf<0x141>(v); v += dppf<0x140>(v);
    return (rdlane(v, 0) + rdlane(v, 16)) + (rdlane(v, 32) + rdlane(v, 48));
}
__device__ __forceinline__ float xrow_max(float v) { v = fmaxf(v, __shfl_xor(v, 16)); v = fmaxf(v, __shfl_xor(v, 32)); return v; }
__device__ __forceinline__ float xrow_sum(float v) { v += __shfl_xor(v, 16); v += __shfl_xor(v, 32); return v; }
__device__ __forceinline__ float siluf(float x) { return x / (1.f + __expf(-x)); }
__device__ __forceinline__ float sigmf(float x) { return 1.f / (1.f + __expf(-x)); }

#define XB_TMO      128
#define XB_XCNT(j)  (256  + 64 * (j))
#define XB_XSUB(j)  (1280 + 64 * (j))
#define XB_XGEN(j)  (2304 + 64 * (j))
#define XB_TOP      3328
#define XB_TOPGEN   3392
#define XCD_BAR_WORDS 3456
#define XB_SPIN_CAP (1u << 20)
__device__ __forceinline__ unsigned xb_ld(unsigned* p)              { return __hip_atomic_load(p, __ATOMIC_RELAXED, __HIP_MEMORY_SCOPE_AGENT); }
__device__ __forceinline__ unsigned xb_add(unsigned* p, unsigned v) { return __hip_atomic_fetch_add(p, v, __ATOMIC_RELAXED, __HIP_MEMORY_SCOPE_AGENT); }
__device__ __forceinline__ unsigned xb_xcc_id() { return (unsigned)__builtin_amdgcn_s_getreg((3 << 11) | 20) & 0xFu; }
#define XB_SPIN(cond, bar) do { unsigned _sp = 0; while (cond) { __builtin_amdgcn_s_sleep(1); \
    if ((++_sp & 255u) == 0u) { if (xb_ld(&(bar)[XB_TMO])) break; if (_sp > XB_SPIN_CAP) { atomicAdd(&(bar)[XB_TMO], 1u); break; } } } } while (0)
struct XcdBarrier { unsigned* bar; unsigned x; volatile LAS unsigned* st; };
__device__ __forceinline__ XcdBarrier xcd_barrier_post(unsigned* bar, volatile LAS unsigned* st) {
    XcdBarrier b; b.bar = bar; b.x = xb_xcc_id(); b.st = st;
    if (threadIdx.x == 0) (void)xb_add(&bar[XB_XCNT(b.x)], 1u);
    return b;
}
__device__ __forceinline__ void xcd_barrier_complete(unsigned* bar, unsigned x, unsigned& nloc, unsigned& nx) {
    const unsigned G = gridDim.x * gridDim.y * gridDim.z;
    unsigned sum, cnt, mine, sp = 0u;
    for (;;) {
        sum = 0u; cnt = 0u; mine = 0u;
#pragma unroll
        for (unsigned j = 0; j < 16; ++j) { const unsigned c = xb_ld(&bar[XB_XCNT(j)]); sum += c; cnt += (c > 0u) ? 1u : 0u; mine = (j == x) ? c : mine; }
        if (sum == G) break;
        __builtin_amdgcn_s_sleep(1);
        if ((++sp & 255u) == 0u) { if (xb_ld(&bar[XB_TMO])) break; if (sp > XB_SPIN_CAP) { atomicAdd(&bar[XB_TMO], 1u); break; } }
    }
    nloc = mine > 0u ? mine : 1u; nx = cnt > 0u ? cnt : 1u;
}
__device__ __forceinline__ void xcd_barrier(const XcdBarrier& b) {
    asm volatile("s_waitcnt vmcnt(0)" ::: "memory");
    __syncthreads();
    if (threadIdx.x == 0) {
        unsigned* bar = b.bar;
        __builtin_amdgcn_s_waitcnt(0);
        unsigned nloc = b.st[0], nx = b.st[1];
        if (nloc == 0u) { xcd_barrier_complete(bar, b.x, nloc, nx); b.st[0] = nloc; b.st[1] = nx; }
        const unsigned old = xb_add(&bar[XB_XSUB(b.x)], 1u);
        const unsigned gen = old / nloc;
        if (old + 1u == (gen + 1u) * nloc) {
            __builtin_amdgcn_fence(__ATOMIC_RELEASE, "agent");
            asm volatile("s_waitcnt vmcnt(0)" ::: "memory");
            const unsigned og = xb_add(&bar[XB_TOP], 1u);
            const unsigned tg = og / nx;
            if (og + 1u == (tg + 1u) * nx) xb_add(&bar[XB_TOPGEN], 1u);
            else XB_SPIN(xb_ld(&bar[XB_TOPGEN]) == tg, bar);
            __builtin_amdgcn_fence(__ATOMIC_ACQUIRE, "agent");
            xb_add(&bar[XB_XGEN(b.x)], 1u);
            asm volatile("s_waitcnt vmcnt(0)" ::: "memory");
        } else {
            XB_SPIN(xb_ld(&bar[XB_XGEN(b.x)]) == gen, bar);
            __builtin_amdgcn_fence(__ATOMIC_ACQUIRE, "agent");
            asm volatile("s_waitcnt vmcnt(0)" ::: "memory");
        }
    }
    __syncthreads();
}

struct Args { const float* in[26]; float* out; unsigned char* ws; };

__device__ __forceinline__ void p0_transpose_item(const float* W, int ldw, int src_col0, const float* kscale, bf16* WT, int K, int dst_row0, int k0, LAS float* scr, int lane) {
#pragma unroll 8
    for (int i = 0; i < 32; ++i) { const int kk = 2 * i + (lane >> 5); float v = W[(size_t)(k0 + kk) * ldw + src_col0 + (lane & 31)]; if (kscale) v *= kscale[k0 + kk]; scr[kk * 33 + (lane & 31)] = v; }
    LDS_WAIT(); asm volatile("" ::: "memory");
    const int c = lane & 7;
#pragma unroll
    for (int j = 0; j < 4; ++j) { const int n = (lane >> 3) + 8 * j; const LAS float* s = scr + (8 * c) * 33 + n;
        v4u o; o.x = pk2(s[0 * 33], s[1 * 33]); o.y = pk2(s[2 * 33], s[3 * 33]); o.z = pk2(s[4 * 33], s[5 * 33]); o.w = pk2(s[6 * 33], s[7 * 33]);
        *(v4u*)(WT + (size_t)(dst_row0 + n) * K + k0 + 8 * c) = o; }
    LDS_WAIT(); asm volatile("" ::: "memory");
}
__device__ __forceinline__ double rope_inv_freq(int i) {
    return i == 0 ? 1.0 : i == 1 ? 0.19392274474868576 : i == 2 ? 0.03760603093086393 : i == 3 ? 0.007292664737217109 : i == 4 ? 0.001414213562373095 :
           i == 5 ? 0.0002742481756762073 : i == 6 ? 5.318295896944988e-05 : 1.031338537721246e-05;
}
__device__ __forceinline__ void rope_cs(int pos, int i, float& c, float& s) {
    const double ang = (double)pos * rope_inv_freq(i);
    const double n = __builtin_rint(ang * 0.15915494309189535);
    const double r = __builtin_fma(-n, 6.283185307179586, ang);
    const double kq = __builtin_rint(r * 0.6366197723675814);
    const double y = __builtin_fma(-kq, 1.5707963267948966, r);
    const double y2 = y * y;
    const double sy = y * (1.0 + y2 * (-1.0 / 6 + y2 * (1.0 / 120 + y2 * (-1.0 / 5040 + y2 * (1.0 / 362880 - y2 * (1.0 / 39916800))))));
    const double cy = 1.0 + y2 * (-0.5 + y2 * (1.0 / 24 + y2 * (-1.0 / 720 + y2 * (1.0 / 40320 + y2 * (-1.0 / 3628800 + y2 * (1.0 / 479001600))))));
    const int q = ((int)kq) & 3;
    const double cc = q == 0 ? cy : q == 1 ? -sy : q == 2 ? -cy : sy;
    const double ss = q == 0 ? sy : q == 1 ? cy : q == 2 ? -sy : -cy;
    c = (float)cc; s = (float)ss;
}

#ifndef REPEAT
#define REPEAT 0
#endif
#define RPT(k) (((REPEAT >> (k)) & 1) ? 2 : 1)

typedef short bf16x8 __attribute__((ext_vector_type(8)));
typedef short v4i16 __attribute__((ext_vector_type(4)));
#define MFMA16(a, b, c) __builtin_amdgcn_mfma_f32_16x16x32_bf16(a, b, c, 0, 0, 0)
constexpr int AT_SLOT = 16384, AT_RING = 3 * AT_SLOT, AT_IMP = AT_RING, AT_IMP_W = 8448, AT_SELM = AT_IMP + 8 * AT_IMP_W, AT_TILEM = AT_SELM + 1024, AT_LIST = AT_TILEM + 16, AT_NB = AT_LIST + 544;
constexpr float SM_C = 0.125f * 1.4426950408889634f;
#define AT_WAITBAR(N) asm volatile("s_waitcnt vmcnt(" #N ") lgkmcnt(0)\n\ts_barrier" ::: "memory")

struct Grp { bf16x8 q[2]; f32x4 o[4]; float m, l; };

__device__ __forceinline__ void glds16(const void* gsrc, unsigned lds_dst) { unsigned keep;
    asm volatile("s_mov_b32 %0, m0\n\ts_mov_b32 m0, %2\n\ts_nop 0\n\tglobal_load_lds_dwordx4 %1, off\n\ts_mov_b32 m0, %0" : "=&s"(keep) : "v"(gsrc), "s"(lds_dst) : "memory"); }
__device__ __forceinline__ void at_dma(const bf16* kb, size_t kpitch, const bf16* vb, size_t vpitch, LAS unsigned char* slot, int tid, int wave, bool withV) {
    const int r = tid >> 3, c = (tid & 7) ^ (2 * ((r >> 1) & 3));
    const unsigned dst = (unsigned)__builtin_amdgcn_readfirstlane((int)((unsigned)(size_t)slot + (unsigned)wave * 1024u));
    glds16(kb + (size_t)r * kpitch + c * 8, dst);
    if (withV) glds16(vb + (size_t)r * vpitch + c * 8, dst + 8192u);
}
__device__ __forceinline__ unsigned cvtpk(float lo, float hi) { typedef float f2 __attribute__((ext_vector_type(2))); typedef __bf16 b2 __attribute__((ext_vector_type(2))); f2 v = {lo, hi}; b2 b = __builtin_convertvector(v, b2); return __builtin_bit_cast(unsigned, b); }
__device__ __forceinline__ float fmax3(float a, float b, float c) { return fmaxf(fmaxf(a, b), c); }

template <int NG, int MODE>
__device__ __forceinline__ void at_block(Grp (&G)[NG], LAS const unsigned char* slot, int koff0, int koff1, const int (&vdt)[4], int g, const int (&lo)[NG], const int (&hi)[NG], const bool (&need)[NG], bool partial,
                                         LAS float* impA, LAS float* impB, int sb0, int lane) {
    bf16x8 kf[4][2];
#pragma unroll
    for (int kt = 0; kt < 4; ++kt) { kf[kt][0] = *(const LAS bf16x8*)(slot + kt * 2048 + koff0); kf[kt][1] = *(const LAS bf16x8*)(slot + kt * 2048 + koff1); }
    bf16x8 pf[NG][2];
#pragma unroll
    for (int gi = 0; gi < NG; ++gi) {
        if (!need[gi]) continue;
        f32x4 s[4];
#pragma unroll
        for (int kt = 0; kt < 4; ++kt) { s[kt] = (f32x4){0.f, 0.f, 0.f, 0.f}; s[kt] = MFMA16(kf[kt][0], G[gi].q[0], s[kt]); s[kt] = MFMA16(kf[kt][1], G[gi].q[1], s[kt]); }
        if (partial) {
#pragma unroll
            for (int kt = 0; kt < 4; ++kt)
#pragma unroll
                for (int r = 0; r < 4; ++r) { const int kl = 16 * kt + 4 * g + r; if (kl < lo[gi] || kl > hi[gi]) s[kt][r] = -INFINITY; }
        }
        float mref;
        if (MODE != 1) {
            float mx = fmax3(s[0][0], s[0][1], s[0][2]); mx = fmax3(mx, s[0][3], s[1][0]); mx = fmax3(mx, s[1][1], s[1][2]); mx = fmax3(mx, s[1][3], s[2][0]);
            mx = fmax3(mx, s[2][1], s[2][2]); mx = fmax3(mx, s[2][3], s[3][0]); mx = fmax3(mx, s[3][1], s[3][2]); mx = fmaxf(mx, s[3][3]);
            mx = xrow_max(mx);
            const float mn = fmaxf(G[gi].m, mx * SM_C);
            const float alpha = __builtin_amdgcn_exp2f(G[gi].m - mn);
            G[gi].m = mn; mref = mn;
            if (__builtin_amdgcn_ballot_w64(alpha != 1.0f)) {
                G[gi].l *= alpha;
                if (MODE == 2) {
#pragma unroll
                    for (int dt = 0; dt < 4; ++dt) G[gi].o[dt] *= alpha; }
            }
        } else mref = G[gi].m;
        float lsum = 0.f;
#pragma unroll
        for (int kt = 0; kt < 4; ++kt)
#pragma unroll
            for (int r = 0; r < 4; ++r) { const float p = __builtin_amdgcn_exp2f(__builtin_fmaf(s[kt][r], SM_C, -mref)); s[kt][r] = p; lsum += p; }
        if (MODE != 1) G[gi].l += lsum;
        if (MODE == 1) {
            const float il = G[gi].l;
#pragma unroll
            for (int kt = 0; kt < 4; ++kt) { s[kt] *= il;
                float a = s[kt][0] + s[kt][1] + s[kt][2] + 0.5f * s[kt][3], b = 0.5f * s[kt][3];
                a += dppf<0xB1>(a); a += dppf<0x4E>(a); b += dppf<0xB1>(b); b += dppf<0x4E>(b);
                if ((lane & 3) == 0) { const int q8 = gi * 4 + ((lane & 15) >> 2); impA[q8 * 132 + sb0 + 4 * kt + g] = a; impB[q8 * 132 + sb0 + 4 * kt + g + 1] = b; } }
        }
        if (MODE != 0) {
            pf[gi][0] = __builtin_bit_cast(bf16x8, (v4u){cvtpk(s[0][0], s[0][1]), cvtpk(s[0][2], s[0][3]), cvtpk(s[1][0], s[1][1]), cvtpk(s[1][2], s[1][3])});
            pf[gi][1] = __builtin_bit_cast(bf16x8, (v4u){cvtpk(s[2][0], s[2][1]), cvtpk(s[2][2], s[2][3]), cvtpk(s[3][0], s[3][1]), cvtpk(s[3][2], s[3][3])});
        }
    }
    if (MODE != 0) {
        LAS const unsigned char* vs = slot + 8192;
#pragma unroll
        for (int dt = 0; dt < 4; ++dt) {
            bf16x8 vf[2];
#pragma unroll
            for (int kp = 0; kp < 2; ++kp) {
                const v4i16 a = __builtin_amdgcn_ds_read_tr16_b64_v4i16((LAS v4i16*)(vs + vdt[dt] + (2 * kp) * 2048));
                const v4i16 b = __builtin_amdgcn_ds_read_tr16_b64_v4i16((LAS v4i16*)(vs + vdt[dt] + (2 * kp + 1) * 2048));
                vf[kp] = (bf16x8){a[0], a[1], a[2], a[3], b[0], b[1], b[2], b[3]};
            }
#pragma unroll
            for (int gi = 0; gi < NG; ++gi) if (need[gi]) { G[gi].o[dt] = MFMA16(vf[0], pf[gi][0], G[gi].o[dt]); G[gi].o[dt] = MFMA16(vf[1], pf[gi][1], G[gi].o[dt]); }
        }
    }
}

template <int N> __device__ __forceinline__ void at_waitbar_blocks(int ahead, bool withv) {
    if (withv) { switch (ahead) { case 0: AT_WAITBAR(0); break; case 1: AT_WAITBAR(2); break; case 2: AT_WAITBAR(4); break; case 3: AT_WAITBAR(6); break; default: AT_WAITBAR(8); break; } }
    else { switch (ahead) { case 0: AT_WAITBAR(0); break; case 1: AT_WAITBAR(1); break; case 2: AT_WAITBAR(2); break; case 3: AT_WAITBAR(3); break; default: AT_WAITBAR(4); break; } }
}
template <bool WITHV, int NSLOT, class Src, class Body>
__device__ __forceinline__ void at_ring(LAS unsigned char* ring, int nb, int tid, int wave, const Src& src, Body& body) {
    const bf16 *kb = nullptr, *vb = nullptr; size_t kp = 0, vp = 0;
#pragma unroll
    for (int j = 0; j < NSLOT - 1; ++j) if (j < nb) { src(j, kb, kp, vb, vp); at_dma(kb, kp, vb, vp, ring + j * AT_SLOT, tid, wave, WITHV); }
    int sl = 0, sn = NSLOT - 1;
    for (int i = 0; i < nb; ++i) {
        const int last = (i + NSLOT - 2 < nb - 1) ? i + NSLOT - 2 : nb - 1;
        at_waitbar_blocks<NSLOT>(last - i, WITHV);
        if (i + NSLOT - 1 < nb) { src(i + NSLOT - 1, kb, kp, vb, vp); at_dma(kb, kp, vb, vp, ring + sn * AT_SLOT, tid, wave, WITHV); }
        body(i, ring + sl * AT_SLOT);
        sl = (sl + 1 == NSLOT) ? 0 : sl + 1; sn = (sn + 1 == NSLOT) ? 0 : sn + 1;
    }
    AT_WAITBAR(0);
}

struct LaneGeo { int lane, i16, g, koff0, koff1; int vdt[4]; };
__device__ __forceinline__ LaneGeo make_geo(int lane) {
    LaneGeo L; L.lane = lane; L.i16 = lane & 15; L.g = lane >> 4;
    const int swz = 2 * ((L.i16 >> 1) & 3);
    L.koff0 = L.i16 * 128 + (((0 ^ (swz >> 2)) * 4 + (L.g ^ (swz & 3))) * 16);
    L.koff1 = L.i16 * 128 + (((1 ^ (swz >> 2)) * 4 + (L.g ^ (swz & 3))) * 16);
    const int sv = (2 * L.g + (L.i16 >> 3)) & 3; const int vbase = (4 * L.g + (L.i16 >> 2)) * 128 + 8 * (L.i16 & 1) + ((L.i16 & 3) >> 1) * 16;
#pragma unroll
    for (int dt = 0; dt < 4; ++dt) L.vdt[dt] = vbase + ((dt ^ sv) << 5);
    return L;
}
__device__ __forceinline__ float xg_sum(float v) { return xrow_sum(v); }

struct SrcCmp { const bf16* K; const bf16* V; int b; __device__ __forceinline__ void operator()(int i, const bf16*& kb, size_t& kp, const bf16*& vb, size_t& vp) const {
    kb = K + (size_t)(b * 512 + 64 * i) * 64; kp = 64; vb = V + (size_t)(b * 512 + 64 * i) * 64; vp = 64; } };
struct SrcSel { const bf16* P; LAS const unsigned* list; bool use_list; int b; int kcol, vcol; int s0;
    __device__ __forceinline__ void operator()(int i, const bf16*& kb, size_t& kp, const bf16*& vb, size_t& vp) const {
        const int s = use_list ? (int)__builtin_amdgcn_readfirstlane(list[i]) : s0 + i; const bf16* base = P + (size_t)(b * T + 64 * s) * NP; kb = base + kcol; vb = base + vcol; kp = NP; vp = NP; } };

struct BodyCmp0 { Grp (&G)[2]; const LaneGeo& L; const int (&nv)[2];
    __device__ __forceinline__ void operator()(int i, LAS const unsigned char* slot) {
        const int lo[2] = {0, 0}; const int hi[2] = {nv[0] - 64 * i - 1, nv[1] - 64 * i - 1}; const bool need[2] = {true, true};
        const bool partial = __builtin_amdgcn_ballot_w64(hi[0] < 63 || hi[1] < 63) != 0ull;
        at_block<2, 0>(G, slot, L.koff0, L.koff1, L.vdt, L.g, lo, hi, need, partial, nullptr, nullptr, 0, L.lane); } };
struct BodyCmp1 { Grp (&G)[2]; const LaneGeo& L; const int (&nv)[2]; LAS float* impA; LAS float* impB;
    __device__ __forceinline__ void operator()(int i, LAS const unsigned char* slot) {
        const int lo[2] = {0, 0}; const int hi[2] = {nv[0] - 64 * i - 1, nv[1] - 64 * i - 1}; const bool need[2] = {true, true};
        const bool partial = __builtin_amdgcn_ballot_w64(hi[0] < 63 || hi[1] < 63) != 0ull;
        at_block<2, 1>(G, slot, L.koff0, L.koff1, L.vdt, L.g, lo, hi, need, partial, impA, impB, 16 * i, L.lane); } };
struct BodySel { Grp (&G)[2]; const LaneGeo& L; LAS const unsigned* list; LAS const unsigned* selm; const int (&tql)[2]; int cur;
    __device__ __forceinline__ void operator()(int i, LAS const unsigned char* slot) {
        const int s = (int)__builtin_amdgcn_readfirstlane(list[i]); const int w = s >> 5, bit = s & 31;
        int lo[2] = {0, 0}, hi[2]; bool need[2];
#pragma unroll
        for (int gi = 0; gi < 2; ++gi) { const unsigned word = selm[tql[gi] * 4 + w]; const bool on = (word >> bit) & 1u;
            hi[gi] = on ? (s == cur ? tql[gi] : 63) : -1; need[gi] = __builtin_amdgcn_ballot_w64(on) != 0ull; }
        if (!need[0] && !need[1]) return;
        const bool partial = __builtin_amdgcn_ballot_w64((need[0] && hi[0] < 63) || (need[1] && hi[1] < 63)) != 0ull;
        at_block<2, 2>(G, slot, L.koff0, L.koff1, L.vdt, L.g, lo, hi, need, partial, nullptr, nullptr, 0, L.lane); } };
struct BodyWin { Grp (&G)[2]; const LaneGeo& L; const int (&tql)[2]; int cur, s0;
    __device__ __forceinline__ void operator()(int i, LAS const unsigned char* slot) {
        const int s = s0 + i; int lo[2], hi[2]; const bool need[2] = {true, true};
#pragma unroll
        for (int gi = 0; gi < 2; ++gi) { lo[gi] = (s == cur - 8) ? tql[gi] + 1 : 0; hi[gi] = (s == cur) ? tql[gi] : 63; }
        const bool partial = (s == cur) || (s == cur - 8);
        at_block<2, 2>(G, slot, L.koff0, L.koff1, L.vdt, L.g, lo, hi, need, partial, nullptr, nullptr, 0, L.lane); } };

__device__ __forceinline__ void grp_reset(Grp& g) { g.m = -1e30f; g.l = 0.f;
#pragma unroll
    for (int dt = 0; dt < 4; ++dt) g.o[dt] = (f32x4){0.f, 0.f, 0.f, 0.f}; }

__device__ __forceinline__ void nsa_unit(int b, int cur, LAS unsigned char* lds, int tid, int wave, int lane, const bf16* P, const bf16* KCMPb, const bf16* VCMPb, const float* GLOG, const float* gate_b,
                                         const float* nsa_out_g, const float* ROPE, bf16* Y, float* otp_wave) {
    LAS unsigned char* ring = lds;
    LAS float* impA = (LAS float*)(lds + AT_IMP + wave * AT_IMP_W); LAS float* impB = impA + 8 * 132;
    LAS unsigned* selm = (LAS unsigned*)(lds + AT_SELM); LAS unsigned* tilem = (LAS unsigned*)(lds + AT_TILEM); LAS unsigned* blist = (LAS unsigned*)(lds + AT_LIST); LAS unsigned* nbw = (LAS unsigned*)(lds + AT_NB);
    const LaneGeo L = make_geo(lane);
    const int t0 = cur * 64; const size_t m0 = (size_t)b * T + t0;
    const int h = L.i16 & 3;
    int tql[2]; tql[0] = 8 * wave + (L.i16 >> 2); tql[1] = tql[0] + 4;
    if (tid < 4) tilem[tid] = 0u;
    Grp G[2]; int nv[2];
    float* otp = otp_wave + lane;
#pragma unroll
    for (int gi = 0; gi < 2; ++gi) {
        const bf16* qp = P + (m0 + tql[gi]) * NP + C_NQ + h * 64 + 8 * L.g;
        G[gi].q[0] = *(const bf16x8*)qp; G[gi].q[1] = *(const bf16x8*)(qp + 32);
        const int tq = t0 + tql[gi]; nv[gi] = tq >= 31 ? min((tq - 31) / 16 + 1, NCMP) : 0;
        grp_reset(G[gi]);
    }
    for (int i = lane; i < 2 * 8 * 132; i += 64) impA[i] = 0.f;
    const int nvmax = (t0 + 63 >= 31) ? min((t0 + 63 - 31) / 16 + 1, NCMP) : 0; const int nblk = (nvmax + 63) >> 6;
    for (int rp_ = 0; rp_ < RPT(8); ++rp_) { grp_reset(G[0]); grp_reset(G[1]); SrcCmp src{KCMPb, VCMPb, b}; BodyCmp0 body{G, L, nv}; at_ring<false, 3>(ring, nblk, tid, wave, src, body); }
#pragma unroll
    for (int gi = 0; gi < 2; ++gi) { const float lt = xg_sum(G[gi].l); G[gi].l = 1.0f / fmaxf(lt, 1e-30f); }
    for (int rp_ = 0; rp_ < RPT(9); ++rp_) {
#pragma unroll
        for (int gi = 0; gi < 2; ++gi)
#pragma unroll
            for (int dt = 0; dt < 4; ++dt) G[gi].o[dt] = (f32x4){0.f, 0.f, 0.f, 0.f};
        SrcCmp src{KCMPb, VCMPb, b}; BodyCmp1 body{G, L, nv, impA, impB}; at_ring<true, 3>(ring, nblk, tid, wave, src, body); }
    for (int rp_ = 0; rp_ < RPT(10); ++rp_) {
        unsigned long long accA = 0ull, accB = 0ull;
        const unsigned long long validA = cur >= 63 ? ~0ull : ((1ull << (cur + 1)) - 1ull), validB = cur < 64 ? 0ull : (cur >= 127 ? ~0ull : ((1ull << (cur - 63)) - 1ull));
#pragma unroll 1
        for (int q8 = 0; q8 < 8; ++q8) {
            const float fa = impA[q8 * 132 + lane] + impB[q8 * 132 + lane], fb = impA[q8 * 132 + 64 + lane] + impB[q8 * 132 + 64 + lane];
            const int sa = lane, sb = lane + 64;
            unsigned va = __builtin_bit_cast(unsigned, fa), vb = __builtin_bit_cast(unsigned, fb);
            if (sa == 0 || sa == cur || sa == cur - 1) va = 0x7f000000u; else if (sa > cur) va = 0u;
            if (sb == cur || sb == cur - 1) vb = 0x7f000000u; else if (sb > cur) vb = 0u;
            unsigned tau = 0u;
#pragma unroll 1
            for (int bit = 30; bit >= 0; --bit) { const unsigned cand = tau | (1u << bit);
                const int cnt = __builtin_popcountll(__builtin_amdgcn_ballot_w64(va >= cand)) + __builtin_popcountll(__builtin_amdgcn_ballot_w64(vb >= cand));
                if (cnt >= 16) tau = cand; }
            const unsigned long long gtA = __builtin_amdgcn_ballot_w64(va > tau), gtB = __builtin_amdgcn_ballot_w64(vb > tau);
            const unsigned long long eqA = __builtin_amdgcn_ballot_w64(va == tau), eqB = __builtin_amdgcn_ballot_w64(vb == tau);
            const int needn = 16 - __builtin_popcountll(gtA) - __builtin_popcountll(gtB); const int nA = __builtin_popcountll(eqA);
            const int takeA = min(needn, nA), takeB = needn - takeA;
            const int rA = __builtin_amdgcn_mbcnt_hi((unsigned)(eqA >> 32), __builtin_amdgcn_mbcnt_lo((unsigned)eqA, 0));
            const int rB = __builtin_amdgcn_mbcnt_hi((unsigned)(eqB >> 32), __builtin_amdgcn_mbcnt_lo((unsigned)eqB, 0));
            const unsigned long long selA = (gtA | __builtin_amdgcn_ballot_w64(va == tau && rA < takeA)) & validA;
            const unsigned long long selB = (gtB | __builtin_amdgcn_ballot_w64(vb == tau && rB < takeB)) & validB;
            if (lane == 0) { LAS unsigned* d = selm + (8 * wave + q8) * 4; d[0] = (unsigned)selA; d[1] = (unsigned)(selA >> 32); d[2] = (unsigned)selB; d[3] = (unsigned)(selB >> 32); }
            accA |= selA; accB |= selB;
        }
        if (lane == 0) { atomicOr((unsigned*)&tilem[0], (unsigned)accA); atomicOr((unsigned*)&tilem[1], (unsigned)(accA >> 32)); atomicOr((unsigned*)&tilem[2], (unsigned)accB); atomicOr((unsigned*)&tilem[3], (unsigned)(accB >> 32)); }
    }
    AT_WAITBAR(0);
    if (wave == 0) {
        const unsigned long long mA = (unsigned long long)tilem[0] | ((unsigned long long)tilem[1] << 32), mB = (unsigned long long)tilem[2] | ((unsigned long long)tilem[3] << 32);
        const int rA = __builtin_amdgcn_mbcnt_hi((unsigned)(mA >> 32), __builtin_amdgcn_mbcnt_lo((unsigned)mA, 0));
        const int rB = __builtin_amdgcn_mbcnt_hi((unsigned)(mB >> 32), __builtin_amdgcn_mbcnt_lo((unsigned)mB, 0));
        const int nA = __builtin_popcountll(mA);
        if ((mA >> lane) & 1ull) blist[rA] = (unsigned)lane;
        if ((mB >> lane) & 1ull) blist[nA + rB] = (unsigned)(64 + lane);
        if (lane == 0) nbw[0] = (unsigned)(nA + __builtin_popcountll(mB));
    }
    AT_WAITBAR(0);
    const int nsel = (int)__builtin_amdgcn_readfirstlane(nbw[0]);
#pragma unroll
    for (int gi = 0; gi < 2; ++gi) { const float gt = sigmf(GLOG[(m0 + tql[gi]) * 12 + h * 3 + 0] + gate_b[h * 3 + 0]);
#pragma unroll
        for (int dt = 0; dt < 4; ++dt)
#pragma unroll
            for (int r = 0; r < 4; ++r) otp[((gi * 4 + dt) * 4 + r) * 64] = G[gi].o[dt][r] * gt; }
#pragma unroll
    for (int gi = 0; gi < 2; ++gi) {
        const int tq = t0 + tql[gi];
        float xf[8]; unpack8(__builtin_bit_cast(v4u, G[gi].q[0]), xf);
        float of[8];
#pragma unroll
        for (int j = 0; j < 8; ++j) of[j] = __shfl_xor(xf[j], 16);
        if (L.g < 2) {
            const f32x4 c0 = *(const f32x4*)(ROPE + tq * 16), c1 = *(const f32x4*)(ROPE + tq * 16 + 4), s0 = *(const f32x4*)(ROPE + tq * 16 + 8), s1 = *(const f32x4*)(ROPE + tq * 16 + 12);
            const float cs[8] = {c0.x, c0.y, c0.z, c0.w, c1.x, c1.y, c1.z, c1.w}, sn[8] = {s0.x, s0.y, s0.z, s0.w, s1.x, s1.y, s1.z, s1.w};
#pragma unroll
            for (int j = 0; j < 8; ++j) xf[j] = (L.g == 0) ? (xf[j] * cs[j] - of[j] * sn[j]) : (xf[j] * cs[j] + of[j] * sn[j]);
        }
        G[gi].q[0] = __builtin_bit_cast(bf16x8, pack8(xf));
        grp_reset(G[gi]);
    }
    for (int rp_ = 0; rp_ < RPT(11); ++rp_) { grp_reset(G[0]); grp_reset(G[1]); SrcSel src{P, blist, true, b, C_KS, C_VS, 0}; BodySel body{G, L, blist, selm, tql, cur}; at_ring<true, 6>(ring, nsel, tid, wave, src, body); }
#pragma unroll
    for (int gi = 0; gi < 2; ++gi) { const float il = sigmf(GLOG[(m0 + tql[gi]) * 12 + h * 3 + 1] + gate_b[h * 3 + 1]) / fmaxf(xg_sum(G[gi].l), 1e-30f);
#pragma unroll
        for (int dt = 0; dt < 4; ++dt)
#pragma unroll
            for (int r = 0; r < 4; ++r) otp[((gi * 4 + dt) * 4 + r) * 64] += G[gi].o[dt][r] * il;
        grp_reset(G[gi]); }
    for (int rp_ = 0; rp_ < RPT(12); ++rp_) { grp_reset(G[0]); grp_reset(G[1]); const int s0 = max(0, cur - 8); SrcSel src{P, blist, false, b, C_KW, C_VW, s0}; BodyWin body{G, L, tql, cur, s0}; at_ring<true, 6>(ring, cur - s0 + 1, tid, wave, src, body); }
#pragma unroll
    for (int gi = 0; gi < 2; ++gi) { const float il = sigmf(GLOG[(m0 + tql[gi]) * 12 + h * 3 + 2] + gate_b[h * 3 + 2]) / fmaxf(xg_sum(G[gi].l), 1e-30f);
#pragma unroll
        for (int dt = 0; dt < 4; ++dt)
#pragma unroll
            for (int r = 0; r < 4; ++r) G[gi].o[dt][r] = otp[((gi * 4 + dt) * 4 + r) * 64] + G[gi].o[dt][r] * il; }
#pragma unroll
    for (int gi = 0; gi < 2; ++gi) {
        float ss = 0.f;
#pragma unroll
        for (int dt = 0; dt < 4; ++dt) ss += G[gi].o[dt].x * G[gi].o[dt].x + G[gi].o[dt].y * G[gi].o[dt].y + G[gi].o[dt].z * G[gi].o[dt].z + G[gi].o[dt].w * G[gi].o[dt].w;
        ss = xg_sum(ss); const float sc = 1.0f / sqrtf(ss * (1.f / 64.f) + 1e-6f);
        const size_t mq = m0 + tql[gi];
#pragma unroll
        for (int dt = 0; dt < 4; ++dt) { const int d = h * 64 + 16 * dt + 4 * L.g;
            const f32x4 gn = *(const f32x4*)(nsa_out_g + d); const v2u gt = *(const v2u*)(P + mq * NP + C_NG + d);
            const float o0 = G[gi].o[dt].x * sc * gn.x * siluf(bflo(gt.x)), o1 = G[gi].o[dt].y * sc * gn.y * siluf(bfhi(gt.x)), o2 = G[gi].o[dt].z * sc * gn.z * siluf(bflo(gt.y)), o3 = G[gi].o[dt].w * sc * gn.w * siluf(bfhi(gt.y));
            *(v2u*)(Y + mq * D + 512 + d) = (v2u){pk2(o0, o1), pk2(o2, o3)}; }
    }
}

struct SrcMem { const bf16* KV; int b; __device__ __forceinline__ void operator()(int i, const bf16*& kb, size_t& kp, const bf16*& vb, size_t& vp) const {
    const int hh = i >> 2, blk = i & 3; kb = KV + (size_t)(b * MEML + 64 * blk) * 512 + hh * 64; vb = kb + 256; kp = 512; vp = 512; } };
struct BodyMem { Grp (&G)[1]; const LaneGeo& L; const bf16* P; bf16* Y; const float* og; size_t mq;
    __device__ __forceinline__ void operator()(int i, LAS const unsigned char* slot) {
        const int hh = i >> 2, blk = i & 3;
        if (blk == 0) { const bf16* qp = P + mq * NP + C_MQ + hh * 64 + 8 * L.g; G[0].q[0] = *(const bf16x8*)qp; G[0].q[1] = *(const bf16x8*)(qp + 32); grp_reset(G[0]); }
        const int lo[1] = {0}, hi[1] = {63}; const bool need[1] = {true};
        at_block<1, 2>(G, slot, L.koff0, L.koff1, L.vdt, L.g, lo, hi, need, false, nullptr, nullptr, 0, L.lane);
        if (blk == 3) {
            const float il = 1.0f / fmaxf(xg_sum(G[0].l), 1e-30f); float ss = 0.f;
#pragma unroll
            for (int dt = 0; dt < 4; ++dt) { G[0].o[dt] *= il; ss += G[0].o[dt].x * G[0].o[dt].x + G[0].o[dt].y * G[0].o[dt].y + G[0].o[dt].z * G[0].o[dt].z + G[0].o[dt].w * G[0].o[dt].w; }
            ss = xg_sum(ss); const float sc = 1.0f / sqrtf(ss * (1.f / 64.f) + 1e-6f);
#pragma unroll
            for (int dt = 0; dt < 4; ++dt) { const int d = hh * 64 + 16 * dt + 4 * L.g;
                const f32x4 gn = *(const f32x4*)(og + d); const v2u gt = *(const v2u*)(P + mq * NP + C_MG + d); const f32x4 o = G[0].o[dt];
                const float o0 = o.x * sc * gn.x * siluf(bflo(gt.x)), o1 = o.y * sc * gn.y * siluf(bfhi(gt.x)), o2 = o.z * sc * gn.z * siluf(bflo(gt.y)), o3 = o.w * sc * gn.w * siluf(bfhi(gt.y));
                *(v2u*)(Y + mq * D + 768 + d) = (v2u){pk2(o0, o1), pk2(o2, o3)}; }
        }
    } };

constexpr int RW_PITCH = 144, RW_MAT = 64 * RW_PITCH;
constexpr int RW_KKT = 0 * RW_MAT, RW_KD = 1 * RW_MAT, RW_U = 1 * RW_MAT, RW_BD = 2 * RW_MAT, RW_TII = 2 * RW_MAT, RW_RT = 3 * RW_MAT, RW_KH = 4 * RW_MAT, RW_BH = 5 * RW_MAT, RW_V = 6 * RW_MAT,
              RW_ABK = 7 * RW_MAT, RW_AVK = 8 * RW_MAT, RW_ARK = 9 * RW_MAT, RW_ARB = 10 * RW_MAT, RW_M1 = 11 * RW_MAT, RW_M2 = 12 * RW_MAT, RW_WC = 13 * RW_MAT;
typedef short s16x4 __attribute__((ext_vector_type(4)));
#define MFMA16K16(a, b, c) __builtin_amdgcn_mfma_f32_16x16x16bf16_1k(a, b, c, 0, 0, 0)
__device__ __forceinline__ s16x4 ds_tr(LAS const unsigned char* p) { return __builtin_bit_cast(s16x4, __builtin_amdgcn_ds_read_tr16_b64_v4i16((LAS v4i16*)p)); }
__device__ __forceinline__ bf16x8 frag_rm(LAS const unsigned char* X, int row0, int k0, int i16, int g) { return *(const LAS bf16x8*)(X + (row0 + i16) * RW_PITCH + (k0 + 8 * g) * 2); }
__device__ __forceinline__ bf16x8 frag_tr(LAS const unsigned char* X, int k0, int col0, int i16, int g) {
    LAS const unsigned char* p = X + (k0 + 8 * g + (i16 >> 2)) * RW_PITCH + (col0 + 4 * (i16 & 3)) * 2;
    const s16x4 a = ds_tr(p), b = ds_tr(p + 4 * RW_PITCH);
    return (bf16x8){a[0], a[1], a[2], a[3], b[0], b[1], b[2], b[3]};
}
__device__ __forceinline__ f32x4 bf4_to_f32(s16x4 v) { return (f32x4){bf2f((unsigned short)v[0]), bf2f((unsigned short)v[1]), bf2f((unsigned short)v[2]), bf2f((unsigned short)v[3])}; }
__device__ __forceinline__ v2u f32_to_bf4(f32x4 v) { return (v2u){cvtpk(v.x, v.y), cvtpk(v.z, v.w)}; }

__device__ __forceinline__ void rwkv_chunk_unit(int u, LAS unsigned char* lds, int wave, int lane, const bf16* P, const bf16* Aarr, const bf16* LW, const float* mu, const float* k_k, const float* k_a,
                                                const float* r_k, float* BONUS, unsigned char* CHK_PR, unsigned char* CHK_QY) {
    const int bh = u >> 7, c = u & 127, b = bh >> 3, h = bh & 7;
    const size_t m0 = (size_t)b * T + 64 * c;
    const int i16 = lane & 15, g = lane >> 4;
    {
        const int ch = h * 64 + lane; const int t8 = 8 * wave;
        float pr[9], pk[9], pv[9], av[8], lwv[8];
        if (64 * c + t8 > 0) { const bf16* pp = P + (m0 + t8 - 1) * NP; pr[0] = bf2f(pp[C_R + ch]); pk[0] = bf2f(pp[C_K + ch]); pv[0] = bf2f(pp[C_V + ch]); } else { pr[0] = 0.f; pk[0] = 0.f; pv[0] = 0.f; }
#pragma unroll
        for (int tt = 0; tt < 8; ++tt) { const size_t m = m0 + t8 + tt; const bf16* pc = P + m * NP;
            pr[tt + 1] = bf2f(pc[C_R + ch]); pk[tt + 1] = bf2f(pc[C_K + ch]); pv[tt + 1] = bf2f(pc[C_V + ch]); av[tt] = bf2f(Aarr[m * 512 + ch]); lwv[tt] = bf2f(LW[m * 512 + ch]); }
        const float mur = mu[C_R + ch], muk = mu[C_K + ch], muv = mu[C_V + ch], kkc = k_k[ch], kac = k_a[ch], rkc = r_k[ch];
        float part = 0.f;
#pragma unroll
        for (int tt = 0; tt < 8; ++tt) part += lwv[tt];
        LAS float* psum = (LAS float*)(lds + RW_WC + 256);
        psum[wave * 64 + lane] = part;
        __syncthreads();
        float pre = 0.f, tot = 0.f;
#pragma unroll
        for (int w2 = 0; w2 < 8; ++w2) { const float x = psum[w2 * 64 + lane]; tot += x; if (w2 < wave) pre += x; }
        float cl = pre;
#pragma unroll
        for (int tt = 0; tt < 8; ++tt) {
            const int t = t8 + tt; const size_t m = m0 + t;
            const float r = pr[tt + 1] + mur * (pr[tt] - pr[tt + 1]), k = pk[tt + 1] + muk * (pk[tt] - pk[tt + 1]), v = pv[tt + 1] + muv * (pv[tt] - pv[tt + 1]);
            const float a = av[tt], lw = lwv[tt];
            float kk = k * kkc; const float ss = wave_sum(kk * kk); kk *= 1.f / fmaxf(sqrtf(ss), 1e-12f);
            const float ka = k * (1.f + (a - 1.f) * kac), bb = kk * a;
            const float bon = wave_sum(r * ka * rkc); if (lane == 0) BONUS[m * 8 + h] = bon;
            const float Wp = __expf(cl); cl += lw; const float Wt = __expf(cl), iW = __expf(-cl), hW = __expf(tot - cl);
            LAS unsigned short* row = (LAS unsigned short*)(lds + t * RW_PITCH) + lane;
            row[RW_KKT / 2] = (unsigned short)f2bf(kk * Wp); row[RW_KD / 2] = (unsigned short)f2bf(ka * iW); row[RW_BD / 2] = (unsigned short)f2bf(bb * iW); row[RW_RT / 2] = (unsigned short)f2bf(r * Wt);
            row[RW_KH / 2] = (unsigned short)f2bf(ka * hW); row[RW_BH / 2] = (unsigned short)f2bf(bb * hW); row[RW_V / 2] = (unsigned short)f2bf(v);
        }
        if (wave == 0) ((LAS float*)(lds + RW_WC))[lane] = __expf(tot);
    }
    __syncthreads();
    {
        const int mb = wave & 3; const bool top = wave < 4;
        LAS const unsigned char* Am = lds + (top ? RW_KKT : RW_RT);
        const bf16x8 a0 = frag_rm(Am, 16 * mb, 0, i16, g), a1 = frag_rm(Am, 16 * mb, 32, i16, g);
#pragma unroll
        for (int nb = 0; nb < 8; ++nb) {
            const int jb = nb & 3; LAS const unsigned char* Bm = lds + (nb < 4 ? RW_BD : RW_KD);
            f32x4 d = {0.f, 0.f, 0.f, 0.f};
            if (jb <= mb) { d = MFMA16(a0, frag_rm(Bm, 16 * jb, 0, i16, g), d); d = MFMA16(a1, frag_rm(Bm, 16 * jb, 32, i16, g), d); }
            const int j = 16 * jb + i16, s0 = 16 * mb + 4 * g;
#pragma unroll
            for (int r = 0; r < 4; ++r) { const bool keep = top ? (j < s0 + r) : (j <= s0 + r); if (!keep) d[r] = 0.f; }
            LAS unsigned char* dst = lds + (top ? (nb < 4 ? RW_ABK : RW_AVK) : (nb < 4 ? RW_ARB : RW_ARK));
            *(LAS v2u*)(dst + j * RW_PITCH + s0 * 2) = f32_to_bf4(d);
        }
    }
    __syncthreads();
    if (wave == 0) {
        const int blk = g, cc = i16;
        float Tv[16];
#pragma unroll
        for (int s = 0; s < 16; ++s) Tv[s] = (s == cc) ? 1.f : 0.f;
#pragma unroll
        for (int j = 0; j < 15; ++j) {
            LAS const unsigned char* rowp = lds + RW_ABK + (16 * blk + j) * RW_PITCH + (16 * blk) * 2;
            float L[16]; { float t8[8]; unpack8(*(const LAS v4u*)rowp, t8);
#pragma unroll
                for (int e = 0; e < 8; ++e) L[e] = t8[e];
                unpack8(*(const LAS v4u*)(rowp + 16), t8);
#pragma unroll
                for (int e = 0; e < 8; ++e) L[8 + e] = t8[e]; }
            const float Tj = Tv[j];
#pragma unroll
            for (int s = j + 1; s < 16; ++s) Tv[s] -= L[s] * Tj;
        }
#pragma unroll
        for (int s = 0; s < 16; ++s) *(LAS unsigned short*)(lds + RW_TII + blk * 512 + s * 32 + cc * 2) = (unsigned short)f2bf(Tv[s]);
    } else if (wave <= 4) {
        const int mb = wave - 1;
        const bf16x8 a0 = frag_tr(lds + RW_AVK, 0, 16 * mb, i16, g), a1 = frag_tr(lds + RW_AVK, 32, 16 * mb, i16, g);
#pragma unroll
        for (int vt = 0; vt < 4; ++vt) {
            f32x4 d = {0.f, 0.f, 0.f, 0.f};
            d = MFMA16(a0, frag_tr(lds + RW_V, 0, 16 * vt, i16, g), d); d = MFMA16(a1, frag_tr(lds + RW_V, 32, 16 * vt, i16, g), d);
            *(LAS v2u*)(lds + RW_U + (16 * vt + i16) * RW_PITCH + (16 * mb + 4 * g) * 2) = f32_to_bf4(d);
        }
    }
    __syncthreads();
    {
        const int c0 = 16 * (wave & 3); const bool top = wave < 4;
        s16x4 Xb[4];
#pragma unroll
        for (int i = 0; i < 4; ++i) {
            f32x4 rhs;
            if (top) rhs = bf4_to_f32(ds_tr(lds + RW_KKT + (16 * i + 4 * g + (i16 >> 2)) * RW_PITCH + (c0 + 4 * (i16 & 3)) * 2));
            else { const v2u w2 = *(const LAS v2u*)(lds + RW_U + (c0 + i16) * RW_PITCH + (16 * i + 4 * g) * 2); rhs = (f32x4){bflo(w2.x), bfhi(w2.x), bflo(w2.y), bfhi(w2.y)}; }
            f32x4 acc = {0.f, 0.f, 0.f, 0.f};
#pragma unroll
            for (int k = 0; k < 4; ++k) if (k < i) {
                const s16x4 al = ds_tr(lds + RW_ABK + (16 * k + 4 * g + (i16 >> 2)) * RW_PITCH + (16 * i + 4 * (i16 & 3)) * 2);
                acc = MFMA16K16(al, Xb[k], acc); }
            rhs -= acc;
            const s16x4 rb = __builtin_bit_cast(s16x4, f32_to_bf4(rhs));
            const s16x4 at = __builtin_bit_cast(s16x4, *(const LAS v2u*)(lds + RW_TII + i * 512 + i16 * 32 + 8 * g));
            f32x4 X = {0.f, 0.f, 0.f, 0.f}; X = MFMA16K16(at, rb, X);
            Xb[i] = __builtin_bit_cast(s16x4, f32_to_bf4(X));
            *(LAS v2u*)(lds + (top ? RW_M1 : RW_M2) + (c0 + i16) * RW_PITCH + (16 * i + 4 * g) * 2) = f32_to_bf4(-X);
        }
    }
    __syncthreads();
    {
        const int nt = wave & 3;
        unsigned char* gpr = CHK_PR + (size_t)u * 16384; unsigned char* gqy = CHK_QY + (size_t)u * 16384;
        if (wave < 4) {
            const bf16x8 bh0 = frag_tr(lds + RW_BH, 0, 16 * nt, i16, g), bh1 = frag_tr(lds + RW_BH, 32, 16 * nt, i16, g);
            f32x4 d[4];
#pragma unroll
            for (int kt = 0; kt < 4; ++kt) { d[kt] = (f32x4){0.f, 0.f, 0.f, 0.f};
                d[kt] = MFMA16(frag_rm(lds + RW_M1, 16 * kt, 0, i16, g), bh0, d[kt]); d[kt] = MFMA16(frag_rm(lds + RW_M1, 16 * kt, 32, i16, g), bh1, d[kt]);
                if (kt == nt) {
#pragma unroll
                    for (int r = 0; r < 4; ++r) if (4 * g + r == i16) d[kt][r] += ((const LAS float*)(lds + RW_WC))[16 * kt + 4 * g + r]; } }
#pragma unroll
            for (int ks = 0; ks < 2; ++ks) { const v2u lo = f32_to_bf4(d[2 * ks]), hi = f32_to_bf4(d[2 * ks + 1]); *(v4u*)(gpr + (nt * 2 + ks) * 1024 + lane * 16) = (v4u){lo.x, lo.y, hi.x, hi.y}; }
            const bf16x8 kh0 = frag_tr(lds + RW_KH, 0, 16 * nt, i16, g), kh1 = frag_tr(lds + RW_KH, 32, 16 * nt, i16, g);
#pragma unroll
            for (int vt = 0; vt < 4; ++vt) { f32x4 q = {0.f, 0.f, 0.f, 0.f};
                q = MFMA16(kh0, frag_tr(lds + RW_V, 0, 16 * vt, i16, g), q); q = MFMA16(kh1, frag_tr(lds + RW_V, 32, 16 * vt, i16, g), q);
                q = MFMA16(bh0, frag_rm(lds + RW_M2, 16 * vt, 0, i16, g), q); q = MFMA16(bh1, frag_rm(lds + RW_M2, 16 * vt, 32, i16, g), q);
                *(v2u*)(gqy + ((vt * 4 + nt) * 64 + lane) * 8) = f32_to_bf4(q); }
        } else {
            const bf16x8 ab0 = frag_tr(lds + RW_ARB, 0, 16 * nt, i16, g), ab1 = frag_tr(lds + RW_ARB, 32, 16 * nt, i16, g);
            f32x4 d[4];
#pragma unroll
            for (int kt = 0; kt < 4; ++kt) { const v2u w2 = *(const LAS v2u*)(lds + RW_RT + (16 * nt + i16) * RW_PITCH + (16 * kt + 4 * g) * 2);
                d[kt] = (f32x4){bflo(w2.x), bfhi(w2.x), bflo(w2.y), bfhi(w2.y)};
                d[kt] = MFMA16(frag_rm(lds + RW_M1, 16 * kt, 0, i16, g), ab0, d[kt]); d[kt] = MFMA16(frag_rm(lds + RW_M1, 16 * kt, 32, i16, g), ab1, d[kt]); }
#pragma unroll
            for (int ks = 0; ks < 2; ++ks) { const v2u lo = f32_to_bf4(d[2 * ks]), hi = f32_to_bf4(d[2 * ks + 1]); *(v4u*)(gpr + 8192 + (nt * 2 + ks) * 1024 + lane * 16) = (v4u){lo.x, lo.y, hi.x, hi.y}; }
            const bf16x8 ak0 = frag_tr(lds + RW_ARK, 0, 16 * nt, i16, g), ak1 = frag_tr(lds + RW_ARK, 32, 16 * nt, i16, g);
#pragma unroll
            for (int vt = 0; vt < 4; ++vt) { f32x4 q = {0.f, 0.f, 0.f, 0.f};
                q = MFMA16(ak0, frag_tr(lds + RW_V, 0, 16 * vt, i16, g), q); q = MFMA16(ak1, frag_tr(lds + RW_V, 32, 16 * vt, i16, g), q);
                q = MFMA16(ab0, frag_rm(lds + RW_M2, 16 * vt, 0, i16, g), q); q = MFMA16(ab1, frag_rm(lds + RW_M2, 16 * vt, 32, i16, g), q);
                *(v2u*)(gqy + 8192 + ((vt * 4 + nt) * 64 + lane) * 8) = f32_to_bf4(q); }
        }
    }
    __syncthreads();
}

__device__ __forceinline__ void rwkv_scan_unit(int unit, int lane, const unsigned char* CHK_PR, const unsigned char* CHK_QY, unsigned char* CHK_S) {
    const int bh = unit >> 2, vt = unit & 3;
    f32x4 S[4];
#pragma unroll
    for (int kt = 0; kt < 4; ++kt) S[kt] = (f32x4){0.f, 0.f, 0.f, 0.f};
    constexpr int PD = 4;
    v4u pf[PD][8]; v2u qf[PD][4];
#pragma unroll
    for (int d = 0; d < PD; ++d) { const size_t u = (size_t)bh * 128 + d;
#pragma unroll
        for (int f = 0; f < 8; ++f) pf[d][f] = *(const v4u*)(CHK_PR + u * 16384 + f * 1024 + lane * 16);
#pragma unroll
        for (int mt = 0; mt < 4; ++mt) qf[d][mt] = *(const v2u*)(CHK_QY + u * 16384 + ((vt * 4 + mt) * 64 + lane) * 8); }
#pragma unroll 1
    for (int c0 = 0; c0 < 128; c0 += PD) {
#pragma unroll
        for (int d = 0; d < PD; ++d) {
            const int c = c0 + d; const size_t u = (size_t)bh * 128 + c;
            const v2u s0 = f32_to_bf4(S[0]), s1 = f32_to_bf4(S[1]), s2 = f32_to_bf4(S[2]), s3 = f32_to_bf4(S[3]);
            const v4u b0 = {s0.x, s0.y, s1.x, s1.y}, b1 = {s2.x, s2.y, s3.x, s3.y};
            *(v4u*)(CHK_S + u * 8192 + ((vt * 2 + 0) * 64 + lane) * 16) = b0; *(v4u*)(CHK_S + u * 8192 + ((vt * 2 + 1) * 64 + lane) * 16) = b1;
#pragma unroll
            for (int mt = 0; mt < 4; ++mt) { f32x4 acc = {bflo(qf[d][mt].x), bfhi(qf[d][mt].x), bflo(qf[d][mt].y), bfhi(qf[d][mt].y)};
                acc = MFMA16(__builtin_bit_cast(bf16x8, pf[d][mt * 2 + 0]), __builtin_bit_cast(bf16x8, b0), acc);
                acc = MFMA16(__builtin_bit_cast(bf16x8, pf[d][mt * 2 + 1]), __builtin_bit_cast(bf16x8, b1), acc); S[mt] = acc; }
            if (c + PD < 128) { const size_t un = u + PD;
#pragma unroll
                for (int f = 0; f < 8; ++f) pf[d][f] = *(const v4u*)(CHK_PR + un * 16384 + f * 1024 + lane * 16);
#pragma unroll
                for (int mt = 0; mt < 4; ++mt) qf[d][mt] = *(const v2u*)(CHK_QY + un * 16384 + ((vt * 4 + mt) * 64 + lane) * 8); }
        }
    }
}

__device__ __forceinline__ void rwkv_out_unit(int u, LAS unsigned char* wl  , int lane, const bf16* P, const unsigned char* CHK_PR, const unsigned char* CHK_QY, const unsigned char* CHK_S,
                                              const float* BONUS, const float* mu, const float* ln_w, const float* ln_b, bf16* Y) {
    const int bh = u >> 7, c = u & 127, b = bh >> 3, h = bh & 7;
    const size_t m0 = (size_t)b * T + 64 * c;
    const int i16 = lane & 15, g = lane >> 4;
    const int ch = h * 64 + lane;
    unsigned short pva[33], pga[33];
    if (64 * c > 0) { const bf16* pp = P + (m0 - 1) * NP; pva[0] = pp[C_V + ch]; pga[0] = pp[C_G + ch]; } else { pva[0] = 0; pga[0] = 0; }
#pragma unroll
    for (int t = 0; t < 32; ++t) { const bf16* pc = P + (m0 + t) * NP; pva[t + 1] = pc[C_V + ch]; pga[t + 1] = pc[C_G + ch]; }
    const float bmine = BONUS[(m0 + lane) * 8 + h];
    bf16x8 sf[4][2];
#pragma unroll
    for (int vt = 0; vt < 4; ++vt)
#pragma unroll
        for (int ks = 0; ks < 2; ++ks) sf[vt][ks] = *(const bf16x8*)(CHK_S + (size_t)u * 8192 + ((vt * 2 + ks) * 64 + lane) * 16);
#pragma unroll
    for (int tt = 0; tt < 4; ++tt) {
        const bf16x8 r0 = *(const bf16x8*)(CHK_PR + (size_t)u * 16384 + 8192 + (tt * 2 + 0) * 1024 + lane * 16), r1 = *(const bf16x8*)(CHK_PR + (size_t)u * 16384 + 8192 + (tt * 2 + 1) * 1024 + lane * 16);
        f32x4 y[4];
#pragma unroll
        for (int vt = 0; vt < 4; ++vt) { const v2u w2 = *(const v2u*)(CHK_QY + (size_t)u * 16384 + 8192 + ((vt * 4 + tt) * 64 + lane) * 8);
            y[vt] = (f32x4){bflo(w2.x), bfhi(w2.x), bflo(w2.y), bfhi(w2.y)};
            y[vt] = MFMA16(r0, sf[vt][0], y[vt]); y[vt] = MFMA16(r1, sf[vt][1], y[vt]); }
#pragma unroll
        for (int r = 0; r < 4; ++r) {
            float s = (y[0][r] + y[1][r]) + (y[2][r] + y[3][r]);
            s += dppf<0xB1>(s); s += dppf<0x4E>(s); s += dppf<0x141>(s); s += dppf<0x140>(s);
            const float mean = s * (1.f / 64.f);
            float q = 0.f;
#pragma unroll
            for (int vt = 0; vt < 4; ++vt) { y[vt][r] -= mean; q += y[vt][r] * y[vt][r]; }
            q += dppf<0xB1>(q); q += dppf<0x4E>(q); q += dppf<0x141>(q); q += dppf<0x140>(q);
            const float rstd = 1.0f / sqrtf(q * (1.f / 64.f) + 64e-5f);
#pragma unroll
            for (int vt = 0; vt < 4; ++vt) *(LAS unsigned short*)(wl + (16 * tt + 4 * g + r) * 132 + (16 * vt + i16) * 2) = (unsigned short)f2bf(y[vt][r] * rstd);
        }
    }
    const float muv = mu[C_V + ch], mug = mu[C_G + ch], lw = ln_w[ch], lb = ln_b[ch];
    unsigned short pvb[32], pgb[32];
#pragma unroll
    for (int t = 0; t < 32; ++t) { const bf16* pc = P + (m0 + 32 + t) * NP; pvb[t] = pc[C_V + ch]; pgb[t] = pc[C_G + ch]; }
#pragma unroll
    for (int t = 0; t < 32; ++t) {
        const float pvc = bf2f(pva[t + 1]), pgc = bf2f(pga[t + 1]), pvp = bf2f(pva[t]), pgp = bf2f(pga[t]);
        const float v = pvc + muv * (pvp - pvc), gt = pgc + mug * (pgp - pgc);
        const float yn = bf2f(*(const LAS unsigned short*)(wl + t * 132 + lane * 2));
        const float o = (yn * lw + lb + rdlane(bmine, t) * v) * siluf(gt);
        Y[(m0 + t) * D + ch] = (bf16)f2bf(o);
    }
#pragma unroll
    for (int t = 0; t < 32; ++t) {
        const float pvc = bf2f(pvb[t]), pgc = bf2f(pgb[t]), pvp = bf2f(t ? pvb[t - 1] : pva[32]), pgp = bf2f(t ? pgb[t - 1] : pga[32]);
        const float v = pvc + muv * (pvp - pvc), gt = pgc + mug * (pgp - pgc);
        const float yn = bf2f(*(const LAS unsigned short*)(wl + (32 + t) * 132 + lane * 2));
        const float o = (yn * lw + lb + rdlane(bmine, 32 + t) * v) * siluf(gt);
        Y[(m0 + 32 + t) * D + ch] = (bf16)f2bf(o);
    }
}

#ifndef PHASES
#define PHASES 0x3ff
#endif
__global__ void __launch_bounds__(NWAVES * 64, 2) hymba_fwd(Args args) {
    extern __shared__ __attribute__((aligned(16))) unsigned char lds_raw[];
    LAS unsigned char* lds = (LAS unsigned char*)lds_raw;
    volatile LAS unsigned* MISC = (volatile LAS unsigned*)(lds + MISC_OFF);
    const int tid = threadIdx.x, lane = tid & 63, wave = __builtin_amdgcn_readfirstlane(tid >> 6);
    const int G = gridDim.x; const int bx = blockIdx.x; const int vcu = (G % 8 == 0) ? (bx % 8) * (G / 8) + bx / 8 : bx;
    const int gw = vcu * NWAVES + wave, NGW = G * NWAVES;
    unsigned char* ws = args.ws;
    unsigned* ctl = (unsigned*)(ws + WS_CTL);
    const float* x = args.in[0]; const float* mem = args.in[1]; const float* norm_in_g = args.in[2]; const float* w_in = args.in[3];
    const float* mu = args.in[4]; const float* w0 = args.in[5]; const float* w_up = args.in[6]; const float* a0 = args.in[7]; const float* a_up = args.in[8];
    const float* k_k = args.in[9]; const float* k_a = args.in[10]; const float* r_k = args.in[11]; const float* ln_w = args.in[12]; const float* ln_b = args.in[13];
    const float* cmp_pos = args.in[14]; const float* ck_w1 = args.in[15]; const float* ck_w2 = args.in[16]; const float* cv_w1 = args.in[17]; const float* cv_w2 = args.in[18];
    const float* gate_b = args.in[19]; const float* nsa_out_g = args.in[20]; const float* mem_norm_g = args.in[21]; const float* w_mem_kv = args.in[22];
    const float* mem_out_g = args.in[23]; const float* w_out = args.in[24]; const float* norm_final_g = args.in[25];
    float* out = args.out;
    bf16* WT_IN = (bf16*)(ws + WS_WIN); bf16* WT_OUT = (bf16*)(ws + WS_WOUT);
    float* ROPE = (float*)(ws + WS_ROPE); float* RS = (float*)(ws + WS_RS); bf16* KCMP = (bf16*)(ws + WS_KCMP); bf16* VCMP = (bf16*)(ws + WS_VCMP);
    bf16* MEMKV = (bf16*)(ws + WS_MEMKV); float* GLOG = (float*)(ws + WS_GLOG);
    bf16* P = (bf16*)(ws + WS_P); bf16* XB = (bf16*)(ws + WS_XB); bf16* Y = (bf16*)(ws + WS_Y);
    bf16* AA = (bf16*)(ws + WS_A); bf16* LWA = (bf16*)(ws + WS_LW); float* BONUS = (float*)(ws + WS_BONUS);
    bf16* W1TK = (bf16*)(ws + WS_W1TK); bf16* W1TV = (bf16*)(ws + WS_W1TV); bf16* W2TK = (bf16*)(ws + WS_W2TK); bf16* W2TV = (bf16*)(ws + WS_W2TV);
    bf16* WUPT = (bf16*)(ws + WS_WUPT); bf16* AUPT = (bf16*)(ws + WS_AUPT); bf16* WKVT = (bf16*)(ws + WS_WKVT); bf16* MEMN = (bf16*)(ws + WS_MEMN);
    unsigned char* CHK_PR = ws + WS_CHK_PR; unsigned char* CHK_QY = ws + WS_CHK_QY; unsigned char* CHK_S = ws + WS_CHK_S;

    for (int u = tid; u < (LDS_BYTES - LDSCTL_OFF) / 4; u += NWAVES * 64) ((LAS unsigned*)(lds + LDSCTL_OFF))[u] = 0u;
    __syncthreads();
    XcdBarrier bar = xcd_barrier_post(ctl + CW_BAR, MISC + 8);

    for (int rep = 0; rep < RPT(0); ++rep) { if (PHASES & 1) {
        LAS float* wgt = (LAS float*)(lds + 81920);
        for (int i = tid; i < D * 12; i += NWAVES * 64) { const int k = i / 12, c = i % 12; wgt[i] = norm_in_g[k] * w_in[(size_t)k * W_IN_COLS + GLOG_SRC + c]; }
        __syncthreads();
        LAS float* scr = (LAS float*)(lds + wave * 8704);
        constexpr int I_IN = 16 * (NP / 32), I_OUT = 16 * (D / 32), I_W1 = 32 * 2, I_KV = 16 * 16, I_UP = 16, I_W2 = 2;
        constexpr int O_OUT = I_IN, O_W1K = O_OUT + I_OUT, O_W1V = O_W1K + I_W1, O_KV = O_W1V + I_W1, O_WUP = O_KV + I_KV, O_AUP = O_WUP + I_UP, O_W2K = O_AUP + I_UP, O_W2V = O_W2K + I_W2, I_ALL = O_W2V + I_W2;
        for (int it = gw; it < I_ALL; it += NGW) {
            if (it < O_OUT) { const int kb = it / (NP / 32), nb = it % (NP / 32); const int src = 32 * nb + (32 * nb >= GLOG_SRC ? 12 : 0);
                p0_transpose_item(w_in, W_IN_COLS, src, norm_in_g, WT_IN, D, 32 * nb, 64 * kb, scr, lane); }
            else if (it < O_W1K) { const int r = it - O_OUT; p0_transpose_item(w_out, D, 32 * (r % (D / 32)), nullptr, WT_OUT, D, 32 * (r % (D / 32)), 64 * (r / (D / 32)), scr, lane); }
            else if (it < O_W1V) { const int r = it - O_W1K; p0_transpose_item(ck_w1, 64, 32 * (r & 1), nullptr, W1TK, 2048, 32 * (r & 1), 64 * (r >> 1), scr, lane); }
            else if (it < O_KV) { const int r = it - O_W1V; p0_transpose_item(cv_w1, 64, 32 * (r & 1), nullptr, W1TV, 2048, 32 * (r & 1), 64 * (r >> 1), scr, lane); }
            else if (it < O_WUP) { const int r = it - O_KV; p0_transpose_item(w_mem_kv, 512, 32 * (r & 15), nullptr, WKVT, D, 32 * (r & 15), 64 * (r >> 4), scr, lane); }
            else if (it < O_AUP) { const int r = it - O_WUP; p0_transpose_item(w_up, 512, 32 * r, nullptr, WUPT, 64, 32 * r, 0, scr, lane); }
            else if (it < O_W2K) { const int r = it - O_AUP; p0_transpose_item(a_up, 512, 32 * r, nullptr, AUPT, 64, 32 * r, 0, scr, lane); }
            else if (it < O_W2V) { const int r = it - O_W2K; p0_transpose_item(ck_w2, 64, 32 * r, nullptr, W2TK, 64, 32 * r, 0, scr, lane); }
            else { const int r = it - O_W2V; p0_transpose_item(cv_w2, 64, 32 * r, nullptr, W2TV, 64, 32 * r, 0, scr, lane); }
        }
        for (int m = gw; m < NB * MEML; m += NGW) {
            const f32x4* xr = (const f32x4*)(mem + (size_t)m * D) + lane; f32x4 v[4]; float ss = 0.f;
#pragma unroll
            for (int j = 0; j < 4; ++j) { v[j] = xr[64 * j]; ss += (v[j].x * v[j].x + v[j].y * v[j].y) + (v[j].z * v[j].z + v[j].w * v[j].w); }
            ss = wave_sum(ss); const float rs = 1.0f / sqrtf(ss * (1.f / D) + 1e-6f);
            unsigned long long* o8 = (unsigned long long*)(MEMN + (size_t)m * D) + lane;
#pragma unroll
            for (int j = 0; j < 4; ++j) { const f32x4 gg = *((const f32x4*)mem_norm_g + 64 * j + lane); const f32x4 y = v[j] * rs * gg; o8[64 * j] = (unsigned long long)pk2(y.x, y.y) | ((unsigned long long)pk2(y.z, y.w) << 32); }
        }
        for (int i = gw * 64 + lane; i < T * 8; i += NGW * 64) { float c, s; rope_cs(i >> 3, i & 7, c, s); ROPE[(i >> 3) * 16 + (i & 7)] = c; ROPE[(i >> 3) * 16 + 8 + (i & 7)] = s; }
        for (int m = gw; m < M; m += NGW) {
            const f32x4* xr = (const f32x4*)(x + (size_t)m * D) + lane;
            f32x4 v[4]; float ss = 0.f;
#pragma unroll
            for (int j = 0; j < 4; ++j) { v[j] = xr[64 * j]; ss += (v[j].x * v[j].x + v[j].y * v[j].y) + (v[j].z * v[j].z + v[j].w * v[j].w); }
            ss = wave_sum(ss);
            const float rs = 1.0f / sqrtf(ss * (1.f / D) + 1e-6f);
            unsigned long long* o8 = (unsigned long long*)(XB + (size_t)m * D) + lane;
#pragma unroll
            for (int j = 0; j < 4; ++j) o8[64 * j] = (unsigned long long)pk2(v[j].x, v[j].y) | ((unsigned long long)pk2(v[j].z, v[j].w) << 32);
            float acc[12];
#pragma unroll
            for (int c = 0; c < 12; ++c) acc[c] = 0.f;
#pragma unroll
            for (int j = 0; j < 4; ++j)
#pragma unroll
                for (int e = 0; e < 4; ++e) { const int k = 256 * j + 4 * lane + e; const float xv = v[j][e];
                    const f32x4 w0v = *(const LAS f32x4*)(wgt + k * 12), w1v = *(const LAS f32x4*)(wgt + k * 12 + 4), w2v = *(const LAS f32x4*)(wgt + k * 12 + 8);
                    acc[0] += xv * w0v.x; acc[1] += xv * w0v.y; acc[2] += xv * w0v.z; acc[3] += xv * w0v.w;
                    acc[4] += xv * w1v.x; acc[5] += xv * w1v.y; acc[6] += xv * w1v.z; acc[7] += xv * w1v.w;
                    acc[8] += xv * w2v.x; acc[9] += xv * w2v.y; acc[10] += xv * w2v.z; acc[11] += xv * w2v.w; }
            float mine = 0.f;
#pragma unroll
            for (int c = 0; c < 12; ++c) { const float t = wave_sum(acc[c]); if (lane == c) mine = t; }
            if (lane < 12) GLOG[(size_t)m * 12 + lane] = mine * rs;
            if (lane == 0) RS[m] = rs;
        }
    }
    xcd_barrier(bar); }

    for (int rep = 0; rep < RPT(1); ++rep) { if (PHASES & 2) {
        pg8::Gemm g{XB, WT_IN, M, NP, D}; pg8::StaticOrder S; S.init(M, NP, G, bx);
        pg8::EpiRowScaleBf16 E{P, NP, RS};
        pg8::gemm_phase<pg8::EpiRowScaleBf16, pg8::StaticOrder, true, true>(lds, g, S, E);
    }
    xcd_barrier(bar); }

    for (int rep = 0; rep < RPT(2); ++rep) { if (PHASES & 4) {
        const int i16 = lane & 15, g = lane >> 4;
        constexpr int U_CMP = NB * 32 * 2, U_KV = 64 * 8, U_LORA = M / 16;
        for (int pass = 0; pass < 2; ++pass)
        for (int idx = (pass == 0 ? (wave == 0 ? vcu : (wave <= 2 ? U_CMP + vcu * 2 + (wave - 1) : U_CMP + U_KV)) : U_CMP + U_KV + gw);
             idx < (pass == 0 ? (wave == 0 ? U_CMP : (wave <= 2 ? U_CMP + U_KV : 0)) : U_CMP + U_KV + U_LORA); idx += (pass == 0 ? (wave == 0 ? G : 2 * G) : NGW)) {
            if (idx < U_CMP) {
                const int kv = idx & 1, ct = (idx >> 1) & 31, b = idx >> 6;
                const bf16* W1T = kv ? W1TV : W1TK; const bf16* W2T = kv ? W2TV : W2TK; const int col = kv ? C_VC : C_KC; bf16* dst = kv ? VCMP : KCMP;
                const int c = 16 * ct + i16, cl = min(c, NCMP - 1);
                const bf16* wbase = P + (size_t)(b * T + 16 * cl) * NP + col + 8 * g;
                f32x4 acc[4];
#pragma unroll
                for (int mt = 0; mt < 4; ++mt) acc[mt] = (f32x4){0.f, 0.f, 0.f, 0.f};
#pragma unroll 4
                for (int ks = 0; ks < 64; ++ks) {
                    const int l = ks >> 1, db = 32 * (ks & 1);
                    float wf[8]; unpack8(*(const v4u*)(wbase + (size_t)l * NP + db), wf);
                    const f32x4 p0 = *(const f32x4*)(cmp_pos + l * 64 + db + 8 * g), p1 = *(const f32x4*)(cmp_pos + l * 64 + db + 8 * g + 4);
                    wf[0] += p0.x; wf[1] += p0.y; wf[2] += p0.z; wf[3] += p0.w; wf[4] += p1.x; wf[5] += p1.y; wf[6] += p1.z; wf[7] += p1.w;
                    const bf16x8 bfr = __builtin_bit_cast(bf16x8, pack8(wf));
#pragma unroll
                    for (int mt = 0; mt < 4; ++mt) acc[mt] = MFMA16(*(const bf16x8*)(W1T + (size_t)(16 * mt + i16) * 2048 + 32 * ks + 8 * g), bfr, acc[mt]);
                }
                v2u hb[4];
#pragma unroll
                for (int mt = 0; mt < 4; ++mt) hb[mt] = f32_to_bf4((f32x4){siluf(acc[mt].x), siluf(acc[mt].y), siluf(acc[mt].z), siluf(acc[mt].w)});
                const bf16x8 b0 = __builtin_bit_cast(bf16x8, (v4u){hb[0].x, hb[0].y, hb[1].x, hb[1].y}), b1 = __builtin_bit_cast(bf16x8, (v4u){hb[2].x, hb[2].y, hb[3].x, hb[3].y});
#pragma unroll
                for (int mt = 0; mt < 4; ++mt) {
                    const bf16* wr = W2T + (16 * mt + i16) * 64 + 4 * g;
                    const v2u a00 = *(const v2u*)wr, a01 = *(const v2u*)(wr + 16), a10 = *(const v2u*)(wr + 32), a11 = *(const v2u*)(wr + 48);
                    f32x4 o = {0.f, 0.f, 0.f, 0.f};
                    o = MFMA16(__builtin_bit_cast(bf16x8, (v4u){a00.x, a00.y, a01.x, a01.y}), b0, o); o = MFMA16(__builtin_bit_cast(bf16x8, (v4u){a10.x, a10.y, a11.x, a11.y}), b1, o);
                    if (c >= NCMP) o = (f32x4){0.f, 0.f, 0.f, 0.f};
                    *(v2u*)(dst + (size_t)(b * 512 + c) * 64 + 16 * mt + 4 * g) = f32_to_bf4(o);
                }
            } else if (idx < U_CMP + U_KV) {
                const int r2 = idx - U_CMP, rt = r2 >> 3, cg = r2 & 7;
                const bf16* arow = WKVT + (size_t)(64 * cg + i16) * D + 8 * g; const bf16* brow = MEMN + (size_t)(16 * rt + i16) * D + 8 * g;
                f32x4 acc[4];
#pragma unroll
                for (int mt = 0; mt < 4; ++mt) acc[mt] = (f32x4){0.f, 0.f, 0.f, 0.f};
#pragma unroll 4
                for (int ks = 0; ks < 32; ++ks) { const bf16x8 bfr = *(const bf16x8*)(brow + 32 * ks);
#pragma unroll
                    for (int mt = 0; mt < 4; ++mt) acc[mt] = MFMA16(*(const bf16x8*)(arow + (size_t)(16 * mt) * D + 32 * ks), bfr, acc[mt]); }
#pragma unroll
                for (int mt = 0; mt < 4; ++mt) *(v2u*)(MEMKV + (size_t)(16 * rt + i16) * 512 + 64 * cg + 16 * mt + 4 * g) = f32_to_bf4(acc[mt]);
            } else {
                const int u = idx - U_CMP - U_KV; const size_t m = (size_t)u * 16 + i16; const int t = (int)(m & (T - 1)); const bool hp = t > 0;
                const bf16* pr = P + m * NP; const bf16* pp = pr - NP;
                bf16x8 bw[2], ba[2];
#pragma unroll
                for (int ks = 0; ks < 2; ++ks) {
                    const int j0 = 32 * ks + 8 * g; float cw[8], pw[8], ca[8], pa[8];
                    unpack8(*(const v4u*)(pr + C_WD + j0), cw); unpack8(*(const v4u*)(pr + C_AD + j0), ca);
                    if (hp) { unpack8(*(const v4u*)(pp + C_WD + j0), pw); unpack8(*(const v4u*)(pp + C_AD + j0), pa); }
                    else {
#pragma unroll
                        for (int e = 0; e < 8; ++e) { pw[e] = 0.f; pa[e] = 0.f; } }
#pragma unroll
                    for (int e = 0; e < 8; ++e) { cw[e] = tanhf(cw[e] + mu[C_WD + j0 + e] * (pw[e] - cw[e])); ca[e] = ca[e] + mu[C_AD + j0 + e] * (pa[e] - ca[e]); }
                    bw[ks] = __builtin_bit_cast(bf16x8, pack8(cw)); ba[ks] = __builtin_bit_cast(bf16x8, pack8(ca));
                }
#pragma unroll 2
                for (int mt = 0; mt < 32; ++mt) {
                    const bf16* wu = WUPT + (16 * mt + i16) * 64 + 8 * g; const bf16* au = AUPT + (16 * mt + i16) * 64 + 8 * g;
                    f32x4 dw = {0.f, 0.f, 0.f, 0.f}, da = {0.f, 0.f, 0.f, 0.f};
                    dw = MFMA16(*(const bf16x8*)wu, bw[0], dw); dw = MFMA16(*(const bf16x8*)(wu + 32), bw[1], dw);
                    da = MFMA16(*(const bf16x8*)au, ba[0], da); da = MFMA16(*(const bf16x8*)(au + 32), ba[1], da);
                    const int c = 16 * mt + 4 * g; const f32x4 w0v = *(const f32x4*)(w0 + c), a0v = *(const f32x4*)(a0 + c);
                    f32x4 lo, ao;
#pragma unroll
                    for (int r = 0; r < 4; ++r) { const float nx = -(w0v[r] + dw[r]); const float sp = fmaxf(nx, 0.f) + __logf(1.f + __expf(-fabsf(nx))); lo[r] = -__expf(-sp - 0.5f); ao[r] = sigmf(a0v[r] + da[r]); }
                    *(v2u*)(LWA + m * 512 + c) = f32_to_bf4(lo); *(v2u*)(AA + m * 512 + c) = f32_to_bf4(ao);
                }
                { bf16* q = P + m * NP + ((g & 1) ? C_KW : C_KS) + 4 * (g >> 1);
                  const v2u x1 = *(const v2u*)q, x2 = *(const v2u*)(q + 8); const f32x4 cs = *(const f32x4*)(ROPE + t * 16 + 4 * (g >> 1)), sn = *(const f32x4*)(ROPE + t * 16 + 8 + 4 * (g >> 1));
                  const f32x4 a1 = {bflo(x1.x), bfhi(x1.x), bflo(x1.y), bfhi(x1.y)}, a2 = {bflo(x2.x), bfhi(x2.x), bflo(x2.y), bfhi(x2.y)};
                  if (rep == 0) { *(v2u*)q = f32_to_bf4(a1 * cs - a2 * sn); *(v2u*)(q + 8) = f32_to_bf4(a2 * cs + a1 * sn); } }
            }
        }
    }
    xcd_barrier(bar); }

    for (int rep = 0; rep < RPT(3); ++rep) { if (PHASES & 8) {
        for (int u = vcu; u < NB * 8 * 128; u += G) rwkv_chunk_unit(u, lds, wave, lane, P, AA, LWA, mu, k_k, k_a, r_k, BONUS, CHK_PR, CHK_QY);
    }
    xcd_barrier(bar); }
    for (int rep = 0; rep < RPT(4); ++rep) if ((PHASES & 128) && wave == 0) {
        for (int unit = bx; unit < NB * 8 * 4; unit += G) rwkv_scan_unit(unit, lane, CHK_PR, CHK_QY, CHK_S);
    }
    for (int rep = 0; rep < RPT(6); ++rep) if (PHASES & 512) {
        const int mu0 = (G == 256) ? (bx >= 128 ? 2 * (bx - 128) : 256) : bx, mu1 = (G == 256) ? (bx >= 128 ? mu0 + 2 : 256) : 256, mus = (G == 256) ? 1 : G;
        for (int u = mu0; u < mu1; u += mus) {
            const int b = u >> 6; const size_t m0 = (size_t)b * T + 128 * (u & 63);
            Grp GM[1]; const LaneGeo L = make_geo(lane);
            SrcMem src{MEMKV, b}; BodyMem body{GM, L, P, Y, mem_out_g, m0 + 16 * wave + L.i16};
            at_ring<true, 6>(lds, 16, tid, wave, src, body);
        }
    }
    for (int rep = 0; rep < RPT(5); ++rep) if (PHASES & 256) {
        for (int pr = vcu; pr < 256; pr += G)
#pragma unroll 1
            for (int half = 0; half < 2; ++half)
                nsa_unit(pr >> 6, half ? 127 - (pr & 63) : (pr & 63), lds, tid, wave, lane, P, KCMP, VCMP, GLOG, gate_b, nsa_out_g, ROPE, Y, (float*)(ws + WS_OTP) + (size_t)(bx * NWAVES + wave) * 2048);
    }
    xcd_barrier(bar);

    for (int rep = 0; rep < RPT(7); ++rep) { if (PHASES & 16) {
        for (int u = gw; u < NB * 8 * 128; u += NGW) rwkv_out_unit(u, lds + wave * 8448, lane, P, CHK_PR, CHK_QY, CHK_S, BONUS, mu, ln_w, ln_b, Y);
    }
    xcd_barrier(bar); }

    if (PHASES & 32) {
        pg8::Gemm g{Y, WT_OUT, M, D, D}; pg8::StaticOrder S; S.init(M, D, G, bx);
        pg8::EpiResF32 E{x, out, D};
        pg8::gemm_phase<pg8::EpiResF32, pg8::StaticOrder, true, true>(lds, g, S, E);
    }
    xcd_barrier(bar);

    if (PHASES & 64) for (int m = gw; m < M; m += NGW) {
        f32x4* xr = (f32x4*)(out + (size_t)m * D) + lane;
        f32x4 v[4]; float ss = 0.f;
#pragma unroll
        for (int j = 0; j < 4; ++j) { v[j] = xr[64 * j]; ss += (v[j].x * v[j].x + v[j].y * v[j].y) + (v[j].z * v[j].z + v[j].w * v[j].w); }
        ss = wave_sum(ss);
        const float rs = 1.0f / sqrtf(ss * (1.f / D) + 1e-6f);
#pragma unroll
        for (int j = 0; j < 4; ++j) { const f32x4 g = *((const f32x4*)norm_final_g + 64 * j + lane); xr[64 * j] = v[j] * rs * g; }
    }
}

extern "C" void kernel_launch(void* const* d_in, const int* in_sizes, int n_in, void* d_out, int out_size, void* d_ws, size_t ws_size, hipStream_t stream) {
    static int grid = 0;
    if (grid == 0) {
        if (n_in != 26 || in_sizes[0] != M * D || out_size != M * D || ws_size < WS_END) { fprintf(stderr, "kernel_launch: unexpected shapes (n_in %d, in0 %d, out %d, ws %zu); nothing launched\n", n_in, n_in > 0 ? in_sizes[0] : -1, out_size, ws_size); grid = -1; return; }
        int dev = 0, cus = 0;
        if (hipGetDevice(&dev) != hipSuccess || hipDeviceGetAttribute(&cus, hipDeviceAttributeMultiprocessorCount, dev) != hipSuccess) { grid = -1; return; }
        if (hipFuncSetAttribute((const void*)hymba_fwd, hipFuncAttributeMaxDynamicSharedMemorySize, LDS_BYTES) != hipSuccess) { fprintf(stderr, "kernel_launch: hipFuncSetAttribute failed\n"); grid = -1; return; }
        (void)hipGetLastError();
        grid = cus;
    }
    if (grid < 0) return;
    (void)hipMemsetAsync((char*)d_ws + WS_CTL, 0, CTL_ZERO_BYTES, stream);
    Args a{};
    for (int i = 0; i < 26; ++i) a.in[i] = (const float*)d_in[i];
    a.out = (float*)d_out; a.ws = (unsigned char*)d_ws;
    hipLaunchKernelGGL(hymba_fwd, dim3(grid), dim3(NWAVES * 64), LDS_BYTES, stream, a);
}
```

```cpp
#define REPEAT 0
#include <hip/hip_runtime.h>
#include <cstdio>
#include <cstdint>
namespace pg8 {
#define PG8_LAS __attribute__((address_space(3)))
typedef unsigned short bf16_t;
typedef short bf16x8 __attribute__((ext_vector_type(8)));
typedef float f32x4 __attribute__((ext_vector_type(4)));
typedef unsigned u32x4 __attribute__((ext_vector_type(4)));
constexpr int BM = 256, BK = 64, HALF = 128, HTB = HALF * BK * 2  , STAGE_BYTES = 8 * HTB, NXCD = 8, WGM = 8;

__host__ __device__ __forceinline__ int lds_byte(int r, int c) { const int st = (r >> 4) * 2 + (c >> 5), rr = r & 15, cc = c & 31, ob = rr * 64 + cc * 2; return st * 1024 + (ob ^ (((ob >> 9) & 1) << 5)); }
__host__ __device__ __forceinline__ void stage_rc(int b, int& R, int& C) { const int st = b / 1024, sb = b % 1024, swz = sb ^ (((sb >> 9) & 1) << 5); R = (st >> 1) * 16 + swz / 64; C = (st & 1) * 32 + (swz % 64) / 2; }
__host__ __device__ __forceinline__ int perm32(int rho) { const int n = rho >> 4, i = rho & 15; return 8 * (i >> 2) + 4 * n + (i & 3); }

struct Unit { int pm, pn; };
struct Gemm { const bf16_t* A; const bf16_t* Bt; int M, N, K; };

struct StaticOrder {
    int nM, nN, nwg, G, c;
    __host__ __device__ void init(int M, int N, int G_, int c_) { nM = M / BM; nN = N / BM; nwg = nM * nN; G = G_; c = c_; }
    __host__ __device__ bool next(int i, Unit& u) const {
        const long L = (long)i * G + c; if (L >= nwg) return false;
        int wgid = (int)L; { const int q = nwg / NXCD, r = nwg % NXCD, xcd = wgid % NXCD, off = wgid / NXCD; wgid = (xcd < r ? xcd * (q + 1) : r * (q + 1) + (xcd - r) * q) + off; }
        const int nig = WGM * nN, gid = wgid / nig, fm = gid * WGM, gsz = (nM - fm) < WGM ? (nM - fm) : WGM;
        u.pm = fm + ((wgid % nig) % gsz); u.pn = (wgid % nig) / gsz; return true;
    }
    __device__ __forceinline__ void a_ready(const Unit&) const {}
    __device__ __forceinline__ void done(const Unit&) const {}
};

__device__ __forceinline__ unsigned cvt_pk_bf16(float lo, float hi) { unsigned r; asm volatile("v_cvt_pk_bf16_f32 %0, %1, %2" : "=v"(r) : "v"(lo), "v"(hi)); return r; }

template <class Epi, class Sched, bool ALIGN_EPI = false, bool SP2 = false>
__device__ __forceinline__ void gemm_phase(PG8_LAS unsigned char* lds, const Gemm g, const Sched& S, const Epi& E) {
    int tid_o = threadIdx.x; asm volatile("" : "+v"(tid_o));
    const int tid = tid_o, wid = __builtin_amdgcn_readfirstlane(tid >> 6), lane = tid & 63, wr = wid >> 2, wc = wid & 3, fr = lane & 15, fq = lane >> 4;
    const int K = g.K, nt = K / BK;
    unsigned voffA[2], voffB[2];
#pragma unroll
    for (int i = 0; i < 2; ++i) { int R, C; stage_rc(tid * 16 + i * 8192, R, C); const int Rb = Epi::PERM ? ((R & ~31) + perm32(R & 31)) : R;
        voffA[i] = (unsigned)(R * K + C) * 2u; voffB[i] = (unsigned)(Rb * K + C) * 2u; }
    const size_t kstep = (size_t)(BK * 2);
    const size_t hstep = (size_t)HALF * K * 2;
    const size_t tstep = 2 * hstep;
    const unsigned ldsw = (unsigned)wid * 1024u;
    const int aoff = lds_byte(wr * 64 + fr, fq * 8), boff = lds_byte(wc * 32 + fr, fq * 8);
#define PG8_SA(b, h) (((b) * 2 + (h)) * HTB)
#define PG8_SB(b, h) ((4 + (b) * 2 + (h)) * HTB)
#define PG8_STAGE(bufoff, gbase, voff) do { _Pragma("unroll") for (int _i = 0; _i < 2; ++_i) \
        __builtin_amdgcn_global_load_lds((const unsigned*)((const char*)(gbase) + (voff)[_i]), (PG8_LAS unsigned*)(lds + (bufoff) + ldsw + _i * 8192), 16, 0, 0); } while (0)
#define PG8_LDA(dst, b, h) do { _Pragma("unroll") for (int m = 0; m < 4; ++m) _Pragma("unroll") for (int k = 0; k < 2; ++k) dst[m][k] = *(const PG8_LAS bf16x8*)(lds + PG8_SA(b, h) + aoff + m * 2048 + k * 1024); } while (0)
#define PG8_LDB(dst, b, h) do { _Pragma("unroll") for (int n = 0; n < 2; ++n) _Pragma("unroll") for (int k = 0; k < 2; ++k) dst[n][k] = *(const PG8_LAS bf16x8*)(lds + PG8_SB(b, h) + boff + n * 2048 + k * 1024); } while (0)
#define PG8_MMA(ai, bj, At, Bt) do { __builtin_amdgcn_s_setprio(1); _Pragma("unroll") for (int m = 0; m < 4; ++m) _Pragma("unroll") for (int n = 0; n < 2; ++n) _Pragma("unroll") for (int k = 0; k < 2; ++k) \
        acc[ai][bj][m][n] = __builtin_amdgcn_mfma_f32_16x16x32_bf16(Bt[n][k], At[m][k], acc[ai][bj][m][n], 0, 0, 0); __builtin_amdgcn_s_setprio(0); } while (0)
#define PG8_WAIT_V(n) asm volatile("s_waitcnt vmcnt(" #n ")" ::: "memory")
#define PG8_WAIT_L(n) asm volatile("s_waitcnt lgkmcnt(" #n ")" ::: "memory")
#define PG8_BAR __builtin_amdgcn_s_barrier()
#define PG8_SCHED __builtin_amdgcn_sched_barrier(0)
    Unit cur, nxt; int ui = 0;
    if (!S.next(0, cur)) return;
    f32x4 acc[2][2][4][2];
#pragma unroll
    for (int a = 0; a < 2; ++a)
#pragma unroll
        for (int b = 0; b < 2; ++b)
#pragma unroll
            for (int m = 0; m < 4; ++m)
#pragma unroll
                for (int n = 0; n < 2; ++n) acc[a][b][m][n] = (f32x4){0.f, 0.f, 0.f, 0.f};
    bf16x8 At[4][2], B0[2][2], B1[2][2];
    const char* cA = (const char*)g.A + (size_t)cur.pm * tstep; const char* cB = (const char*)g.Bt + (size_t)cur.pn * tstep;
    S.a_ready(cur);
    if constexpr (SP2) {
        PG8_STAGE(PG8_SB(0, 0), cB, voffB); PG8_STAGE(PG8_SB(0, 1), cB + hstep, voffB); PG8_STAGE(PG8_SA(0, 0), cA, voffA); PG8_STAGE(PG8_SA(0, 1), cA + hstep, voffA);
        if (wr == 1) PG8_BAR;
        PG8_WAIT_V(2); PG8_BAR;
        PG8_STAGE(PG8_SB(1, 0), cB + kstep, voffB); PG8_STAGE(PG8_SA(1, 0), cA + kstep, voffA); PG8_STAGE(PG8_SB(1, 1), cB + hstep + kstep, voffB);
        PG8_WAIT_V(6); PG8_BAR;
    } else {
        PG8_STAGE(PG8_SB(0, 0), cB, voffB); PG8_STAGE(PG8_SA(0, 0), cA, voffA); PG8_STAGE(PG8_SB(0, 1), cB + hstep, voffB); PG8_STAGE(PG8_SA(0, 1), cA + hstep, voffA);
        if (wr == 1) PG8_BAR;
        PG8_WAIT_V(4); PG8_BAR;
        PG8_STAGE(PG8_SB(1, 0), cB + kstep, voffB); PG8_STAGE(PG8_SA(1, 0), cA + kstep, voffA); PG8_STAGE(PG8_SB(1, 1), cB + hstep + kstep, voffB);
        PG8_WAIT_V(6); PG8_BAR;
    }
    for (;;) {
        const bool has_next = S.next(ui + 1, nxt);
        const char* nA = has_next ? (const char*)g.A + (size_t)nxt.pm * tstep : cA; const char* nB = has_next ? (const char*)g.Bt + (size_t)nxt.pn * tstep : cB;
        for (int t = 0; t < nt; t += 2) {
            const bool last = (t == nt - 2);
            const char* a1 = cA + (size_t)(t + 1) * kstep;
            const char* a2 = last ? nA : cA + (size_t)(t + 2) * kstep; const char* b2 = last ? nB : cB + (size_t)(t + 2) * kstep;
            const char* a3 = a2 + kstep; const char* b3 = b2 + kstep;
            if (last && has_next) S.a_ready(nxt);
            if constexpr (SP2) {
            PG8_LDB(B0, 0, 0); PG8_LDB(B1, 0, 1); PG8_SCHED; PG8_LDA(At, 0, 0); PG8_STAGE(PG8_SA(1, 1), a1 + hstep, voffA);
            PG8_WAIT_V(8); PG8_WAIT_L(0); PG8_BAR; PG8_MMA(0, 0, At, B0); PG8_MMA(0, 1, At, B1); PG8_BAR; PG8_SCHED;
            PG8_LDA(At, 0, 1); PG8_STAGE(PG8_SB(0, 0), b2, voffB); PG8_STAGE(PG8_SB(0, 1), b2 + hstep, voffB); PG8_STAGE(PG8_SA(0, 0), a2, voffA);
            PG8_WAIT_V(8); PG8_WAIT_L(0); PG8_BAR; PG8_MMA(1, 0, At, B0); PG8_MMA(1, 1, At, B1); PG8_BAR; PG8_SCHED;
            PG8_LDB(B0, 1, 0); PG8_LDB(B1, 1, 1); PG8_SCHED; PG8_LDA(At, 1, 0); PG8_STAGE(PG8_SA(0, 1), a2 + hstep, voffA);
            PG8_WAIT_V(8); PG8_WAIT_L(0); PG8_BAR; PG8_MMA(0, 0, At, B0); PG8_MMA(0, 1, At, B1); PG8_BAR; PG8_SCHED;
            PG8_LDA(At, 1, 1); PG8_STAGE(PG8_SB(1, 0), b3, voffB); PG8_STAGE(PG8_SB(1, 1), b3 + hstep, voffB); PG8_STAGE(PG8_SA(1, 0), a3, voffA);
            PG8_WAIT_V(8); PG8_WAIT_L(0); PG8_BAR; PG8_MMA(1, 0, At, B0); PG8_MMA(1, 1, At, B1); PG8_BAR; PG8_SCHED;
            } else {
            PG8_LDB(B0, 0, 0); PG8_SCHED; PG8_LDA(At, 0, 0); PG8_STAGE(PG8_SA(1, 1), a1 + hstep, voffA);
            PG8_WAIT_L(8); PG8_BAR; PG8_WAIT_L(0); PG8_MMA(0, 0, At, B0); PG8_BAR; PG8_SCHED;
            PG8_LDB(B1, 0, 1); PG8_STAGE(PG8_SB(0, 0), b2, voffB);
            PG8_BAR; PG8_WAIT_L(0); PG8_MMA(0, 1, At, B1); PG8_BAR;
            PG8_LDA(At, 0, 1); PG8_STAGE(PG8_SA(0, 0), a2, voffA);
            PG8_BAR; PG8_WAIT_L(0); PG8_MMA(1, 0, At, B0); PG8_BAR; PG8_SCHED;
            PG8_STAGE(PG8_SB(0, 1), b2 + hstep, voffB);
            PG8_WAIT_V(6); PG8_BAR; PG8_MMA(1, 1, At, B1); PG8_BAR;
            PG8_LDB(B0, 1, 0); PG8_SCHED; PG8_LDA(At, 1, 0); PG8_STAGE(PG8_SA(0, 1), a2 + hstep, voffA);
            PG8_WAIT_L(8); PG8_BAR; PG8_WAIT_L(0); PG8_MMA(0, 0, At, B0); PG8_BAR; PG8_SCHED;
            PG8_LDB(B1, 1, 1); PG8_STAGE(PG8_SB(1, 0), b3, voffB);
            PG8_BAR; PG8_WAIT_L(0); PG8_MMA(0, 1, At, B1); PG8_BAR;
            PG8_LDA(At, 1, 1); PG8_STAGE(PG8_SA(1, 0), a3, voffA);
            PG8_BAR; PG8_WAIT_L(0); PG8_MMA(1, 0, At, B0); PG8_BAR; PG8_SCHED;
            PG8_STAGE(PG8_SB(1, 1), b3 + hstep, voffB);
            PG8_WAIT_V(6); PG8_BAR; PG8_MMA(1, 1, At, B1); PG8_BAR;
            }
        }
        if constexpr (ALIGN_EPI) { if (wr == 0) PG8_BAR; }
        if constexpr (!Epi::AFTER_DRAIN) { E(acc, cur, wr, wc, fr, fq); S.done(cur); }
        if (!has_next) break;
#pragma unroll
        for (int a = 0; a < 2; ++a)
#pragma unroll
            for (int b = 0; b < 2; ++b)
#pragma unroll
                for (int m = 0; m < 4; ++m)
#pragma unroll
                    for (int n = 0; n < 2; ++n) acc[a][b][m][n] = (f32x4){0.f, 0.f, 0.f, 0.f};
        cur = nxt; cA = nA; cB = nB; ++ui;
        if constexpr (ALIGN_EPI) { if (wr == 1) PG8_BAR; }
    }
    PG8_WAIT_V(0);
    if constexpr (!ALIGN_EPI) { if (wr == 0) PG8_BAR; }
    PG8_BAR;
    if constexpr (Epi::AFTER_DRAIN) { E.fused(acc, cur, wr, wc, fr, fq, lds, wid, lane); S.done(cur); }
#undef PG8_SA
#undef PG8_SB
#undef PG8_STAGE
#undef PG8_LDA
#undef PG8_LDB
#undef PG8_MMA
#undef PG8_WAIT_V
#undef PG8_WAIT_L
#undef PG8_BAR
#undef PG8_SCHED
}
}
namespace pg8 {
struct EpiRowScaleBf16 {
    static constexpr bool PERM = true, AFTER_DRAIN = false;
    bf16_t* O; int ldc; const float* rs;
    __device__ __forceinline__ void operator()(const f32x4 (&acc)[2][2][4][2], const Unit& u, int wr, int wc, int fr, int fq) const {
        const int row0 = u.pm * BM + wr * 64 + fr; const int col0 = u.pn * BM + wc * 32 + 8 * fq;
#pragma unroll
        for (int ai = 0; ai < 2; ++ai)
#pragma unroll
            for (int m = 0; m < 4; ++m) { const int row = row0 + ai * HALF + m * 16; const float sc = rs[row]; bf16_t* rowp = O + (size_t)row * ldc + col0;
#pragma unroll
                for (int bj = 0; bj < 2; ++bj) { f32x4 v0 = acc[ai][bj][m][0] * sc, v1 = acc[ai][bj][m][1] * sc;
                    u32x4 w; w.x = cvt_pk_bf16(v0[0], v0[1]); w.y = cvt_pk_bf16(v0[2], v0[3]); w.z = cvt_pk_bf16(v1[0], v1[1]); w.w = cvt_pk_bf16(v1[2], v1[3]);
                    *(u32x4*)(rowp + bj * HALF) = w; } }
    }
};
struct EpiResF32 {
    static constexpr bool PERM = false, AFTER_DRAIN = false;
    const float* base; float* out; int ldc;
    __device__ __forceinline__ void operator()(const f32x4 (&acc)[2][2][4][2], const Unit& u, int wr, int wc, int fr, int fq) const {
        const int col0 = u.pn * BM + wc * 32 + 4 * fq;
#pragma unroll
        for (int ai = 0; ai < 2; ++ai)
#pragma unroll
            for (int m = 0; m < 4; ++m) { const int r = u.pm * BM + ai * HALF + wr * 64 + m * 16 + fr; const size_t off = (size_t)r * ldc + col0;
#pragma unroll
                for (int bj = 0; bj < 2; ++bj)
#pragma unroll
                    for (int n = 0; n < 2; ++n) { const f32x4 bs = *(const f32x4*)(base + off + bj * HALF + n * 16); *(f32x4*)(out + off + bj * HALF + n * 16) = bs + acc[ai][bj][m][n]; } }
    }
};
}

constexpr int NB = 4, T = 8192, D = 1024, M = NB * T;
constexpr int NP = 3584;
constexpr int W_IN_COLS = 3596;
constexpr int C_R = 0, C_K = 512, C_V = 1024, C_G = 1536, C_WD = 2048, C_AD = 2112, C_NQ = 2176, C_NG = 2432, C_KC = 2688, C_VC = 2752,
              C_KS = 2816, C_VS = 2880, C_KW = 2944, C_VW = 3008, C_MQ = 3072, C_MG = 3328;
constexpr int GLOG_SRC = 2688;
constexpr int NCMP = 511, NSEL = 128, MEML = 256;

constexpr size_t MiB = 1u << 20;
constexpr size_t WS_CTL = 0, CTL_ZERO_BYTES = 1 * MiB;
constexpr size_t WS_WIN = 1 * MiB, WS_WOUT = 8 * MiB;
constexpr size_t KiB = 1024;
constexpr size_t WS_ROPE = 10 * MiB, WS_RS = 10 * MiB + 512 * KiB, WS_W1TK = 10 * MiB + 768 * KiB, WS_KCMP = 11 * MiB, WS_VCMP = 11 * MiB + 256 * KiB, WS_W1TV = 11 * MiB + 512 * KiB,
                 WS_WUPT = 11 * MiB + 768 * KiB, WS_AUPT = 11 * MiB + 832 * KiB, WS_W2TK = 11 * MiB + 896 * KiB, WS_W2TV = 11 * MiB + 904 * KiB, WS_MEMKV = 12 * MiB, WS_WKVT = 13 * MiB, WS_GLOG = 14 * MiB, WS_MEMN = 304 * MiB  ;
constexpr size_t WS_P = 16 * MiB, WS_XB = 240 * MiB, WS_CHK_PR = 240 * MiB, WS_Y = 304 * MiB, WS_A = 368 * MiB, WS_CHK_S = 368 * MiB, WS_LW = 400 * MiB, WS_CHK_QY = 432 * MiB, WS_BONUS = 496 * MiB, WS_OTP = 400 * MiB  , WS_END = 497 * MiB;
constexpr int CW_BAR = 4096;

constexpr int RING_BYTES = 131072, LDSCTL_OFF = RING_BYTES, MISC_OFF = LDSCTL_OFF + 320, LDS_BYTES = 147456;
constexpr int NWAVES = 8;

#define GAS __attribute__((address_space(1)))
#define LAS __attribute__((address_space(3)))
typedef unsigned short bf16;
typedef unsigned v4u __attribute__((ext_vector_type(4)));
typedef unsigned v2u __attribute__((ext_vector_type(2)));
typedef float f32x4 __attribute__((ext_vector_type(4)));
#define LDS_WAIT() asm volatile("s_waitcnt lgkmcnt(0)" ::: "memory")
__device__ __forceinline__ unsigned f2bf(float f) { unsigned u = __builtin_bit_cast(unsigned, f); return (u + 0x7fffu + ((u >> 16) & 1u)) >> 16; }
__device__ __forceinline__ unsigned pk2(float lo, float hi) { return f2bf(lo) | (f2bf(hi) << 16); }
__device__ __forceinline__ float bf2f(unsigned short h) { return __builtin_bit_cast(float, (unsigned)h << 16); }
__device__ __forceinline__ float bflo(unsigned u) { return __builtin_bit_cast(float, u << 16); }
__device__ __forceinline__ float bfhi(unsigned u) { return __builtin_bit_cast(float, u & 0xffff0000u); }
__device__ __forceinline__ void unpack8(const v4u v, float (&f)[8]) { f[0] = bflo(v.x); f[1] = bfhi(v.x); f[2] = bflo(v.y); f[3] = bfhi(v.y); f[4] = bflo(v.z); f[5] = bfhi(v.z); f[6] = bflo(v.w); f[7] = bfhi(v.w); }
__device__ __forceinline__ v4u pack8(const float (&f)[8]) { v4u o; o.x = pk2(f[0], f[1]); o.y = pk2(f[2], f[3]); o.z = pk2(f[4], f[5]); o.w = pk2(f[6], f[7]); return o; }
__device__ __forceinline__ float rdlane(float v, int l) { return __builtin_bit_cast(float, __builtin_amdgcn_readlane(__builtin_bit_cast(int, v), l)); }
template <int CTRL> __device__ __forceinline__ float dppf(float v) { return __builtin_bit_cast(float, __builtin_amdgcn_update_dpp(0, __builtin_bit_cast(int, v), CTRL, 0xf, 0xf, true)); }
__device__ __forceinline__ float sum8(float x) { x += dppf<0xB1>(x); x += dppf<0x4E>(x); x += dppf<0x141>(x); return x; }
__device__ __forceinline__ float wave_sum(float v) {
    v += dppf<0xB1>(v); v += dppf<0x4E>(v); v += dppf<0x141>(v); v += dppf<0x140>(v);
    return (rdlane(v, 0) + rdlane(v, 16)) + (rdlane(v, 32) + rdlane(v, 48));
}
__device__ __forceinline__ float xrow_max(float v) { v = fmaxf(v, __shfl_xor(v, 16)); v = fmaxf(v, __shfl_xor(v, 32)); return v; }
__device__ __forceinline__ float xrow_sum(float v) { v += __shfl_xor(v, 16); v += __shfl_xor(v, 32); return v; }
__device__ __forceinline__ float siluf(float x) { return x / (1.f + __expf(-x)); }
__device__ __forceinline__ float sigmf(float x) { return 1.f / (1.f + __expf(-x)); }

#define XB_TMO      128
#define XB_XCNT(j)  (256  + 64 * (j))
#define XB_XSUB(j)  (1280 + 64 * (j))
#define XB_XGEN(j)  (2304 + 64 * (j))
#define XB_TOP      3328
#define XB_TOPGEN   3392
#define XCD_BAR_WORDS 3456
#define XB_SPIN_CAP (1u << 20)
__device__ __forceinline__ unsigned xb_ld(unsigned* p)              { return __hip_atomic_load(p, __ATOMIC_RELAXED, __HIP_MEMORY_SCOPE_AGENT); }
__device__ __forceinline__ unsigned xb_add(unsigned* p, unsigned v) { return __hip_atomic_fetch_add(p, v, __ATOMIC_RELAXED, __HIP_MEMORY_SCOPE_AGENT); }
__device__ __forceinline__ unsigned xb_xcc_id() { return (unsigned)__builtin_amdgcn_s_getreg((3 << 11) | 20) & 0xFu; }
#define XB_SPIN(cond, bar) do { unsigned _sp = 0; while (cond) { __builtin_amdgcn_s_sleep(1); \
    if ((++_sp & 255u) == 0u) { if (xb_ld(&(bar)[XB_TMO])) break; if (_sp > XB_SPIN_CAP) { atomicAdd(&(bar)[XB_TMO], 1u); break; } } } } while (0)
struct XcdBarrier { unsigned* bar; unsigned x; volatile LAS unsigned* st; };
__device__ __forceinline__ XcdBarrier xcd_barrier_post(unsigned* bar, volatile LAS unsigned* st) {
    XcdBarrier b; b.bar = bar; b.x = xb_xcc_id(); b.st = st;
    if (threadIdx.x == 0) (void)xb_add(&bar[XB_XCNT(b.x)], 1u);
    return b;
}
__device__ __forceinline__ void xcd_barrier_complete(unsigned* bar, unsigned x, unsigned& nloc, unsigned& nx) {
    const unsigned G = gridDim.x * gridDim.y * gridDim.z;
    unsigned sum, cnt, mine, sp = 0u;
    for (;;) {
        sum = 0u; cnt = 0u; mine = 0u;
#pragma unroll
        for (unsigned j = 0; j < 16; ++j) { const unsigned c = xb_ld(&bar[XB_XCNT(j)]); sum += c; cnt += (c > 0u) ? 1u : 0u; mine = (j == x) ? c : mine; }
        if (sum == G) break;
        __builtin_amdgcn_s_sleep(1);
        if ((++sp & 255u) == 0u) { if (xb_ld(&bar[XB_TMO])) break; if (sp > XB_SPIN_CAP) { atomicAdd(&bar[XB_TMO], 1u); break; } }
    }
    nloc = mine > 0u ? mine : 1u; nx = cnt > 0u ? cnt : 1u;
}
__device__ __forceinline__ void xcd_barrier(const XcdBarrier& b) {
    asm volatile("s_waitcnt vmcnt(0)" ::: "memory");
    __syncthreads();
    if (threadIdx.x == 0) {
        unsigned* bar = b.bar;
        __builtin_amdgcn_s_waitcnt(0);
        unsigned nloc = b.st[0], nx = b.st[1];
        if (nloc == 0u) { xcd_barrier_complete(bar, b.x, nloc, nx); b.st[0] = nloc; b.st[1] = nx; }
        const unsigned old = xb_add(&bar[XB_XSUB(b.x)], 1u);
        const unsigned gen = old / nloc;
        if (old + 1u == (gen + 1u) * nloc) {
            __builtin_amdgcn_fence(__ATOMIC_RELEASE, "agent");
            asm volatile("s_waitcnt vmcnt(0)" ::: "memory");
            const unsigned og = xb_add(&bar[XB_TOP], 1u);
            const unsigned tg = og / nx;
            if (og + 1u == (tg + 1u) * nx) xb_add(&bar[XB_TOPGEN], 1u);
            else XB_SPIN(xb_ld(&bar[XB_TOPGEN]) == tg, bar);
            __builtin_amdgcn_fence(__ATOMIC_ACQUIRE, "agent");
            xb_add(&bar[XB_XGEN(b.x)], 1u);
            asm volatile("s_waitcnt vmcnt(0)" ::: "memory");
        } else {
            XB_SPIN(xb_ld(&bar[XB_XGEN(b.x)]) == gen, bar);
            __builtin_amdgcn_fence(__ATOMIC_ACQUIRE, "agent");
            asm volatile("s_waitcnt vmcnt(0)" ::: "memory");
        }
    }
    __syncthreads();
}

struct Args { const float* in[26]; float* out; unsigned char* ws; };

__device__ __forceinline__ void p0_transpose_item(const float* W, int ldw, int src_col0, const float* kscale, bf16* WT, int K, int dst_row0, int k0, LAS float* scr, int lane) {
    float tv[32];
#pragma unroll
    for (int i = 0; i < 32; ++i) { const int kk = 2 * i + (lane >> 5); tv[i] = W[(size_t)(k0 + kk) * ldw + src_col0 + (lane & 31)]; }
#pragma unroll
    for (int i = 0; i < 32; ++i) { const int kk = 2 * i + (lane >> 5); float v = tv[i]; if (kscale) v *= kscale[k0 + kk]; scr[kk * 33 + (lane & 31)] = v; }
    LDS_WAIT(); asm volatile("" ::: "memory");
    const int c = lane & 7;
#pragma unroll
    for (int j = 0; j < 4; ++j) { const int n = (lane >> 3) + 8 * j; const LAS float* s = scr + (8 * c) * 33 + n;
        v4u o; o.x = pk2(s[0 * 33], s[1 * 33]); o.y = pk2(s[2 * 33], s[3 * 33]); o.z = pk2(s[4 * 33], s[5 * 33]); o.w = pk2(s[6 * 33], s[7 * 33]);
        *(v4u*)(WT + (size_t)(dst_row0 + n) * K + k0 + 8 * c) = o; }
    LDS_WAIT(); asm volatile("" ::: "memory");
}
__device__ __forceinline__ double rope_inv_freq(int i) {
    return i == 0 ? 1.0 : i == 1 ? 0.19392274474868576 : i == 2 ? 0.03760603093086393 : i == 3 ? 0.007292664737217109 : i == 4 ? 0.001414213562373095 :
           i == 5 ? 0.0002742481756762073 : i == 6 ? 5.318295896944988e-05 : 1.031338537721246e-05;
}
__device__ __forceinline__ void rope_cs(int pos, int i, float& c, float& s) {
    const double ang = (double)pos * rope_inv_freq(i);
    const double n = __builtin_rint(ang * 0.15915494309189535);
    const double r = __builtin_fma(-n, 6.283185307179586, ang);
    const double kq = __builtin_rint(r * 0.6366197723675814);
    const double y = __builtin_fma(-kq, 1.5707963267948966, r);
    const double y2 = y * y;
    const double sy = y * (1.0 + y2 * (-1.0 / 6 + y2 * (1.0 / 120 + y2 * (-1.0 / 5040 + y2 * (1.0 / 362880 - y2 * (1.0 / 39916800))))));
    const double cy = 1.0 + y2 * (-0.5 + y2 * (1.0 / 24 + y2 * (-1.0 / 720 + y2 * (1.0 / 40320 + y2 * (-1.0 / 3628800 + y2 * (1.0 / 479001600))))));
    const int q = ((int)kq) & 3;
    const double cc = q == 0 ? cy : q == 1 ? -sy : q == 2 ? -cy : sy;
    const double ss = q == 0 ? sy : q == 1 ? cy : q == 2 ? -sy : -cy;
    c = (float)cc; s = (float)ss;
}

#ifndef REPEAT
#define REPEAT 0
#endif
#define RPT(k) (((REPEAT >> (k)) & 1) ? 2 : 1)

typedef short bf16x8 __attribute__((ext_vector_type(8)));
typedef short v4i16 __attribute__((ext_vector_type(4)));
#define MFMA16(a, b, c) __builtin_amdgcn_mfma_f32_16x16x32_bf16(a, b, c, 0, 0, 0)
constexpr int AT_SLOT = 16384, AT_RING = 3 * AT_SLOT, AT_IMP = AT_RING, AT_IMP_W = 8448, AT_SELM = AT_IMP + 8 * AT_IMP_W, AT_TILEM = AT_SELM + 1024, AT_LIST = AT_TILEM + 16, AT_NB = AT_LIST + 544;
constexpr float SM_C = 0.125f * 1.4426950408889634f;
#define AT_WAITBAR(N) asm volatile("s_waitcnt vmcnt(" #N ") lgkmcnt(0)\n\ts_barrier" ::: "memory")

struct Grp { bf16x8 q[2]; f32x4 o[4]; float m, l; };

__device__ __forceinline__ void glds16(const void* gsrc, unsigned lds_dst) { unsigned keep;
    asm volatile("s_mov_b32 %0, m0\n\ts_mov_b32 m0, %2\n\ts_nop 0\n\tglobal_load_lds_dwordx4 %1, off\n\ts_mov_b32 m0, %0" : "=&s"(keep) : "v"(gsrc), "s"(lds_dst) : "memory"); }
__device__ __forceinline__ void at_dma(const bf16* kb, size_t kpitch, const bf16* vb, size_t vpitch, LAS unsigned char* slot, int tid, int wave, bool withV) {
    const int r = tid >> 3, c = (tid & 7) ^ (2 * ((r >> 1) & 3));
    const unsigned dst = (unsigned)__builtin_amdgcn_readfirstlane((int)((unsigned)(size_t)slot + (unsigned)wave * 1024u));
    glds16(kb + (size_t)r * kpitch + c * 8, dst);
    if (withV) glds16(vb + (size_t)r * vpitch + c * 8, dst + 8192u);
}
__device__ __forceinline__ unsigned cvtpk(float lo, float hi) { typedef float f2 __attribute__((ext_vector_type(2))); typedef __bf16 b2 __attribute__((ext_vector_type(2))); f2 v = {lo, hi}; b2 b = __builtin_convertvector(v, b2); return __builtin_bit_cast(unsigned, b); }
__device__ __forceinline__ float fmax3(float a, float b, float c) { return fmaxf(fmaxf(a, b), c); }

template <int NG, int MODE>
__device__ __forceinline__ void at_block(Grp (&G)[NG], LAS const unsigned char* slot, int koff0, int koff1, const int (&vdt)[4], int g, const int (&lo)[NG], const int (&hi)[NG], const bool (&need)[NG], const bool (&on)[NG], bool partial,
                                         LAS float* impA, LAS float* impB, int sb0, int lane) {
    bf16x8 kf[4][2];
#pragma unroll
    for (int kt = 0; kt < 4; ++kt) { kf[kt][0] = *(const LAS bf16x8*)(slot + kt * 2048 + koff0); kf[kt][1] = *(const LAS bf16x8*)(slot + kt * 2048 + koff1); }
    bf16x8 pf[NG][2];
#pragma unroll
    for (int gi = 0; gi < NG; ++gi) {
        if (!need[gi]) continue;
        f32x4 s[4];
#pragma unroll
        for (int kt = 0; kt < 4; ++kt) { s[kt] = (f32x4){0.f, 0.f, 0.f, 0.f}; s[kt] = MFMA16(kf[kt][0], G[gi].q[0], s[kt]); s[kt] = MFMA16(kf[kt][1], G[gi].q[1], s[kt]); }
        if (partial) {
#pragma unroll
            for (int kt = 0; kt < 4; ++kt)
#pragma unroll
                for (int r = 0; r < 4; ++r) { const int kl = 16 * kt + 4 * g + r; if (kl < lo[gi] || kl > hi[gi]) s[kt][r] = -INFINITY; }
        }
        float mref;
        if (MODE != 1) {
            float mx = fmax3(s[0][0], s[0][1], s[0][2]); mx = fmax3(mx, s[0][3], s[1][0]); mx = fmax3(mx, s[1][1], s[1][2]); mx = fmax3(mx, s[1][3], s[2][0]);
            mx = fmax3(mx, s[2][1], s[2][2]); mx = fmax3(mx, s[2][3], s[3][0]); mx = fmax3(mx, s[3][1], s[3][2]); mx = fmaxf(mx, s[3][3]);
            mx = xrow_max(mx);
            const float mn = fmaxf(G[gi].m, on[gi] ? mx * SM_C : -INFINITY);
            const float alpha = __builtin_amdgcn_exp2f(G[gi].m - mn);
            G[gi].m = mn; mref = on[gi] ? mn : INFINITY;
            if (__builtin_amdgcn_ballot_w64(alpha != 1.0f)) {
                G[gi].l *= alpha;
                if (MODE == 2) {
#pragma unroll
                    for (int dt = 0; dt < 4; ++dt) G[gi].o[dt] *= alpha; }
            }
        } else mref = G[gi].m;
        float lsum = 0.f;
#pragma unroll
        for (int kt = 0; kt < 4; ++kt)
#pragma unroll
            for (int r = 0; r < 4; ++r) { const float p = __builtin_amdgcn_exp2f(__builtin_fmaf(s[kt][r], SM_C, -mref)); s[kt][r] = p; lsum += p; }
        if (MODE != 1) G[gi].l += lsum;
        if (MODE == 1) {
            const float il = G[gi].l;
#pragma unroll
            for (int kt = 0; kt < 4; ++kt) { s[kt] *= il;
                float a = s[kt][0] + s[kt][1] + s[kt][2] + 0.5f * s[kt][3], b = 0.5f * s[kt][3];
                a += dppf<0xB1>(a); a += dppf<0x4E>(a); b += dppf<0xB1>(b); b += dppf<0x4E>(b);
                if ((lane & 3) == 0) { const int q8 = gi * 4 + ((lane & 15) >> 2); impA[q8 * 132 + sb0 + 4 * kt + g] = a; impB[q8 * 132 + sb0 + 4 * kt + g + 1] = b; } }
        }
        if (MODE != 0) {
            pf[gi][0] = __builtin_bit_cast(bf16x8, (v4u){cvtpk(s[0][0], s[0][1]), cvtpk(s[0][2], s[0][3]), cvtpk(s[1][0], s[1][1]), cvtpk(s[1][2], s[1][3])});
            pf[gi][1] = __builtin_bit_cast(bf16x8, (v4u){cvtpk(s[2][0], s[2][1]), cvtpk(s[2][2], s[2][3]), cvtpk(s[3][0], s[3][1]), cvtpk(s[3][2], s[3][3])});
        }
    }
    if (MODE != 0) {
        LAS const unsigned char* vs = slot + 8192;
#pragma unroll
        for (int dt = 0; dt < 4; ++dt) {
            bf16x8 vf[2];
#pragma unroll
            for (int kp = 0; kp < 2; ++kp) {
                const v4i16 a = __builtin_amdgcn_ds_read_tr16_b64_v4i16((LAS v4i16*)(vs + vdt[dt] + (2 * kp) * 2048));
                const v4i16 b = __builtin_amdgcn_ds_read_tr16_b64_v4i16((LAS v4i16*)(vs + vdt[dt] + (2 * kp + 1) * 2048));
                vf[kp] = (bf16x8){a[0], a[1], a[2], a[3], b[0], b[1], b[2], b[3]};
            }
#pragma unroll
            for (int gi = 0; gi < NG; ++gi) if (need[gi]) { G[gi].o[dt] = MFMA16(vf[0], pf[gi][0], G[gi].o[dt]); G[gi].o[dt] = MFMA16(vf[1], pf[gi][1], G[gi].o[dt]); }
        }
    }
}


template <int N> __device__ __forceinline__ void at_waitbar_blocks(int ahead, bool withv) {
    if (withv) { switch (ahead) { case 0: AT_WAITBAR(0); break; case 1: AT_WAITBAR(2); break; case 2: AT_WAITBAR(4); break; case 3: AT_WAITBAR(6); break; default: AT_WAITBAR(8); break; } }
    else { switch (ahead) { case 0: AT_WAITBAR(0); break; case 1: AT_WAITBAR(1); break; case 2: AT_WAITBAR(2); break; case 3: AT_WAITBAR(3); break; default: AT_WAITBAR(4); break; } }
}
template <bool WITHV, int NSLOT, class Src, class Body>
__device__ __forceinline__ void at_ring(LAS unsigned char* ring, int nb, int tid, int wave, const Src& src, Body& body) {
    const bf16 *kb = nullptr, *vb = nullptr; size_t kp = 0, vp = 0;
#pragma unroll
    for (int j = 0; j < NSLOT - 1; ++j) if (j < nb) { src(j, kb, kp, vb, vp); at_dma(kb, kp, vb, vp, ring + j * AT_SLOT, tid, wave, WITHV); }
    int sl = 0, sn = NSLOT - 1;
    for (int i = 0; i < nb; ++i) {
        const int last = (i + NSLOT - 2 < nb - 1) ? i + NSLOT - 2 : nb - 1;
        at_waitbar_blocks<NSLOT>(last - i, WITHV);
        if (i + NSLOT - 1 < nb) { src(i + NSLOT - 1, kb, kp, vb, vp); at_dma(kb, kp, vb, vp, ring + sn * AT_SLOT, tid, wave, WITHV); }
        body(i, ring + sl * AT_SLOT);
        sl = (sl + 1 == NSLOT) ? 0 : sl + 1; sn = (sn + 1 == NSLOT) ? 0 : sn + 1;
    }
    AT_WAITBAR(0);
}

struct LaneGeo { int lane, i16, g, koff0, koff1; int vdt[4]; };
__device__ __forceinline__ LaneGeo make_geo(int lane) {
    LaneGeo L; L.lane = lane; L.i16 = lane & 15; L.g = lane >> 4;
    const int swz = 2 * ((L.i16 >> 1) & 3);
    L.koff0 = L.i16 * 128 + (((0 ^ (swz >> 2)) * 4 + (L.g ^ (swz & 3))) * 16);
    L.koff1 = L.i16 * 128 + (((1 ^ (swz >> 2)) * 4 + (L.g ^ (swz & 3))) * 16);
    const int sv = (2 * L.g + (L.i16 >> 3)) & 3; const int vbase = (4 * L.g + (L.i16 >> 2)) * 128 + 8 * (L.i16 & 1) + ((L.i16 & 3) >> 1) * 16;
#pragma unroll
    for (int dt = 0; dt < 4; ++dt) L.vdt[dt] = vbase + ((dt ^ sv) << 5);
    return L;
}
__device__ __forceinline__ float xg_sum(float v) { return xrow_sum(v); }

struct SrcCmp { const bf16* K; const bf16* V; int b; __device__ __forceinline__ void operator()(int i, const bf16*& kb, size_t& kp, const bf16*& vb, size_t& vp) const {
    kb = K + (size_t)(b * 512 + 64 * i) * 64; kp = 64; vb = V + (size_t)(b * 512 + 64 * i) * 64; vp = 64; } };
struct SrcSel { const bf16* P; LAS const unsigned* list; bool use_list; int b; int kcol, vcol; int s0;
    __device__ __forceinline__ void operator()(int i, const bf16*& kb, size_t& kp, const bf16*& vb, size_t& vp) const {
        const int s = use_list ? (int)__builtin_amdgcn_readfirstlane(list[i]) : s0 + i; const bf16* base = P + (size_t)(b * T + 64 * s) * NP; kb = base + kcol; vb = base + vcol; kp = NP; vp = NP; } };

struct BodyCmp0 { Grp (&G)[2]; const LaneGeo& L; const int (&nv)[2];
    __device__ __forceinline__ void operator()(int i, LAS const unsigned char* slot) {
        const int lo[2] = {0, 0}; const int hi[2] = {nv[0] - 64 * i - 1, nv[1] - 64 * i - 1}; const bool need[2] = {true, true}, on[2] = {true, true};
        const bool partial = __builtin_amdgcn_ballot_w64(hi[0] < 63 || hi[1] < 63) != 0ull;
        at_block<2, 0>(G, slot, L.koff0, L.koff1, L.vdt, L.g, lo, hi, need, on, partial, nullptr, nullptr, 0, L.lane); } };
struct BodyCmp1 { Grp (&G)[2]; const LaneGeo& L; const int (&nv)[2]; LAS float* impA; LAS float* impB;
    __device__ __forceinline__ void operator()(int i, LAS const unsigned char* slot) {
        const int lo[2] = {0, 0}; const int hi[2] = {nv[0] - 64 * i - 1, nv[1] - 64 * i - 1}; const bool need[2] = {true, true}, on[2] = {true, true};
        const bool partial = __builtin_amdgcn_ballot_w64(hi[0] < 63 || hi[1] < 63) != 0ull;
        at_block<2, 1>(G, slot, L.koff0, L.koff1, L.vdt, L.g, lo, hi, need, on, partial, impA, impB, 16 * i, L.lane); } };
struct BodySel { Grp (&G)[2]; const LaneGeo& L; LAS const unsigned* list; LAS const unsigned* selm; const int (&tql)[2]; int cur;
    __device__ __forceinline__ void operator()(int i, LAS const unsigned char* slot) {
        const int s = (int)__builtin_amdgcn_readfirstlane(list[i]); const int w = s >> 5, bit = s & 31;
        const int lo[2] = {0, 0}; int hi[2]; bool need[2], on[2];
#pragma unroll
        for (int gi = 0; gi < 2; ++gi) { const unsigned word = selm[tql[gi] * 4 + w]; on[gi] = (word >> bit) & 1u;
            hi[gi] = (s == cur) ? tql[gi] : 63; need[gi] = __builtin_amdgcn_ballot_w64(on[gi]) != 0ull; }
        if (!need[0] && !need[1]) return;
        at_block<2, 2>(G, slot, L.koff0, L.koff1, L.vdt, L.g, lo, hi, need, on, s == cur, nullptr, nullptr, 0, L.lane); } };
struct BodyWin { Grp (&G)[2]; const LaneGeo& L; const int (&tql)[2]; int cur, s0;
    __device__ __forceinline__ void operator()(int i, LAS const unsigned char* slot) {
        const int s = s0 + i; int lo[2], hi[2]; const bool need[2] = {true, true}, on[2] = {true, true};
#pragma unroll
        for (int gi = 0; gi < 2; ++gi) { lo[gi] = (s == cur - 8) ? tql[gi] + 1 : 0; hi[gi] = (s == cur) ? tql[gi] : 63; }
        const bool partial = (s == cur) || (s == cur - 8);
        at_block<2, 2>(G, slot, L.koff0, L.koff1, L.vdt, L.g, lo, hi, need, on, partial, nullptr, nullptr, 0, L.lane); } };

__device__ __forceinline__ void grp_reset(Grp& g) { g.m = -1e30f; g.l = 0.f;
#pragma unroll
    for (int dt = 0; dt < 4; ++dt) g.o[dt] = (f32x4){0.f, 0.f, 0.f, 0.f}; }

__device__ __forceinline__ void nsa_unit(int b, int cur, LAS unsigned char* lds, int tid, int wave, int lane, const bf16* P, const bf16* KCMPb, const bf16* VCMPb, const float* GLOG, const float* gate_b,
                                         const float* nsa_out_g, const float* ROPE, bf16* Y, float* otp_wave) {
    LAS unsigned char* ring = lds;
    LAS float* impA = (LAS float*)(lds + AT_IMP + wave * AT_IMP_W); LAS float* impB = impA + 8 * 132;
    LAS unsigned* selm = (LAS unsigned*)(lds + AT_SELM); LAS unsigned* tilem = (LAS unsigned*)(lds + AT_TILEM); LAS unsigned* blist = (LAS unsigned*)(lds + AT_LIST); LAS unsigned* nbw = (LAS unsigned*)(lds + AT_NB);
    const LaneGeo L = make_geo(lane);
    const int t0 = cur * 64; const size_t m0 = (size_t)b * T + t0;
    const int h = L.i16 & 3;
    int tql[2]; tql[0] = 8 * wave + (L.i16 >> 2); tql[1] = tql[0] + 4;
    if (tid < 4) tilem[tid] = 0u;
    Grp G[2]; int nv[2];
    float* otp = otp_wave + lane;
#pragma unroll
    for (int gi = 0; gi < 2; ++gi) {
        const bf16* qp = P + (m0 + tql[gi]) * NP + C_NQ + h * 64 + 8 * L.g;
        G[gi].q[0] = *(const bf16x8*)qp; G[gi].q[1] = *(const bf16x8*)(qp + 32);
        const int tq = t0 + tql[gi]; nv[gi] = tq >= 31 ? min((tq - 31) / 16 + 1, NCMP) : 0;
        grp_reset(G[gi]);
    }
    asm volatile("" :: "v"(G[0].q[0]), "v"(G[0].q[1]), "v"(G[1].q[0]), "v"(G[1].q[1]));
    for (int i = lane; i < 2 * 8 * 132; i += 64) impA[i] = 0.f;
    const int nvmax = (t0 + 63 >= 31) ? min((t0 + 63 - 31) / 16 + 1, NCMP) : 0; const int nblk = (nvmax + 63) >> 6;
    for (int rp_ = 0; rp_ < RPT(8); ++rp_) { grp_reset(G[0]); grp_reset(G[1]); SrcCmp src{KCMPb, VCMPb, b}; BodyCmp0 body{G, L, nv}; at_ring<false, 3>(ring, nblk, tid, wave, src, body); }
#pragma unroll
    for (int gi = 0; gi < 2; ++gi) { const float lt = xg_sum(G[gi].l); G[gi].l = 1.0f / fmaxf(lt, 1e-30f); }
    for (int rp_ = 0; rp_ < RPT(9); ++rp_) {
#pragma unroll
        for (int gi = 0; gi < 2; ++gi)
#pragma unroll
            for (int dt = 0; dt < 4; ++dt) G[gi].o[dt] = (f32x4){0.f, 0.f, 0.f, 0.f};
        SrcCmp src{KCMPb, VCMPb, b}; BodyCmp1 body{G, L, nv, impA, impB}; at_ring<true, 3>(ring, nblk, tid, wave, src, body); }
    for (int rp_ = 0; rp_ < RPT(10); ++rp_) {
        unsigned long long accA = 0ull, accB = 0ull;
        const unsigned long long validA = cur >= 63 ? ~0ull : ((1ull << (cur + 1)) - 1ull), validB = cur < 64 ? 0ull : (cur >= 127 ? ~0ull : ((1ull << (cur - 63)) - 1ull));
#pragma unroll 1
        for (int q8 = 0; q8 < 8; ++q8) {
            const float fa = impA[q8 * 132 + lane] + impB[q8 * 132 + lane], fb = impA[q8 * 132 + 64 + lane] + impB[q8 * 132 + 64 + lane];
            const int sa = lane, sb = lane + 64;
            unsigned va = __builtin_bit_cast(unsigned, fa), vb = __builtin_bit_cast(unsigned, fb);
            if (sa == 0 || sa == cur || sa == cur - 1) va = 0x7f000000u; else if (sa > cur) va = 0u;
            if (sb == cur || sb == cur - 1) vb = 0x7f000000u; else if (sb > cur) vb = 0u;
            unsigned tau = 0u;
#pragma unroll 1
            for (int bit = 30; bit >= 0; --bit) { const unsigned cand = tau | (1u << bit);
                const int cnt = __builtin_popcountll(__builtin_amdgcn_ballot_w64(va >= cand)) + __builtin_popcountll(__builtin_amdgcn_ballot_w64(vb >= cand));
                if (cnt >= 16) tau = cand; }
            const unsigned long long gtA = __builtin_amdgcn_ballot_w64(va > tau), gtB = __builtin_amdgcn_ballot_w64(vb > tau);
            const unsigned long long eqA = __builtin_amdgcn_ballot_w64(va == tau), eqB = __builtin_amdgcn_ballot_w64(vb == tau);
            const int needn = 16 - __builtin_popcountll(gtA) - __builtin_popcountll(gtB); const int nA = __builtin_popcountll(eqA);
            const int takeA = min(needn, nA), takeB = needn - takeA;
            const int rA = __builtin_amdgcn_mbcnt_hi((unsigned)(eqA >> 32), __builtin_amdgcn_mbcnt_lo((unsigned)eqA, 0));
            const int rB = __builtin_amdgcn_mbcnt_hi((unsigned)(eqB >> 32), __builtin_amdgcn_mbcnt_lo((unsigned)eqB, 0));
            const unsigned long long selA = (gtA | __builtin_amdgcn_ballot_w64(va == tau && rA < takeA)) & validA;
            const unsigned long long selB = (gtB | __builtin_amdgcn_ballot_w64(vb == tau && rB < takeB)) & validB;
            if (lane == 0) { LAS unsigned* d = selm + (8 * wave + q8) * 4; d[0] = (unsigned)selA; d[1] = (unsigned)(selA >> 32); d[2] = (unsigned)selB; d[3] = (unsigned)(selB >> 32); }
            accA |= selA; accB |= selB;
        }
        if (lane == 0) { atomicOr((unsigned*)&tilem[0], (unsigned)accA); atomicOr((unsigned*)&tilem[1], (unsigned)(accA >> 32)); atomicOr((unsigned*)&tilem[2], (unsigned)accB); atomicOr((unsigned*)&tilem[3], (unsigned)(accB >> 32)); }
    }
    AT_WAITBAR(0);
    if (wave == 0) {
        const unsigned long long mA = (unsigned long long)tilem[0] | ((unsigned long long)tilem[1] << 32), mB = (unsigned long long)tilem[2] | ((unsigned long long)tilem[3] << 32);
        const int rA = __builtin_amdgcn_mbcnt_hi((unsigned)(mA >> 32), __builtin_amdgcn_mbcnt_lo((unsigned)mA, 0));
        const int rB = __builtin_amdgcn_mbcnt_hi((unsigned)(mB >> 32), __builtin_amdgcn_mbcnt_lo((unsigned)mB, 0));
        const int nA = __builtin_popcountll(mA);
        if ((mA >> lane) & 1ull) blist[rA] = (unsigned)lane;
        if ((mB >> lane) & 1ull) blist[nA + rB] = (unsigned)(64 + lane);
        if (lane == 0) nbw[0] = (unsigned)(nA + __builtin_popcountll(mB));
    }
    AT_WAITBAR(0);
    const int nsel = (int)__builtin_amdgcn_readfirstlane(nbw[0]);
#pragma unroll
    for (int gi = 0; gi < 2; ++gi) { const float gt = sigmf(GLOG[(m0 + tql[gi]) * 12 + h * 3 + 0] + gate_b[h * 3 + 0]);
#pragma unroll
        for (int dt = 0; dt < 4; ++dt)
#pragma unroll
            for (int r = 0; r < 4; ++r) otp[((gi * 4 + dt) * 4 + r) * 64] = G[gi].o[dt][r] * gt; }
#pragma unroll
    for (int gi = 0; gi < 2; ++gi) {
        const int tq = t0 + tql[gi];
        float xf[8]; unpack8(__builtin_bit_cast(v4u, G[gi].q[0]), xf);
        float of[8];
#pragma unroll
        for (int j = 0; j < 8; ++j) of[j] = __shfl_xor(xf[j], 16);
        if (L.g < 2) {
            const f32x4 c0 = *(const f32x4*)(ROPE + tq * 16), c1 = *(const f32x4*)(ROPE + tq * 16 + 4), s0 = *(const f32x4*)(ROPE + tq * 16 + 8), s1 = *(const f32x4*)(ROPE + tq * 16 + 12);
            const float cs[8] = {c0.x, c0.y, c0.z, c0.w, c1.x, c1.y, c1.z, c1.w}, sn[8] = {s0.x, s0.y, s0.z, s0.w, s1.x, s1.y, s1.z, s1.w};
#pragma unroll
            for (int j = 0; j < 8; ++j) xf[j] = (L.g == 0) ? (xf[j] * cs[j] - of[j] * sn[j]) : (xf[j] * cs[j] + of[j] * sn[j]);
        }
        G[gi].q[0] = __builtin_bit_cast(bf16x8, pack8(xf));
        grp_reset(G[gi]);
    }
    for (int rp_ = 0; rp_ < RPT(11); ++rp_) { grp_reset(G[0]); grp_reset(G[1]); SrcSel src{P, blist, true, b, C_KS, C_VS, 0}; BodySel body{G, L, blist, selm, tql, cur}; at_ring<true, 6>(ring, nsel, tid, wave, src, body); }
#pragma unroll
    for (int gi = 0; gi < 2; ++gi) { const float il = sigmf(GLOG[(m0 + tql[gi]) * 12 + h * 3 + 1] + gate_b[h * 3 + 1]) / fmaxf(xg_sum(G[gi].l), 1e-30f);
#pragma unroll
        for (int dt = 0; dt < 4; ++dt)
#pragma unroll
            for (int r = 0; r < 4; ++r) otp[((gi * 4 + dt) * 4 + r) * 64] += G[gi].o[dt][r] * il;
        grp_reset(G[gi]); }
    for (int rp_ = 0; rp_ < RPT(12); ++rp_) { grp_reset(G[0]); grp_reset(G[1]); const int s0 = max(0, cur - 8); SrcSel src{P, blist, false, b, C_KW, C_VW, s0}; BodyWin body{G, L, tql, cur, s0}; at_ring<true, 6>(ring, cur - s0 + 1, tid, wave, src, body); }
#pragma unroll
    for (int gi = 0; gi < 2; ++gi) { const float il = sigmf(GLOG[(m0 + tql[gi]) * 12 + h * 3 + 2] + gate_b[h * 3 + 2]) / fmaxf(xg_sum(G[gi].l), 1e-30f);
#pragma unroll
        for (int dt = 0; dt < 4; ++dt)
#pragma unroll
            for (int r = 0; r < 4; ++r) G[gi].o[dt][r] = otp[((gi * 4 + dt) * 4 + r) * 64] + G[gi].o[dt][r] * il; }
#pragma unroll
    for (int gi = 0; gi < 2; ++gi) {
        float ss = 0.f;
#pragma unroll
        for (int dt = 0; dt < 4; ++dt) ss += G[gi].o[dt].x * G[gi].o[dt].x + G[gi].o[dt].y * G[gi].o[dt].y + G[gi].o[dt].z * G[gi].o[dt].z + G[gi].o[dt].w * G[gi].o[dt].w;
        ss = xg_sum(ss); const float sc = 1.0f / sqrtf(ss * (1.f / 64.f) + 1e-6f);
        const size_t mq = m0 + tql[gi];
#pragma unroll
        for (int dt = 0; dt < 4; ++dt) { const int d = h * 64 + 16 * dt + 4 * L.g;
            const f32x4 gn = *(const f32x4*)(nsa_out_g + d); const v2u gt = *(const v2u*)(P + mq * NP + C_NG + d);
            const float o0 = G[gi].o[dt].x * sc * gn.x * siluf(bflo(gt.x)), o1 = G[gi].o[dt].y * sc * gn.y * siluf(bfhi(gt.x)), o2 = G[gi].o[dt].z * sc * gn.z * siluf(bflo(gt.y)), o3 = G[gi].o[dt].w * sc * gn.w * siluf(bfhi(gt.y));
            *(v2u*)(Y + mq * D + 512 + d) = (v2u){pk2(o0, o1), pk2(o2, o3)}; }
    }
}

struct SrcMem { const bf16* KV; int b; __device__ __forceinline__ void operator()(int i, const bf16*& kb, size_t& kp, const bf16*& vb, size_t& vp) const {
    const int hh = i >> 2, blk = i & 3; kb = KV + (size_t)(b * MEML + 64 * blk) * 512 + hh * 64; vb = kb + 256; kp = 512; vp = 512; } };
struct BodyMem { Grp (&G)[1]; const LaneGeo& L; const bf16* P; bf16* Y; const float* og; size_t mq;
    __device__ __forceinline__ void operator()(int i, LAS const unsigned char* slot) {
        const int hh = i >> 2, blk = i & 3;
        if (blk == 0) { const bf16* qp = P + mq * NP + C_MQ + hh * 64 + 8 * L.g; G[0].q[0] = *(const bf16x8*)qp; G[0].q[1] = *(const bf16x8*)(qp + 32); grp_reset(G[0]); }
        const int lo[1] = {0}, hi[1] = {63}; const bool need[1] = {true}, on[1] = {true};
        at_block<1, 2>(G, slot, L.koff0, L.koff1, L.vdt, L.g, lo, hi, need, on, false, nullptr, nullptr, 0, L.lane);
        if (blk == 3) {
            const float il = 1.0f / fmaxf(xg_sum(G[0].l), 1e-30f); float ss = 0.f;
#pragma unroll
            for (int dt = 0; dt < 4; ++dt) { G[0].o[dt] *= il; ss += G[0].o[dt].x * G[0].o[dt].x + G[0].o[dt].y * G[0].o[dt].y + G[0].o[dt].z * G[0].o[dt].z + G[0].o[dt].w * G[0].o[dt].w; }
            ss = xg_sum(ss); const float sc = 1.0f / sqrtf(ss * (1.f / 64.f) + 1e-6f);
#pragma unroll
            for (int dt = 0; dt < 4; ++dt) { const int d = hh * 64 + 16 * dt + 4 * L.g;
                const f32x4 gn = *(const f32x4*)(og + d); const v2u gt = *(const v2u*)(P + mq * NP + C_MG + d); const f32x4 o = G[0].o[dt];
                const float o0 = o.x * sc * gn.x * siluf(bflo(gt.x)), o1 = o.y * sc * gn.y * siluf(bfhi(gt.x)), o2 = o.z * sc * gn.z * siluf(bflo(gt.y)), o3 = o.w * sc * gn.w * siluf(bfhi(gt.y));
                *(v2u*)(Y + mq * D + 768 + d) = (v2u){pk2(o0, o1), pk2(o2, o3)}; }
        }
    } };

constexpr int RW_PITCH = 144, RW_MAT = 64 * RW_PITCH;
constexpr int RW_KKT = 0 * RW_MAT, RW_KD = 1 * RW_MAT, RW_U = 1 * RW_MAT, RW_BD = 2 * RW_MAT, RW_TII = 2 * RW_MAT, RW_RT = 3 * RW_MAT, RW_KH = 4 * RW_MAT, RW_BH = 5 * RW_MAT, RW_V = 6 * RW_MAT,
              RW_ABK = 7 * RW_MAT, RW_AVK = 8 * RW_MAT, RW_ARK = 9 * RW_MAT, RW_ARB = 10 * RW_MAT, RW_M1 = 11 * RW_MAT, RW_M2 = 12 * RW_MAT, RW_WC = 13 * RW_MAT;
typedef short s16x4 __attribute__((ext_vector_type(4)));
#define MFMA16K16(a, b, c) __builtin_amdgcn_mfma_f32_16x16x16bf16_1k(a, b, c, 0, 0, 0)
__device__ __forceinline__ s16x4 ds_tr(LAS const unsigned char* p) { return __builtin_bit_cast(s16x4, __builtin_amdgcn_ds_read_tr16_b64_v4i16((LAS v4i16*)p)); }
__device__ __forceinline__ bf16x8 frag_rm(LAS const unsigned char* X, int row0, int k0, int i16, int g) { return *(const LAS bf16x8*)(X + (row0 + i16) * RW_PITCH + (k0 + 8 * g) * 2); }
__device__ __forceinline__ bf16x8 frag_tr(LAS const unsigned char* X, int k0, int col0, int i16, int g) {
    LAS const unsigned char* p = X + (k0 + 8 * g + (i16 >> 2)) * RW_PITCH + (col0 + 4 * (i16 & 3)) * 2;
    const s16x4 a = ds_tr(p), b = ds_tr(p + 4 * RW_PITCH);
    return (bf16x8){a[0], a[1], a[2], a[3], b[0], b[1], b[2], b[3]};
}
__device__ __forceinline__ f32x4 bf4_to_f32(s16x4 v) { return (f32x4){bf2f((unsigned short)v[0]), bf2f((unsigned short)v[1]), bf2f((unsigned short)v[2]), bf2f((unsigned short)v[3])}; }
__device__ __forceinline__ v2u f32_to_bf4(f32x4 v) { return (v2u){cvtpk(v.x, v.y), cvtpk(v.z, v.w)}; }

struct RwRaw { v4u rc, kc, vc, rp, kp, vp, a, lw; };
__device__ __forceinline__ void rwkv_load_raw(RwRaw& R, int u, int wave, int lane, const bf16* P, const bf16* Aarr, const bf16* LW) {
    const int bh = u >> 7, c = u & 127, b = bh >> 3, h = bh & 7; const int t = 8 * wave + (lane >> 3), ch = h * 64 + 8 * (lane & 7);
    const size_t m = (size_t)b * T + 64 * c + t; const bf16* pc = P + m * NP;
    R.rc = *(const v4u*)(pc + C_R + ch); R.kc = *(const v4u*)(pc + C_K + ch); R.vc = *(const v4u*)(pc + C_V + ch); R.a = *(const v4u*)(Aarr + m * 512 + ch); R.lw = *(const v4u*)(LW + m * 512 + ch);
    if (64 * c + t > 0) { const bf16* pp = pc - NP; R.rp = *(const v4u*)(pp + C_R + ch); R.kp = *(const v4u*)(pp + C_K + ch); R.vp = *(const v4u*)(pp + C_V + ch); }
    else { R.rp = (v4u){0u, 0u, 0u, 0u}; R.kp = R.rp; R.vp = R.rp; }
}
__device__ __forceinline__ void rwkv_chunk_unit(int u, const RwRaw& R, int u_next, RwRaw& Rn, LAS unsigned char* lds, int wave, int lane, const bf16* P, const bf16* Aarr, const bf16* LW, const float* mu, const float* k_k, const float* k_a,
                                                const float* r_k, float* BONUS, unsigned char* CHK_PR, unsigned char* CHK_QY) {
    const int bh = u >> 7, c = u & 127, b = bh >> 3, h = bh & 7;
    const size_t m0 = (size_t)b * T + 64 * c;
    asm volatile("" : "+v"(lane));
    const int i16 = lane & 15, g = lane >> 4;
    {
#define BFE(v, e) (((e) & 1) ? bfhi((v)[(e) >> 1]) : bflo((v)[(e) >> 1]))
        const int tl = lane >> 3, co = lane & 7, t = 8 * wave + tl, ch = h * 64 + 8 * co;
        LAS float* scan = (LAS float*)(lds + RW_ABK) + wave * 512;
        LAS float* psum = (LAS float*)(lds + RW_WC + 256);
        float inc[8];
#pragma unroll
        for (int e = 0; e < 8; ++e) inc[e] = BFE(R.lw, e);
        *(LAS f32x4*)(scan + tl * 64 + 8 * co) = (f32x4){inc[0], inc[1], inc[2], inc[3]}; *(LAS f32x4*)(scan + tl * 64 + 8 * co + 4) = (f32x4){inc[4], inc[5], inc[6], inc[7]};
#pragma unroll
        for (int tp = 0; tp < 7; ++tp) { const f32x4 x0 = *(const LAS f32x4*)(scan + tp * 64 + 8 * co), x1 = *(const LAS f32x4*)(scan + tp * 64 + 8 * co + 4);
            if (tp < tl) { inc[0] += x0.x; inc[1] += x0.y; inc[2] += x0.z; inc[3] += x0.w; inc[4] += x1.x; inc[5] += x1.y; inc[6] += x1.z; inc[7] += x1.w; } }
        if (tl == 7) { *(LAS f32x4*)(psum + wave * 64 + 8 * co) = (f32x4){inc[0], inc[1], inc[2], inc[3]}; *(LAS f32x4*)(psum + wave * 64 + 8 * co + 4) = (f32x4){inc[4], inc[5], inc[6], inc[7]}; }
        __syncthreads();
        if (u_next >= 0) rwkv_load_raw(Rn, u_next, wave, lane, P, Aarr, LW);
        float tot[8];
#pragma unroll
        for (int e = 0; e < 8; ++e) tot[e] = 0.f;
#pragma unroll
        for (int w2 = 0; w2 < 8; ++w2) { const f32x4 x0 = *(const LAS f32x4*)(psum + w2 * 64 + 8 * co), x1 = *(const LAS f32x4*)(psum + w2 * 64 + 8 * co + 4);
            const float xs[8] = {x0.x, x0.y, x0.z, x0.w, x1.x, x1.y, x1.z, x1.w};
#pragma unroll
            for (int e = 0; e < 8; ++e) { tot[e] += xs[e]; if (w2 < wave) inc[e] += xs[e]; } }
        float kk[8], ka[8], rr[8]; float ss = 0.f, bon = 0.f; v4u vpk;
#pragma unroll
        for (int q = 0; q < 2; ++q) {
            const f32x4 mr = *(const f32x4*)(mu + C_R + ch + 4 * q), mk = *(const f32x4*)(mu + C_K + ch + 4 * q), mv = *(const f32x4*)(mu + C_V + ch + 4 * q);
            const f32x4 kkc = *(const f32x4*)(k_k + ch + 4 * q), kac = *(const f32x4*)(k_a + ch + 4 * q), rkc = *(const f32x4*)(r_k + ch + 4 * q);
            float vv[4];
#pragma unroll
            for (int j = 0; j < 4; ++j) { const int e = 4 * q + j;
                const float rc = BFE(R.rc, e), kc = BFE(R.kc, e), vc = BFE(R.vc, e);
                rr[e] = rc + mr[j] * (BFE(R.rp, e) - rc); const float k = kc + mk[j] * (BFE(R.kp, e) - kc); vv[j] = vc + mv[j] * (BFE(R.vp, e) - vc);
                kk[e] = k * kkc[j]; ss += kk[e] * kk[e]; ka[e] = k * (1.f + (BFE(R.a, e) - 1.f) * kac[j]); bon += rr[e] * ka[e] * rkc[j]; }
            vpk[2 * q] = pk2(vv[0], vv[1]); vpk[2 * q + 1] = pk2(vv[2], vv[3]);
        }
        ss = sum8(ss); bon = sum8(bon);
        const float inv = 1.f / fmaxf(sqrtf(ss), 1e-12f);
        if (co == 0) BONUS[(m0 + t) * 8 + h] = bon;
        v4u p_kkt, p_kd, p_bd, p_rt, p_kh, p_bh;
#pragma unroll
        for (int i = 0; i < 4; ++i) {
            float okkt[2], okd[2], obd[2], ort[2], okh[2], obh[2];
#pragma unroll
            for (int j = 0; j < 2; ++j) { const int e = 2 * i + j; const float kn = kk[e] * inv, bbv = kn * BFE(R.a, e);
                const float cl = inc[e]; const float Wp = __expf(cl - BFE(R.lw, e)), Wt = __expf(cl), iW = __expf(-cl), hW = __expf(tot[e] - cl);
                okkt[j] = kn * Wp; okd[j] = ka[e] * iW; obd[j] = bbv * iW; ort[j] = rr[e] * Wt; okh[j] = ka[e] * hW; obh[j] = bbv * hW; }
            p_kkt[i] = pk2(okkt[0], okkt[1]); p_kd[i] = pk2(okd[0], okd[1]); p_bd[i] = pk2(obd[0], obd[1]); p_rt[i] = pk2(ort[0], ort[1]); p_kh[i] = pk2(okh[0], okh[1]); p_bh[i] = pk2(obh[0], obh[1]);
        }
        LAS unsigned char* row = lds + t * RW_PITCH + co * 16;
        *(LAS v4u*)(row + RW_KKT) = p_kkt; *(LAS v4u*)(row + RW_KD) = p_kd; *(LAS v4u*)(row + RW_BD) = p_bd; *(LAS v4u*)(row + RW_RT) = p_rt;
        *(LAS v4u*)(row + RW_KH) = p_kh; *(LAS v4u*)(row + RW_BH) = p_bh; *(LAS v4u*)(row + RW_V) = vpk;
        if (wave == 0 && tl == 0) { LAS float* wc = (LAS float*)(lds + RW_WC) + 8 * co;
#pragma unroll
            for (int e = 0; e < 8; ++e) wc[e] = __expf(tot[e]); }
#undef BFE
    }
    __syncthreads();
    {
        const int mb = wave & 3; const bool top = wave < 4;
        LAS const unsigned char* Am = lds + (top ? RW_KKT : RW_RT);
        const bf16x8 a0 = frag_rm(Am, 16 * mb, 0, i16, g), a1 = frag_rm(Am, 16 * mb, 32, i16, g);
#pragma unroll
        for (int nb = 0; nb < 8; ++nb) {
            const int jb = nb & 3; LAS const unsigned char* Bm = lds + (nb < 4 ? RW_BD : RW_KD);
            f32x4 d = {0.f, 0.f, 0.f, 0.f};
            if (jb <= mb) { d = MFMA16(a0, frag_rm(Bm, 16 * jb, 0, i16, g), d); d = MFMA16(a1, frag_rm(Bm, 16 * jb, 32, i16, g), d); }
            const int j = 16 * jb + i16, s0 = 16 * mb + 4 * g;
#pragma unroll
            for (int r = 0; r < 4; ++r) { const bool keep = top ? (j < s0 + r) : (j <= s0 + r); if (!keep) d[r] = 0.f; }
            LAS unsigned char* dst = lds + (top ? (nb < 4 ? RW_ABK : RW_AVK) : (nb < 4 ? RW_ARB : RW_ARK));
            *(LAS v2u*)(dst + j * RW_PITCH + s0 * 2) = f32_to_bf4(d);
        }
    }
    __syncthreads();
    if (wave == 0) {
        const int blk = g, cc = i16;
        float Tv[16];
#pragma unroll
        for (int s = 0; s < 16; ++s) Tv[s] = (s == cc) ? 1.f : 0.f;
#pragma unroll
        for (int j = 0; j < 15; ++j) {
            LAS const unsigned char* rowp = lds + RW_ABK + (16 * blk + j) * RW_PITCH + (16 * blk) * 2;
            float L[16]; { float t8[8]; unpack8(*(const LAS v4u*)rowp, t8);
#pragma unroll
                for (int e = 0; e < 8; ++e) L[e] = t8[e];
                unpack8(*(const LAS v4u*)(rowp + 16), t8);
#pragma unroll
                for (int e = 0; e < 8; ++e) L[8 + e] = t8[e]; }
            const float Tj = Tv[j];
#pragma unroll
            for (int s = j + 1; s < 16; ++s) Tv[s] -= L[s] * Tj;
        }
#pragma unroll
        for (int s = 0; s < 16; ++s) *(LAS unsigned short*)(lds + RW_TII + blk * 512 + s * 32 + cc * 2) = (unsigned short)f2bf(Tv[s]);
    } else if (wave <= 4) {
        const int mb = wave - 1;
        const bf16x8 a0 = frag_tr(lds + RW_AVK, 0, 16 * mb, i16, g), a1 = frag_tr(lds + RW_AVK, 32, 16 * mb, i16, g);
#pragma unroll
        for (int vt = 0; vt < 4; ++vt) {
            f32x4 d = {0.f, 0.f, 0.f, 0.f};
            d = MFMA16(a0, frag_tr(lds + RW_V, 0, 16 * vt, i16, g), d); d = MFMA16(a1, frag_tr(lds + RW_V, 32, 16 * vt, i16, g), d);
            *(LAS v2u*)(lds + RW_U + (16 * vt + i16) * RW_PITCH + (16 * mb + 4 * g) * 2) = f32_to_bf4(d);
        }
    }
    __syncthreads();
    {
        const int c0 = 16 * (wave & 3); const bool top = wave < 4;
        s16x4 Xb[4];
#pragma unroll
        for (int i = 0; i < 4; ++i) {
            f32x4 rhs;
            if (top) rhs = bf4_to_f32(ds_tr(lds + RW_KKT + (16 * i + 4 * g + (i16 >> 2)) * RW_PITCH + (c0 + 4 * (i16 & 3)) * 2));
            else { const v2u w2 = *(const LAS v2u*)(lds + RW_U + (c0 + i16) * RW_PITCH + (16 * i + 4 * g) * 2); rhs = (f32x4){bflo(w2.x), bfhi(w2.x), bflo(w2.y), bfhi(w2.y)}; }
            f32x4 acc = {0.f, 0.f, 0.f, 0.f};
#pragma unroll
            for (int k = 0; k < 4; ++k) if (k < i) {
                const s16x4 al = ds_tr(lds + RW_ABK + (16 * k + 4 * g + (i16 >> 2)) * RW_PITCH + (16 * i + 4 * (i16 & 3)) * 2);
                acc = MFMA16K16(al, Xb[k], acc); }
            rhs -= acc;
            const s16x4 rb = __builtin_bit_cast(s16x4, f32_to_bf4(rhs));
            const s16x4 at = __builtin_bit_cast(s16x4, *(const LAS v2u*)(lds + RW_TII + i * 512 + i16 * 32 + 8 * g));
            f32x4 X = {0.f, 0.f, 0.f, 0.f}; X = MFMA16K16(at, rb, X);
            Xb[i] = __builtin_bit_cast(s16x4, f32_to_bf4(X));
            *(LAS v2u*)(lds + (top ? RW_M1 : RW_M2) + (c0 + i16) * RW_PITCH + (16 * i + 4 * g) * 2) = f32_to_bf4(-X);
        }
    }
    __syncthreads();
    {
        const int nt = wave & 3;
        unsigned char* gpr = CHK_PR + (size_t)u * 16384; unsigned char* gqy = CHK_QY + (size_t)u * 16384;
        if (wave < 4) {
            const bf16x8 bh0 = frag_tr(lds + RW_BH, 0, 16 * nt, i16, g), bh1 = frag_tr(lds + RW_BH, 32, 16 * nt, i16, g);
            f32x4 d[4];
#pragma unroll
            for (int kt = 0; kt < 4; ++kt) { d[kt] = (f32x4){0.f, 0.f, 0.f, 0.f};
                d[kt] = MFMA16(frag_rm(lds + RW_M1, 16 * kt, 0, i16, g), bh0, d[kt]); d[kt] = MFMA16(frag_rm(lds + RW_M1, 16 * kt, 32, i16, g), bh1, d[kt]);
                if (kt == nt) {
#pragma unroll
                    for (int r = 0; r < 4; ++r) if (4 * g + r == i16) d[kt][r] += ((const LAS float*)(lds + RW_WC))[16 * kt + 4 * g + r]; } }
#pragma unroll
            for (int ks = 0; ks < 2; ++ks) { const v2u lo = f32_to_bf4(d[2 * ks]), hi = f32_to_bf4(d[2 * ks + 1]); *(v4u*)(gpr + (nt * 2 + ks) * 1024 + lane * 16) = (v4u){lo.x, lo.y, hi.x, hi.y}; }
            const bf16x8 kh0 = frag_tr(lds + RW_KH, 0, 16 * nt, i16, g), kh1 = frag_tr(lds + RW_KH, 32, 16 * nt, i16, g);
#pragma unroll
            for (int vt = 0; vt < 4; ++vt) { f32x4 q = {0.f, 0.f, 0.f, 0.f};
                q = MFMA16(kh0, frag_tr(lds + RW_V, 0, 16 * vt, i16, g), q); q = MFMA16(kh1, frag_tr(lds + RW_V, 32, 16 * vt, i16, g), q);
                q = MFMA16(bh0, frag_rm(lds + RW_M2, 16 * vt, 0, i16, g), q); q = MFMA16(bh1, frag_rm(lds + RW_M2, 16 * vt, 32, i16, g), q);
                *(v2u*)(gqy + ((vt * 4 + nt) * 64 + lane) * 8) = f32_to_bf4(q); }
        } else {
            const bf16x8 ab0 = frag_tr(lds + RW_ARB, 0, 16 * nt, i16, g), ab1 = frag_tr(lds + RW_ARB, 32, 16 * nt, i16, g);
            f32x4 d[4];
#pragma unroll
            for (int kt = 0; kt < 4; ++kt) { const v2u w2 = *(const LAS v2u*)(lds + RW_RT + (16 * nt + i16) * RW_PITCH + (16 * kt + 4 * g) * 2);
                d[kt] = (f32x4){bflo(w2.x), bfhi(w2.x), bflo(w2.y), bfhi(w2.y)};
                d[kt] = MFMA16(frag_rm(lds + RW_M1, 16 * kt, 0, i16, g), ab0, d[kt]); d[kt] = MFMA16(frag_rm(lds + RW_M1, 16 * kt, 32, i16, g), ab1, d[kt]); }
#pragma unroll
            for (int ks = 0; ks < 2; ++ks) { const v2u lo = f32_to_bf4(d[2 * ks]), hi = f32_to_bf4(d[2 * ks + 1]); *(v4u*)(gpr + 8192 + (nt * 2 + ks) * 1024 + lane * 16) = (v4u){lo.x, lo.y, hi.x, hi.y}; }
            const bf16x8 ak0 = frag_tr(lds + RW_ARK, 0, 16 * nt, i16, g), ak1 = frag_tr(lds + RW_ARK, 32, 16 * nt, i16, g);
#pragma unroll
            for (int vt = 0; vt < 4; ++vt) { f32x4 q = {0.f, 0.f, 0.f, 0.f};
                q = MFMA16(ak0, frag_tr(lds + RW_V, 0, 16 * vt, i16, g), q); q = MFMA16(ak1, frag_tr(lds + RW_V, 32, 16 * vt, i16, g), q);
                q = MFMA16(ab0, frag_rm(lds + RW_M2, 16 * vt, 0, i16, g), q); q = MFMA16(ab1, frag_rm(lds + RW_M2, 16 * vt, 32, i16, g), q);
                *(v2u*)(gqy + 8192 + ((vt * 4 + nt) * 64 + lane) * 8) = f32_to_bf4(q); }
        }
    }
    __syncthreads();
}

__device__ __forceinline__ void rwkv_scan_unit(int unit, int lane, const unsigned char* CHK_PR, const unsigned char* CHK_QY, unsigned char* CHK_S) {
    const int bh = unit >> 2, vt = unit & 3;
    f32x4 S[4];
#pragma unroll
    for (int kt = 0; kt < 4; ++kt) S[kt] = (f32x4){0.f, 0.f, 0.f, 0.f};
    constexpr int PD = 4;
    v4u pf[PD][8]; v2u qf[PD][4];
#pragma unroll
    for (int d = 0; d < PD; ++d) { const size_t u = (size_t)bh * 128 + d;
#pragma unroll
        for (int f = 0; f < 8; ++f) pf[d][f] = *(const v4u*)(CHK_PR + u * 16384 + f * 1024 + lane * 16);
#pragma unroll
        for (int mt = 0; mt < 4; ++mt) qf[d][mt] = *(const v2u*)(CHK_QY + u * 16384 + ((vt * 4 + mt) * 64 + lane) * 8); }
#pragma unroll 1
    for (int c0 = 0; c0 < 128; c0 += PD) {
#pragma unroll
        for (int d = 0; d < PD; ++d) {
            const int c = c0 + d; const size_t u = (size_t)bh * 128 + c;
            const v2u s0 = f32_to_bf4(S[0]), s1 = f32_to_bf4(S[1]), s2 = f32_to_bf4(S[2]), s3 = f32_to_bf4(S[3]);
            const v4u b0 = {s0.x, s0.y, s1.x, s1.y}, b1 = {s2.x, s2.y, s3.x, s3.y};
            *(v4u*)(CHK_S + u * 8192 + ((vt * 2 + 0) * 64 + lane) * 16) = b0; *(v4u*)(CHK_S + u * 8192 + ((vt * 2 + 1) * 64 + lane) * 16) = b1;
#pragma unroll
            for (int mt = 0; mt < 4; ++mt) { f32x4 acc = {bflo(qf[d][mt].x), bfhi(qf[d][mt].x), bflo(qf[d][mt].y), bfhi(qf[d][mt].y)};
                acc = MFMA16(__builtin_bit_cast(bf16x8, pf[d][mt * 2 + 0]), __builtin_bit_cast(bf16x8, b0), acc);
                acc = MFMA16(__builtin_bit_cast(bf16x8, pf[d][mt * 2 + 1]), __builtin_bit_cast(bf16x8, b1), acc); S[mt] = acc; }
            if (c + PD < 128) { const size_t un = u + PD;
#pragma unroll
                for (int f = 0; f < 8; ++f) pf[d][f] = *(const v4u*)(CHK_PR + un * 16384 + f * 1024 + lane * 16);
#pragma unroll
                for (int mt = 0; mt < 4; ++mt) qf[d][mt] = *(const v2u*)(CHK_QY + un * 16384 + ((vt * 4 + mt) * 64 + lane) * 8); }
        }
    }
}

__device__ __forceinline__ void rwkv_out_unit(int u, LAS unsigned char* wl  , int lane, const bf16* P, const unsigned char* CHK_PR, const unsigned char* CHK_QY, const unsigned char* CHK_S,
                                              const float* BONUS, const float* mu, const float* ln_w, const float* ln_b, bf16* Y) {
    const int bh = u >> 7, c = u & 127, b = bh >> 3, h = bh & 7;
    const size_t m0 = (size_t)b * T + 64 * c;
    const int i16 = lane & 15, g = lane >> 4;
    const int ch = h * 64 + lane;
    unsigned short pva[33], pga[33];
    if (64 * c > 0) { const bf16* pp = P + (m0 - 1) * NP; pva[0] = pp[C_V + ch]; pga[0] = pp[C_G + ch]; } else { pva[0] = 0; pga[0] = 0; }
#pragma unroll
    for (int t = 0; t < 32; ++t) { const bf16* pc = P + (m0 + t) * NP; pva[t + 1] = pc[C_V + ch]; pga[t + 1] = pc[C_G + ch]; }
    const float bmine = BONUS[(m0 + lane) * 8 + h];
    bf16x8 sf[4][2];
#pragma unroll
    for (int vt = 0; vt < 4; ++vt)
#pragma unroll
        for (int ks = 0; ks < 2; ++ks) sf[vt][ks] = *(const bf16x8*)(CHK_S + (size_t)u * 8192 + ((vt * 2 + ks) * 64 + lane) * 16);
#pragma unroll
    for (int tt = 0; tt < 4; ++tt) {
        const bf16x8 r0 = *(const bf16x8*)(CHK_PR + (size_t)u * 16384 + 8192 + (tt * 2 + 0) * 1024 + lane * 16), r1 = *(const bf16x8*)(CHK_PR + (size_t)u * 16384 + 8192 + (tt * 2 + 1) * 1024 + lane * 16);
        f32x4 y[4];
#pragma unroll
        for (int vt = 0; vt < 4; ++vt) { const v2u w2 = *(const v2u*)(CHK_QY + (size_t)u * 16384 + 8192 + ((vt * 4 + tt) * 64 + lane) * 8);
            y[vt] = (f32x4){bflo(w2.x), bfhi(w2.x), bflo(w2.y), bfhi(w2.y)};
            y[vt] = MFMA16(r0, sf[vt][0], y[vt]); y[vt] = MFMA16(r1, sf[vt][1], y[vt]); }
#pragma unroll
        for (int r = 0; r < 4; ++r) {
            float s = (y[0][r] + y[1][r]) + (y[2][r] + y[3][r]);
            s += dppf<0xB1>(s); s += dppf<0x4E>(s); s += dppf<0x141>(s); s += dppf<0x140>(s);
            const float mean = s * (1.f / 64.f);
            float q = 0.f;
#pragma unroll
            for (int vt = 0; vt < 4; ++vt) { y[vt][r] -= mean; q += y[vt][r] * y[vt][r]; }
            q += dppf<0xB1>(q); q += dppf<0x4E>(q); q += dppf<0x141>(q); q += dppf<0x140>(q);
            const float rstd = 1.0f / sqrtf(q * (1.f / 64.f) + 64e-5f);
#pragma unroll
            for (int vt = 0; vt < 4; ++vt) *(LAS unsigned short*)(wl + (16 * tt + 4 * g + r) * 132 + (16 * vt + i16) * 2) = (unsigned short)f2bf(y[vt][r] * rstd);
        }
    }
    const float muv = mu[C_V + ch], mug = mu[C_G + ch], lw = ln_w[ch], lb = ln_b[ch];
    unsigned short pvb[32], pgb[32];
#pragma unroll
    for (int t = 0; t < 32; ++t) { const bf16* pc = P + (m0 + 32 + t) * NP; pvb[t] = pc[C_V + ch]; pgb[t] = pc[C_G + ch]; }
#pragma unroll
    for (int t = 0; t < 32; ++t) {
        const float pvc = bf2f(pva[t + 1]), pgc = bf2f(pga[t + 1]), pvp = bf2f(pva[t]), pgp = bf2f(pga[t]);
        const float v = pvc + muv * (pvp - pvc), gt = pgc + mug * (pgp - pgc);
        const float yn = bf2f(*(const LAS unsigned short*)(wl + t * 132 + lane * 2));
        const float o = (yn * lw + lb + rdlane(bmine, t) * v) * siluf(gt);
        Y[(m0 + t) * D + ch] = (bf16)f2bf(o);
    }
#pragma unroll
    for (int t = 0; t < 32; ++t) {
        const float pvc = bf2f(pvb[t]), pgc = bf2f(pgb[t]), pvp = bf2f(t ? pvb[t - 1] : pva[32]), pgp = bf2f(t ? pgb[t - 1] : pga[32]);
        const float v = pvc + muv * (pvp - pvc), gt = pgc + mug * (pgp - pgc);
        const float yn = bf2f(*(const LAS unsigned short*)(wl + (32 + t) * 132 + lane * 2));
        const float o = (yn * lw + lb + rdlane(bmine, 32 + t) * v) * siluf(gt);
        Y[(m0 + 32 + t) * D + ch] = (bf16)f2bf(o);
    }
}

#ifndef PHASES
#define PHASES 0x3ff
#endif
__global__ void __launch_bounds__(NWAVES * 64, 2) hymba_fwd(Args args) {
    extern __shared__ __attribute__((aligned(16))) unsigned char lds_raw[];
    LAS unsigned char* lds = (LAS unsigned char*)lds_raw;
    volatile LAS unsigned* MISC = (volatile LAS unsigned*)(lds + MISC_OFF);
    const int tid = threadIdx.x, lane = tid & 63, wave = __builtin_amdgcn_readfirstlane(tid >> 6);
    const int G = gridDim.x; const int bx = blockIdx.x; const int vcu = (G % 8 == 0) ? (bx % 8) * (G / 8) + bx / 8 : bx;
    const int gw = vcu * NWAVES + wave, NGW = G * NWAVES;
    unsigned char* ws = args.ws;
    unsigned* ctl = (unsigned*)(ws + WS_CTL);
    const float* x = args.in[0]; const float* mem = args.in[1]; const float* norm_in_g = args.in[2]; const float* w_in = args.in[3];
    const float* mu = args.in[4]; const float* w0 = args.in[5]; const float* w_up = args.in[6]; const float* a0 = args.in[7]; const float* a_up = args.in[8];
    const float* k_k = args.in[9]; const float* k_a = args.in[10]; const float* r_k = args.in[11]; const float* ln_w = args.in[12]; const float* ln_b = args.in[13];
    const float* cmp_pos = args.in[14]; const float* ck_w1 = args.in[15]; const float* ck_w2 = args.in[16]; const float* cv_w1 = args.in[17]; const float* cv_w2 = args.in[18];
    const float* gate_b = args.in[19]; const float* nsa_out_g = args.in[20]; const float* mem_norm_g = args.in[21]; const float* w_mem_kv = args.in[22];
    const float* mem_out_g = args.in[23]; const float* w_out = args.in[24]; const float* norm_final_g = args.in[25];
    float* out = args.out;
    bf16* WT_IN = (bf16*)(ws + WS_WIN); bf16* WT_OUT = (bf16*)(ws + WS_WOUT);
    float* ROPE = (float*)(ws + WS_ROPE); float* RS = (float*)(ws + WS_RS); bf16* KCMP = (bf16*)(ws + WS_KCMP); bf16* VCMP = (bf16*)(ws + WS_VCMP);
    bf16* MEMKV = (bf16*)(ws + WS_MEMKV); float* GLOG = (float*)(ws + WS_GLOG);
    bf16* P = (bf16*)(ws + WS_P); bf16* XB = (bf16*)(ws + WS_XB); bf16* Y = (bf16*)(ws + WS_Y);
    bf16* AA = (bf16*)(ws + WS_A); bf16* LWA = (bf16*)(ws + WS_LW); float* BONUS = (float*)(ws + WS_BONUS);
    bf16* W1TK = (bf16*)(ws + WS_W1TK); bf16* W1TV = (bf16*)(ws + WS_W1TV); bf16* W2TK = (bf16*)(ws + WS_W2TK); bf16* W2TV = (bf16*)(ws + WS_W2TV);
    bf16* WUPT = (bf16*)(ws + WS_WUPT); bf16* AUPT = (bf16*)(ws + WS_AUPT); bf16* WKVT = (bf16*)(ws + WS_WKVT); bf16* MEMN = (bf16*)(ws + WS_MEMN);
    unsigned char* CHK_PR = ws + WS_CHK_PR; unsigned char* CHK_QY = ws + WS_CHK_QY; unsigned char* CHK_S = ws + WS_CHK_S;

    for (int u = tid; u < (LDS_BYTES - LDSCTL_OFF) / 4; u += NWAVES * 64) ((LAS unsigned*)(lds + LDSCTL_OFF))[u] = 0u;
    __syncthreads();
    XcdBarrier bar = xcd_barrier_post(ctl + CW_BAR, MISC + 8);

#pragma unroll 1
    for (int rep = 0; rep < RPT(0); ++rep) { if (PHASES & 1) {
        LAS float* wgt = (LAS float*)(lds + 81920);
#pragma unroll
        for (int j = 0; j < (D * 12) / (NWAVES * 64); ++j) { const int i = tid + j * NWAVES * 64; const int k = i / 12, c = i % 12; wgt[c * D + k] = norm_in_g[k] * w_in[(size_t)k * W_IN_COLS + GLOG_SRC + c]; }
        __syncthreads();
        LAS float* scr = (LAS float*)(lds + wave * 8704);
        constexpr int I_IN = 16 * (NP / 32), I_OUT = 16 * (D / 32), I_W1 = 32 * 2, I_KV = 16 * 16, I_UP = 16, I_W2 = 2;
        constexpr int O_OUT = I_IN, O_W1K = O_OUT + I_OUT, O_W1V = O_W1K + I_W1, O_KV = O_W1V + I_W1, O_WUP = O_KV + I_KV, O_AUP = O_WUP + I_UP, O_W2K = O_AUP + I_UP, O_W2V = O_W2K + I_W2, I_ALL = O_W2V + I_W2;
        for (int it = gw; it < I_ALL; it += NGW) {
            if (it < O_OUT) { const int kb = it / (NP / 32), nb = it % (NP / 32); const int src = 32 * nb + (32 * nb >= GLOG_SRC ? 12 : 0);
                p0_transpose_item(w_in, W_IN_COLS, src, norm_in_g, WT_IN, D, 32 * nb, 64 * kb, scr, lane); }
            else if (it < O_W1K) { const int r = it - O_OUT; p0_transpose_item(w_out, D, 32 * (r % (D / 32)), nullptr, WT_OUT, D, 32 * (r % (D / 32)), 64 * (r / (D / 32)), scr, lane); }
            else if (it < O_W1V) { const int r = it - O_W1K; p0_transpose_item(ck_w1, 64, 32 * (r & 1), nullptr, W1TK, 2048, 32 * (r & 1), 64 * (r >> 1), scr, lane); }
            else if (it < O_KV) { const int r = it - O_W1V; p0_transpose_item(cv_w1, 64, 32 * (r & 1), nullptr, W1TV, 2048, 32 * (r & 1), 64 * (r >> 1), scr, lane); }
            else if (it < O_WUP) { const int r = it - O_KV; p0_transpose_item(w_mem_kv, 512, 32 * (r & 15), nullptr, WKVT, D, 32 * (r & 15), 64 * (r >> 4), scr, lane); }
            else if (it < O_AUP) { const int r = it - O_WUP; p0_transpose_item(w_up, 512, 32 * r, nullptr, WUPT, 64, 32 * r, 0, scr, lane); }
            else if (it < O_W2K) { const int r = it - O_AUP; p0_transpose_item(a_up, 512, 32 * r, nullptr, AUPT, 64, 32 * r, 0, scr, lane); }
            else if (it < O_W2V) { const int r = it - O_W2K; p0_transpose_item(ck_w2, 64, 32 * r, nullptr, W2TK, 64, 32 * r, 0, scr, lane); }
            else { const int r = it - O_W2V; p0_transpose_item(cv_w2, 64, 32 * r, nullptr, W2TV, 64, 32 * r, 0, scr, lane); }
        }
        for (int m = gw; m < NB * MEML; m += NGW) {
            const f32x4* xr = (const f32x4*)(mem + (size_t)m * D) + lane; f32x4 v[4]; float ss = 0.f;
#pragma unroll
            for (int j = 0; j < 4; ++j) { v[j] = xr[64 * j]; ss += (v[j].x * v[j].x + v[j].y * v[j].y) + (v[j].z * v[j].z + v[j].w * v[j].w); }
            ss = wave_sum(ss); const float rs = 1.0f / sqrtf(ss * (1.f / D) + 1e-6f);
            unsigned long long* o8 = (unsigned long long*)(MEMN + (size_t)m * D) + lane;
#pragma unroll
            for (int j = 0; j < 4; ++j) { const f32x4 gg = *((const f32x4*)mem_norm_g + 64 * j + lane); const f32x4 y = v[j] * rs * gg; o8[64 * j] = (unsigned long long)pk2(y.x, y.y) | ((unsigned long long)pk2(y.z, y.w) << 32); }
        }
        for (int i = gw * 64 + lane; i < T * 8; i += NGW * 64) { float c, s; rope_cs(i >> 3, i & 7, c, s); ROPE[(i >> 3) * 16 + (i & 7)] = c; ROPE[(i >> 3) * 16 + 8 + (i & 7)] = s; }
        {
        f32x4 vn[4];
        if (gw < M) { const f32x4* xr = (const f32x4*)(x + (size_t)gw * D) + lane;
#pragma unroll
            for (int j = 0; j < 4; ++j) vn[j] = xr[64 * j]; }
        for (int m = gw; m < M; m += NGW) {
            f32x4 v[4]; float ss = 0.f;
#pragma unroll
            for (int j = 0; j < 4; ++j) v[j] = vn[j];
            if (m + NGW < M) { const f32x4* xr = (const f32x4*)(x + (size_t)(m + NGW) * D) + lane;
#pragma unroll
                for (int j = 0; j < 4; ++j) vn[j] = xr[64 * j]; }
#pragma unroll
            for (int j = 0; j < 4; ++j) ss += (v[j].x * v[j].x + v[j].y * v[j].y) + (v[j].z * v[j].z + v[j].w * v[j].w);
            ss = wave_sum(ss);
            const float rs = 1.0f / sqrtf(ss * (1.f / D) + 1e-6f);
            unsigned long long* o8 = (unsigned long long*)(XB + (size_t)m * D) + lane;
#pragma unroll
            for (int j = 0; j < 4; ++j) o8[64 * j] = (unsigned long long)pk2(v[j].x, v[j].y) | ((unsigned long long)pk2(v[j].z, v[j].w) << 32);
            float mine = 0.f;
#pragma unroll 2
            for (int c = 0; c < 12; ++c) {
                float a = 0.f;
#pragma unroll
                for (int j = 0; j < 4; ++j) { const f32x4 w4 = *(const LAS f32x4*)(wgt + c * D + 256 * j + 4 * lane); a += (v[j].x * w4.x + v[j].y * w4.y) + (v[j].z * w4.z + v[j].w * w4.w); }
                a = wave_sum(a); if (lane == c) mine = a;
            }
            if (lane < 12) GLOG[(size_t)m * 12 + lane] = mine * rs;
            if (lane == 0) RS[m] = rs;
        }
        }
    }
    xcd_barrier(bar); }

    for (int rep = 0; rep < RPT(1); ++rep) { if (PHASES & 2) {
        pg8::Gemm g{XB, WT_IN, M, NP, D}; pg8::StaticOrder S; S.init(M, NP, G, bx);
        pg8::EpiRowScaleBf16 E{P, NP, RS};
        pg8::gemm_phase<pg8::EpiRowScaleBf16, pg8::StaticOrder, true, true>(lds, g, S, E);
    }
    xcd_barrier(bar); }

    for (int rep = 0; rep < RPT(2); ++rep) { if (PHASES & 4) {
        const int i16 = lane & 15, g = lane >> 4;
        constexpr int U_CMP = NB * 32 * 2, U_KV = 64 * 8, U_LORA = M / 16;
        for (int pass = 0; pass < 2; ++pass)
        for (int idx = (pass == 0 ? (wave == 0 ? vcu : (wave <= 2 ? U_CMP + vcu * 2 + (wave - 1) : U_CMP + U_KV)) : U_CMP + U_KV + gw);
             idx < (pass == 0 ? (wave == 0 ? U_CMP : (wave <= 2 ? U_CMP + U_KV : 0)) : U_CMP + U_KV + U_LORA); idx += (pass == 0 ? (wave == 0 ? G : 2 * G) : NGW)) {
            if (idx < U_CMP) {
                const int kv = idx & 1, ct = (idx >> 1) & 31, b = idx >> 6;
                const bf16* W1T = kv ? W1TV : W1TK; const bf16* W2T = kv ? W2TV : W2TK; const int col = kv ? C_VC : C_KC; bf16* dst = kv ? VCMP : KCMP;
                const int c = 16 * ct + i16, cl = min(c, NCMP - 1);
                const bf16* wbase = P + (size_t)(b * T + 16 * cl) * NP + col + 8 * g;
                f32x4 acc[4];
#pragma unroll
                for (int mt = 0; mt < 4; ++mt) acc[mt] = (f32x4){0.f, 0.f, 0.f, 0.f};
#pragma unroll 8
                for (int ks = 0; ks < 64; ++ks) {
                    const int l = ks >> 1, db = 32 * (ks & 1);
                    float wf[8]; unpack8(*(const v4u*)(wbase + (size_t)l * NP + db), wf);
                    const f32x4 p0 = *(const f32x4*)(cmp_pos + l * 64 + db + 8 * g), p1 = *(const f32x4*)(cmp_pos + l * 64 + db + 8 * g + 4);
                    wf[0] += p0.x; wf[1] += p0.y; wf[2] += p0.z; wf[3] += p0.w; wf[4] += p1.x; wf[5] += p1.y; wf[6] += p1.z; wf[7] += p1.w;
                    const bf16x8 bfr = __builtin_bit_cast(bf16x8, pack8(wf));
#pragma unroll
                    for (int mt = 0; mt < 4; ++mt) acc[mt] = MFMA16(*(const bf16x8*)(W1T + (size_t)(16 * mt + i16) * 2048 + 32 * ks + 8 * g), bfr, acc[mt]);
                }
                v2u hb[4];
#pragma unroll
                for (int mt = 0; mt < 4; ++mt) hb[mt] = f32_to_bf4((f32x4){siluf(acc[mt].x), siluf(acc[mt].y), siluf(acc[mt].z), siluf(acc[mt].w)});
                const bf16x8 b0 = __builtin_bit_cast(bf16x8, (v4u){hb[0].x, hb[0].y, hb[1].x, hb[1].y}), b1 = __builtin_bit_cast(bf16x8, (v4u){hb[2].x, hb[2].y, hb[3].x, hb[3].y});
#pragma unroll
                for (int mt = 0; mt < 4; ++mt) {
                    const bf16* wr = W2T + (16 * mt + i16) * 64 + 4 * g;
                    const v2u a00 = *(const v2u*)wr, a01 = *(const v2u*)(wr + 16), a10 = *(const v2u*)(wr + 32), a11 = *(const v2u*)(wr + 48);
                    f32x4 o = {0.f, 0.f, 0.f, 0.f};
                    o = MFMA16(__builtin_bit_cast(bf16x8, (v4u){a00.x, a00.y, a01.x, a01.y}), b0, o); o = MFMA16(__builtin_bit_cast(bf16x8, (v4u){a10.x, a10.y, a11.x, a11.y}), b1, o);
                    if (c >= NCMP) o = (f32x4){0.f, 0.f, 0.f, 0.f};
                    *(v2u*)(dst + (size_t)(b * 512 + c) * 64 + 16 * mt + 4 * g) = f32_to_bf4(o);
                }
            } else if (idx < U_CMP + U_KV) {
                const int r2 = idx - U_CMP, rt = r2 >> 3, cg = r2 & 7;
                const bf16* arow = WKVT + (size_t)(64 * cg + i16) * D + 8 * g; const bf16* brow = MEMN + (size_t)(16 * rt + i16) * D + 8 * g;
                f32x4 acc[4];
#pragma unroll
                for (int mt = 0; mt < 4; ++mt) acc[mt] = (f32x4){0.f, 0.f, 0.f, 0.f};
#pragma unroll 8
                for (int ks = 0; ks < 32; ++ks) { const bf16x8 bfr = *(const bf16x8*)(brow + 32 * ks);
#pragma unroll
                    for (int mt = 0; mt < 4; ++mt) acc[mt] = MFMA16(*(const bf16x8*)(arow + (size_t)(16 * mt) * D + 32 * ks), bfr, acc[mt]); }
#pragma unroll
                for (int mt = 0; mt < 4; ++mt) *(v2u*)(MEMKV + (size_t)(16 * rt + i16) * 512 + 64 * cg + 16 * mt + 4 * g) = f32_to_bf4(acc[mt]);
            } else {
                const int u = idx - U_CMP - U_KV; const size_t m = (size_t)u * 16 + i16; const int t = (int)(m & (T - 1)); const bool hp = t > 0;
                const bf16* pr = P + m * NP; const bf16* pp = pr - NP;
                bf16x8 bw[2], ba[2];
#pragma unroll
                for (int ks = 0; ks < 2; ++ks) {
                    const int j0 = 32 * ks + 8 * g; float cw[8], pw[8], ca[8], pa[8];
                    unpack8(*(const v4u*)(pr + C_WD + j0), cw); unpack8(*(const v4u*)(pr + C_AD + j0), ca);
                    if (hp) { unpack8(*(const v4u*)(pp + C_WD + j0), pw); unpack8(*(const v4u*)(pp + C_AD + j0), pa); }
                    else {
#pragma unroll
                        for (int e = 0; e < 8; ++e) { pw[e] = 0.f; pa[e] = 0.f; } }
#pragma unroll
                    for (int e = 0; e < 8; ++e) { cw[e] = tanhf(cw[e] + mu[C_WD + j0 + e] * (pw[e] - cw[e])); ca[e] = ca[e] + mu[C_AD + j0 + e] * (pa[e] - ca[e]); }
                    bw[ks] = __builtin_bit_cast(bf16x8, pack8(cw)); ba[ks] = __builtin_bit_cast(bf16x8, pack8(ca));
                }
#pragma unroll 8
                for (int mt = 0; mt < 32; ++mt) {
                    const bf16* wu = WUPT + (16 * mt + i16) * 64 + 8 * g; const bf16* au = AUPT + (16 * mt + i16) * 64 + 8 * g;
                    f32x4 dw = {0.f, 0.f, 0.f, 0.f}, da = {0.f, 0.f, 0.f, 0.f};
                    dw = MFMA16(*(const bf16x8*)wu, bw[0], dw); dw = MFMA16(*(const bf16x8*)(wu + 32), bw[1], dw);
                    da = MFMA16(*(const bf16x8*)au, ba[0], da); da = MFMA16(*(const bf16x8*)(au + 32), ba[1], da);
                    const int c = 16 * mt + 4 * g; const f32x4 w0v = *(const f32x4*)(w0 + c), a0v = *(const f32x4*)(a0 + c);
                    f32x4 lo, ao;
#pragma unroll
                    for (int r = 0; r < 4; ++r) { const float nx = -(w0v[r] + dw[r]); const float sp = fmaxf(nx, 0.f) + __logf(1.f + __expf(-fabsf(nx))); lo[r] = -__expf(-sp - 0.5f); ao[r] = sigmf(a0v[r] + da[r]); }
                    *(v2u*)(LWA + m * 512 + c) = f32_to_bf4(lo); *(v2u*)(AA + m * 512 + c) = f32_to_bf4(ao);
                }
                { bf16* q = P + m * NP + ((g & 1) ? C_KW : C_KS) + 4 * (g >> 1);
                  const v2u x1 = *(const v2u*)q, x2 = *(const v2u*)(q + 8); const f32x4 cs = *(const f32x4*)(ROPE + t * 16 + 4 * (g >> 1)), sn = *(const f32x4*)(ROPE + t * 16 + 8 + 4 * (g >> 1));
                  const f32x4 a1 = {bflo(x1.x), bfhi(x1.x), bflo(x1.y), bfhi(x1.y)}, a2 = {bflo(x2.x), bfhi(x2.x), bflo(x2.y), bfhi(x2.y)};
                  if (rep == 0) { *(v2u*)q = f32_to_bf4(a1 * cs - a2 * sn); *(v2u*)(q + 8) = f32_to_bf4(a2 * cs + a1 * sn); } }
            }
        }
    }
    xcd_barrier(bar); }

    for (int rep = 0; rep < RPT(3); ++rep) { if (PHASES & 8) {
        RwRaw Rc, Rn; Rn = RwRaw{};
        if (vcu < NB * 8 * 128) rwkv_load_raw(Rc, vcu, wave, lane, P, AA, LWA);
        for (int u = vcu; u < NB * 8 * 128; u += G) { const int un = (u + G < NB * 8 * 128) ? u + G : -1;
            rwkv_chunk_unit(u, Rc, un, Rn, lds, wave, lane, P, AA, LWA, mu, k_k, k_a, r_k, BONUS, CHK_PR, CHK_QY); Rc = Rn; }
    }
    xcd_barrier(bar); }
    for (int rep = 0; rep < RPT(4); ++rep) if ((PHASES & 128) && wave == 0) {
        for (int unit = bx; unit < NB * 8 * 4; unit += G) rwkv_scan_unit(unit, lane, CHK_PR, CHK_QY, CHK_S);
    }
    for (int rep = 0; rep < RPT(6); ++rep) if (PHASES & 512) {
        const int mu0 = (G == 256) ? (bx >= 128 ? 2 * (bx - 128) : 256) : bx, mu1 = (G == 256) ? (bx >= 128 ? mu0 + 2 : 256) : 256, mus = (G == 256) ? 1 : G;
        for (int u = mu0; u < mu1; u += mus) {
            const int b = u >> 6; const size_t m0 = (size_t)b * T + 128 * (u & 63);
            Grp GM[1]; const LaneGeo L = make_geo(lane);
            SrcMem src{MEMKV, b}; BodyMem body{GM, L, P, Y, mem_out_g, m0 + 16 * wave + L.i16};
            at_ring<true, 6>(lds, 16, tid, wave, src, body);
        }
    }
    for (int rep = 0; rep < RPT(5); ++rep) if (PHASES & 256) {
        for (int pr = vcu; pr < 256; pr += G)
#pragma unroll 1
            for (int half = 0; half < 2; ++half)
                nsa_unit(pr >> 6, half ? 127 - (pr & 63) : (pr & 63), lds, tid, wave, lane, P, KCMP, VCMP, GLOG, gate_b, nsa_out_g, ROPE, Y, (float*)(ws + WS_OTP) + (size_t)(bx * NWAVES + wave) * 2048);
    }
    xcd_barrier(bar);

    for (int rep = 0; rep < RPT(7); ++rep) { if (PHASES & 16) {
        for (int u = gw; u < NB * 8 * 128; u += NGW) rwkv_out_unit(u, lds + wave * 8448, lane, P, CHK_PR, CHK_QY, CHK_S, BONUS, mu, ln_w, ln_b, Y);
    }
    xcd_barrier(bar); }

#pragma unroll 1
    for (int rep = 0; rep < RPT(13); ++rep) { if (PHASES & 32) {
        pg8::Gemm g{Y, WT_OUT, M, D, D}; pg8::StaticOrder S; S.init(M, D, G, bx);
        pg8::EpiResF32 E{x, out, D};
        pg8::gemm_phase<pg8::EpiResF32, pg8::StaticOrder, true, true>(lds, g, S, E);
    }
    xcd_barrier(bar); }

    if (PHASES & 64) for (int m = gw; m < M; m += NGW) {
        f32x4* xr = (f32x4*)(out + (size_t)m * D) + lane;
        f32x4 v[4]; float ss = 0.f;
#pragma unroll
        for (int j = 0; j < 4; ++j) { v[j] = xr[64 * j]; ss += (v[j].x * v[j].x + v[j].y * v[j].y) + (v[j].z * v[j].z + v[j].w * v[j].w); }
        ss = wave_sum(ss);
        const float rs = 1.0f / sqrtf(ss * (1.f / D) + 1e-6f);
#pragma unroll
        for (int j = 0; j < 4; ++j) { const f32x4 g = *((const f32x4*)norm_final_g + 64 * j + lane); xr[64 * j] = v[j] * rs * g; }
    }
}

extern "C" void kernel_launch(void* const* d_in, const int* in_sizes, int n_in, void* d_out, int out_size, void* d_ws, size_t ws_size, hipStream_t stream) {
    static int grid = 0;
    if (grid == 0) {
        if (n_in != 26 || in_sizes[0] != M * D || out_size != M * D || ws_size < WS_END) { fprintf(stderr, "kernel_launch: unexpected shapes (n_in %d, in0 %d, out %d, ws %zu); nothing launched\n", n_in, n_in > 0 ? in_sizes[0] : -1, out_size, ws_size); grid = -1; return; }
        int dev = 0, cus = 0;
        if (hipGetDevice(&dev) != hipSuccess || hipDeviceGetAttribute(&cus, hipDeviceAttributeMultiprocessorCount, dev) != hipSuccess) { grid = -1; return; }
        if (hipFuncSetAttribute((const void*)hymba_fwd, hipFuncAttributeMaxDynamicSharedMemorySize, LDS_BYTES) != hipSuccess) { fprintf(stderr, "kernel_launch: hipFuncSetAttribute failed\n"); grid = -1; return; }
        (void)hipGetLastError();
        grid = cus;
    }
    if (grid < 0) return;
    (void)hipMemsetAsync((char*)d_ws + WS_CTL, 0, CTL_ZERO_BYTES, stream);
    Args a{};
    for (int i = 0; i < 26; ++i) a.in[i] = (const float*)d_in[i];
    a.out = (float*)d_out; a.ws = (unsigned char*)d_ws;
    hipLaunchKernelGGL(hymba_fwd, dim3(grid), dim3(NWAVES * 64), LDS_BYTES, stream, a);
}
```

```cpp
#define REPEAT 0
#include <hip/hip_runtime.h>
#include <cstdio>
#include <cstdint>
namespace pg8 {
#define PG8_LAS __attribute__((address_space(3)))
typedef unsigned short bf16_t;
typedef short bf16x8 __attribute__((ext_vector_type(8)));
typedef float f32x4 __attribute__((ext_vector_type(4)));
typedef unsigned u32x4 __attribute__((ext_vector_type(4)));
constexpr int BM = 256, BK = 64, HALF = 128, HTB = HALF * BK * 2  , STAGE_BYTES = 8 * HTB, NXCD = 8, WGM = 8;

__host__ __device__ __forceinline__ int lds_byte(int r, int c) { const int st = (r >> 4) * 2 + (c >> 5), rr = r & 15, cc = c & 31, ob = rr * 64 + cc * 2; return st * 1024 + (ob ^ (((ob >> 9) & 1) << 5)); }
__host__ __device__ __forceinline__ void stage_rc(int b, int& R, int& C) { const int st = b / 1024, sb = b % 1024, swz = sb ^ (((sb >> 9) & 1) << 5); R = (st >> 1) * 16 + swz / 64; C = (st & 1) * 32 + (swz % 64) / 2; }
__host__ __device__ __forceinline__ int perm32(int rho) { const int n = rho >> 4, i = rho & 15; return 8 * (i >> 2) + 4 * n + (i & 3); }

struct Unit { int pm, pn; };
struct Gemm { const bf16_t* A; const bf16_t* Bt; int M, N, K; };

struct StaticOrder {
    int nM, nN, nwg, G, c;
    __host__ __device__ void init(int M, int N, int G_, int c_) { nM = M / BM; nN = N / BM; nwg = nM * nN; G = G_; c = c_; }
    __host__ __device__ bool next(int i, Unit& u) const {
        const long L = (long)i * G + c; if (L >= nwg) return false;
        int wgid = (int)L; { const int q = nwg / NXCD, r = nwg % NXCD, xcd = wgid % NXCD, off = wgid / NXCD; wgid = (xcd < r ? xcd * (q + 1) : r * (q + 1) + (xcd - r) * q) + off; }
        const int nig = WGM * nN, gid = wgid / nig, fm = gid * WGM, gsz = (nM - fm) < WGM ? (nM - fm) : WGM;
        u.pm = fm + ((wgid % nig) % gsz); u.pn = (wgid % nig) / gsz; return true;
    }
    __device__ __forceinline__ void a_ready(const Unit&) const {}
    __device__ __forceinline__ void done(const Unit&) const {}
};

__device__ __forceinline__ unsigned cvt_pk_bf16(float lo, float hi) { unsigned r; asm volatile("v_cvt_pk_bf16_f32 %0, %1, %2" : "=v"(r) : "v"(lo), "v"(hi)); return r; }

template <class Epi, class Sched, bool ALIGN_EPI = false, bool SP2 = false>
__device__ __forceinline__ void gemm_phase(PG8_LAS unsigned char* lds, const Gemm g, const Sched& S, const Epi& E) {
    int tid_o = threadIdx.x; asm volatile("" : "+v"(tid_o));
    const int tid = tid_o, wid = __builtin_amdgcn_readfirstlane(tid >> 6), lane = tid & 63, wr = wid >> 2, wc = wid & 3, fr = lane & 15, fq = lane >> 4;
    const int K = g.K, nt = K / BK;
    unsigned voffA[2], voffB[2];
#pragma unroll
    for (int i = 0; i < 2; ++i) { int R, C; stage_rc(tid * 16 + i * 8192, R, C); const int Rb = Epi::PERM ? ((R & ~31) + perm32(R & 31)) : R;
        voffA[i] = (unsigned)(R * K + C) * 2u; voffB[i] = (unsigned)(Rb * K + C) * 2u; }
    const size_t kstep = (size_t)(BK * 2);
    const size_t hstep = (size_t)HALF * K * 2;
    const size_t tstep = 2 * hstep;
    const unsigned ldsw = (unsigned)wid * 1024u;
    const int aoff = lds_byte(wr * 64 + fr, fq * 8), boff = lds_byte(wc * 32 + fr, fq * 8);
#define PG8_SA(b, h) (((b) * 2 + (h)) * HTB)
#define PG8_SB(b, h) ((4 + (b) * 2 + (h)) * HTB)
#define PG8_STAGE(bufoff, gbase, voff) do { _Pragma("unroll") for (int _i = 0; _i < 2; ++_i) \
        __builtin_amdgcn_global_load_lds((const unsigned*)((const char*)(gbase) + (voff)[_i]), (PG8_LAS unsigned*)(lds + (bufoff) + ldsw + _i * 8192), 16, 0, 0); } while (0)
#define PG8_LDA(dst, b, h) do { _Pragma("unroll") for (int m = 0; m < 4; ++m) _Pragma("unroll") for (int k = 0; k < 2; ++k) dst[m][k] = *(const PG8_LAS bf16x8*)(lds + PG8_SA(b, h) + aoff + m * 2048 + k * 1024); } while (0)
#define PG8_LDB(dst, b, h) do { _Pragma("unroll") for (int n = 0; n < 2; ++n) _Pragma("unroll") for (int k = 0; k < 2; ++k) dst[n][k] = *(const PG8_LAS bf16x8*)(lds + PG8_SB(b, h) + boff + n * 2048 + k * 1024); } while (0)
#define PG8_MMA(ai, bj, At, Bt) do { __builtin_amdgcn_s_setprio(1); _Pragma("unroll") for (int m = 0; m < 4; ++m) _Pragma("unroll") for (int n = 0; n < 2; ++n) _Pragma("unroll") for (int k = 0; k < 2; ++k) \
        acc[ai][bj][m][n] = __builtin_amdgcn_mfma_f32_16x16x32_bf16(Bt[n][k], At[m][k], acc[ai][bj][m][n], 0, 0, 0); __builtin_amdgcn_s_setprio(0); } while (0)
#define PG8_WAIT_V(n) asm volatile("s_waitcnt vmcnt(" #n ")" ::: "memory")
#define PG8_WAIT_L(n) asm volatile("s_waitcnt lgkmcnt(" #n ")" ::: "memory")
#define PG8_BAR __builtin_amdgcn_s_barrier()
#define PG8_SCHED __builtin_amdgcn_sched_barrier(0)
    Unit cur, nxt; int ui = 0;
    if (!S.next(0, cur)) return;
    f32x4 acc[2][2][4][2];
#pragma unroll
    for (int a = 0; a < 2; ++a)
#pragma unroll
        for (int b = 0; b < 2; ++b)
#pragma unroll
            for (int m = 0; m < 4; ++m)
#pragma unroll
                for (int n = 0; n < 2; ++n) acc[a][b][m][n] = (f32x4){0.f, 0.f, 0.f, 0.f};
    bf16x8 At[4][2], B0[2][2], B1[2][2];
    const char* cA = (const char*)g.A + (size_t)cur.pm * tstep; const char* cB = (const char*)g.Bt + (size_t)cur.pn * tstep;
    S.a_ready(cur);
    if constexpr (SP2) {
        PG8_STAGE(PG8_SB(0, 0), cB, voffB); PG8_STAGE(PG8_SB(0, 1), cB + hstep, voffB); PG8_STAGE(PG8_SA(0, 0), cA, voffA); PG8_STAGE(PG8_SA(0, 1), cA + hstep, voffA);
        if (wr == 1) PG8_BAR;
        PG8_WAIT_V(2); PG8_BAR;
        PG8_STAGE(PG8_SB(1, 0), cB + kstep, voffB); PG8_STAGE(PG8_SA(1, 0), cA + kstep, voffA); PG8_STAGE(PG8_SB(1, 1), cB + hstep + kstep, voffB);
        PG8_WAIT_V(6); PG8_BAR;
    } else {
        PG8_STAGE(PG8_SB(0, 0), cB, voffB); PG8_STAGE(PG8_SA(0, 0), cA, voffA); PG8_STAGE(PG8_SB(0, 1), cB + hstep, voffB); PG8_STAGE(PG8_SA(0, 1), cA + hstep, voffA);
        if (wr == 1) PG8_BAR;
        PG8_WAIT_V(4); PG8_BAR;
        PG8_STAGE(PG8_SB(1, 0), cB + kstep, voffB); PG8_STAGE(PG8_SA(1, 0), cA + kstep, voffA); PG8_STAGE(PG8_SB(1, 1), cB + hstep + kstep, voffB);
        PG8_WAIT_V(6); PG8_BAR;
    }
    for (;;) {
        const bool has_next = S.next(ui + 1, nxt);
        const char* nA = has_next ? (const char*)g.A + (size_t)nxt.pm * tstep : cA; const char* nB = has_next ? (const char*)g.Bt + (size_t)nxt.pn * tstep : cB;
        for (int t = 0; t < nt; t += 2) {
            const bool last = (t == nt - 2);
            const char* a1 = cA + (size_t)(t + 1) * kstep;
            const char* a2 = last ? nA : cA + (size_t)(t + 2) * kstep; const char* b2 = last ? nB : cB + (size_t)(t + 2) * kstep;
            const char* a3 = a2 + kstep; const char* b3 = b2 + kstep;
            if (last && has_next) S.a_ready(nxt);
            if constexpr (SP2) {
            PG8_LDB(B0, 0, 0); PG8_LDB(B1, 0, 1); PG8_SCHED; PG8_LDA(At, 0, 0); PG8_STAGE(PG8_SA(1, 1), a1 + hstep, voffA);
            PG8_WAIT_V(8); PG8_WAIT_L(0); PG8_BAR; PG8_MMA(0, 0, At, B0); PG8_MMA(0, 1, At, B1); PG8_BAR; PG8_SCHED;
            PG8_LDA(At, 0, 1); PG8_STAGE(PG8_SB(0, 0), b2, voffB); PG8_STAGE(PG8_SB(0, 1), b2 + hstep, voffB); PG8_STAGE(PG8_SA(0, 0), a2, voffA);
            PG8_WAIT_V(8); PG8_WAIT_L(0); PG8_BAR; PG8_MMA(1, 0, At, B0); PG8_MMA(1, 1, At, B1); PG8_BAR; PG8_SCHED;
            PG8_LDB(B0, 1, 0); PG8_LDB(B1, 1, 1); PG8_SCHED; PG8_LDA(At, 1, 0); PG8_STAGE(PG8_SA(0, 1), a2 + hstep, voffA);
            PG8_WAIT_V(8); PG8_WAIT_L(0); PG8_BAR; PG8_MMA(0, 0, At, B0); PG8_MMA(0, 1, At, B1); PG8_BAR; PG8_SCHED;
            PG8_LDA(At, 1, 1); PG8_STAGE(PG8_SB(1, 0), b3, voffB); PG8_STAGE(PG8_SB(1, 1), b3 + hstep, voffB); PG8_STAGE(PG8_SA(1, 0), a3, voffA);
            PG8_WAIT_V(8); PG8_WAIT_L(0); PG8_BAR; PG8_MMA(1, 0, At, B0); PG8_MMA(1, 1, At, B1); PG8_BAR; PG8_SCHED;
            } else {
            PG8_LDB(B0, 0, 0); PG8_SCHED; PG8_LDA(At, 0, 0); PG8_STAGE(PG8_SA(1, 1), a1 + hstep, voffA);
            PG8_WAIT_L(8); PG8_BAR; PG8_WAIT_L(0); PG8_MMA(0, 0, At, B0); PG8_BAR; PG8_SCHED;
            PG8_LDB(B1, 0, 1); PG8_STAGE(PG8_SB(0, 0), b2, voffB);
            PG8_BAR; PG8_WAIT_L(0); PG8_MMA(0, 1, At, B1); PG8_BAR;
            PG8_LDA(At, 0, 1); PG8_STAGE(PG8_SA(0, 0), a2, voffA);
            PG8_BAR; PG8_WAIT_L(0); PG8_MMA(1, 0, At, B0); PG8_BAR; PG8_SCHED;
            PG8_STAGE(PG8_SB(0, 1), b2 + hstep, voffB);
            PG8_WAIT_V(6); PG8_BAR; PG8_MMA(1, 1, At, B1); PG8_BAR;
            PG8_LDB(B0, 1, 0); PG8_SCHED; PG8_LDA(At, 1, 0); PG8_STAGE(PG8_SA(0, 1), a2 + hstep, voffA);
            PG8_WAIT_L(8); PG8_BAR; PG8_WAIT_L(0); PG8_MMA(0, 0, At, B0); PG8_BAR; PG8_SCHED;
            PG8_LDB(B1, 1, 1); PG8_STAGE(PG8_SB(1, 0), b3, voffB);
            PG8_BAR; PG8_WAIT_L(0); PG8_MMA(0, 1, At, B1); PG8_BAR;
            PG8_LDA(At, 1, 1); PG8_STAGE(PG8_SA(1, 0), a3, voffA);
            PG8_BAR; PG8_WAIT_L(0); PG8_MMA(1, 0, At, B0); PG8_BAR; PG8_SCHED;
            PG8_STAGE(PG8_SB(1, 1), b3 + hstep, voffB);
            PG8_WAIT_V(6); PG8_BAR; PG8_MMA(1, 1, At, B1); PG8_BAR;
            }
        }
        if constexpr (ALIGN_EPI) { if (wr == 0) PG8_BAR; }
        if constexpr (!Epi::AFTER_DRAIN) { E(acc, cur, wr, wc, fr, fq); S.done(cur); }
        if (!has_next) break;
#pragma unroll
        for (int a = 0; a < 2; ++a)
#pragma unroll
            for (int b = 0; b < 2; ++b)
#pragma unroll
                for (int m = 0; m < 4; ++m)
#pragma unroll
                    for (int n = 0; n < 2; ++n) acc[a][b][m][n] = (f32x4){0.f, 0.f, 0.f, 0.f};
        cur = nxt; cA = nA; cB = nB; ++ui;
        if constexpr (ALIGN_EPI) { if (wr == 1) PG8_BAR; }
    }
    PG8_WAIT_V(0);
    if constexpr (!ALIGN_EPI) { if (wr == 0) PG8_BAR; }
    PG8_BAR;
    if constexpr (Epi::AFTER_DRAIN) { E.fused(acc, cur, wr, wc, fr, fq, lds, wid, lane); S.done(cur); }
#undef PG8_SA
#undef PG8_SB
#undef PG8_STAGE
#undef PG8_LDA
#undef PG8_LDB
#undef PG8_MMA
#undef PG8_WAIT_V
#undef PG8_WAIT_L
#undef PG8_BAR
#undef PG8_SCHED
}
}
namespace pg8 {
struct EpiRowScaleBf16 {
    static constexpr bool PERM = true, AFTER_DRAIN = false;
    bf16_t* O; int ldc; const float* rs;
    __device__ __forceinline__ void operator()(const f32x4 (&acc)[2][2][4][2], const Unit& u, int wr, int wc, int fr, int fq) const {
        const int row0 = u.pm * BM + wr * 64 + fr; const int col0 = u.pn * BM + wc * 32 + 8 * fq;
#pragma unroll
        for (int ai = 0; ai < 2; ++ai)
#pragma unroll
            for (int m = 0; m < 4; ++m) { const int row = row0 + ai * HALF + m * 16; const float sc = rs[row]; bf16_t* rowp = O + (size_t)row * ldc + col0;
#pragma unroll
                for (int bj = 0; bj < 2; ++bj) { f32x4 v0 = acc[ai][bj][m][0] * sc, v1 = acc[ai][bj][m][1] * sc;
                    u32x4 w; w.x = cvt_pk_bf16(v0[0], v0[1]); w.y = cvt_pk_bf16(v0[2], v0[3]); w.z = cvt_pk_bf16(v1[0], v1[1]); w.w = cvt_pk_bf16(v1[2], v1[3]);
                    *(u32x4*)(rowp + bj * HALF) = w; } }
    }
};
struct EpiResF32 {
    static constexpr bool PERM = false, AFTER_DRAIN = false;
    const float* base; float* out; int ldc;
    __device__ __forceinline__ void operator()(const f32x4 (&acc)[2][2][4][2], const Unit& u, int wr, int wc, int fr, int fq) const {
        const int col0 = u.pn * BM + wc * 32 + 4 * fq;
#pragma unroll
        for (int ai = 0; ai < 2; ++ai)
#pragma unroll
            for (int m = 0; m < 4; ++m) { const int r = u.pm * BM + ai * HALF + wr * 64 + m * 16 + fr; const size_t off = (size_t)r * ldc + col0;
#pragma unroll
                for (int bj = 0; bj < 2; ++bj)
#pragma unroll
                    for (int n = 0; n < 2; ++n) { const f32x4 bs = *(const f32x4*)(base + off + bj * HALF + n * 16); *(f32x4*)(out + off + bj * HALF + n * 16) = bs + acc[ai][bj][m][n]; } }
    }
};
}

constexpr int NB = 4, T = 8192, D = 1024, M = NB * T;
constexpr int NP = 3584;
constexpr int W_IN_COLS = 3596;
constexpr int C_R = 0, C_K = 512, C_V = 1024, C_G = 1536, C_WD = 2048, C_AD = 2112, C_NQ = 2176, C_NG = 2432, C_KC = 2688, C_VC = 2752,
              C_KS = 2816, C_VS = 2880, C_KW = 2944, C_VW = 3008, C_MQ = 3072, C_MG = 3328;
constexpr int GLOG_SRC = 2688;
constexpr int NCMP = 511, NSEL = 128, MEML = 256;

constexpr size_t MiB = 1u << 20;
constexpr size_t WS_CTL = 0, CTL_ZERO_BYTES = 1 * MiB;
constexpr size_t WS_WIN = 1 * MiB, WS_WOUT = 8 * MiB;
constexpr size_t KiB = 1024;
constexpr size_t WS_ROPE = 10 * MiB, WS_RS = 10 * MiB + 512 * KiB, WS_W1TK = 10 * MiB + 768 * KiB, WS_KCMP = 11 * MiB, WS_VCMP = 11 * MiB + 256 * KiB, WS_W1TV = 11 * MiB + 512 * KiB,
                 WS_WUPT = 11 * MiB + 768 * KiB, WS_AUPT = 11 * MiB + 832 * KiB, WS_W2TK = 11 * MiB + 896 * KiB, WS_W2TV = 11 * MiB + 904 * KiB, WS_MEMKV = 12 * MiB, WS_WKVT = 13 * MiB, WS_GLOG = 14 * MiB, WS_MEMN = 304 * MiB  ;
constexpr size_t WS_P = 16 * MiB, WS_XB = 240 * MiB, WS_CHK_PR = 240 * MiB, WS_Y = 304 * MiB, WS_A = 368 * MiB, WS_CHK_S = 368 * MiB, WS_LW = 400 * MiB, WS_CHK_QY = 432 * MiB, WS_BONUS = 496 * MiB, WS_OTP = 400 * MiB  , WS_END = 497 * MiB;
constexpr int CW_BAR = 4096;

constexpr int RING_BYTES = 131072, LDSCTL_OFF = RING_BYTES, MISC_OFF = LDSCTL_OFF + 320, LDS_BYTES = 147456;
constexpr int NWAVES = 8;

#define GAS __attribute__((address_space(1)))
#define LAS __attribute__((address_space(3)))
typedef unsigned short bf16;
typedef unsigned v4u __attribute__((ext_vector_type(4)));
typedef unsigned v2u __attribute__((ext_vector_type(2)));
typedef float f32x4 __attribute__((ext_vector_type(4)));
#define LDS_WAIT() asm volatile("s_waitcnt lgkmcnt(0)" ::: "memory")
__device__ __forceinline__ unsigned f2bf(float f) { unsigned u = __builtin_bit_cast(unsigned, f); return (u + 0x7fffu + ((u >> 16) & 1u)) >> 16; }
__device__ __forceinline__ unsigned pk2(float lo, float hi) { return f2bf(lo) | (f2bf(hi) << 16); }
__device__ __forceinline__ float bf2f(unsigned short h) { return __builtin_bit_cast(float, (unsigned)h << 16); }
__device__ __forceinline__ float bflo(unsigned u) { return __builtin_bit_cast(float, u << 16); }
__device__ __forceinline__ float bfhi(unsigned u) { return __builtin_bit_cast(float, u & 0xffff0000u); }
__device__ __forceinline__ void unpack8(const v4u v, float (&f)[8]) { f[0] = bflo(v.x); f[1] = bfhi(v.x); f[2] = bflo(v.y); f[3] = bfhi(v.y); f[4] = bflo(v.z); f[5] = bfhi(v.z); f[6] = bflo(v.w); f[7] = bfhi(v.w); }
__device__ __forceinline__ v4u pack8(const float (&f)[8]) { v4u o; o.x = pk2(f[0], f[1]); o.y = pk2(f[2], f[3]); o.z = pk2(f[4], f[5]); o.w = pk2(f[6], f[7]); return o; }
__device__ __forceinline__ float rdlane(float v, int l) { return __builtin_bit_cast(float, __builtin_amdgcn_readlane(__builtin_bit_cast(int, v), l)); }
template <int CTRL> __device__ __forceinline__ float dppf(float v) { return __builtin_bit_cast(float, __builtin_amdgcn_update_dpp(0, __builtin_bit_cast(int, v), CTRL, 0xf, 0xf, true)); }
template <int CTRL> __device__ __forceinline__ int dppi(int v) { return __builtin_amdgcn_update_dpp(0, v, CTRL, 0xf, 0xf, true); }
__device__ __forceinline__ int sum8i(int x) { x += dppi<0xB1>(x); x += dppi<0x4E>(x); x += dppi<0x141>(x); return x; }
__device__ __forceinline__ float sum8(float x) { x += dppf<0xB1>(x); x += dppf<0x4E>(x); x += dppf<0x141>(x); return x; }
__device__ __forceinline__ float wave_sum(float v) {
    v += dppf<0xB1>(v); v += dppf<0x4E>(v); v += dppf<0x141>(v); v += dppf<0x140>(v);
    return (rdlane(v, 0) + rdlane(v, 16)) + (rdlane(v, 32) + rdlane(v, 48));
}
__device__ __forceinline__ float xrow_max(float v) { v = fmaxf(v, __shfl_xor(v, 16)); v = fmaxf(v, __shfl_xor(v, 32)); return v; }
__device__ __forceinline__ float xrow_sum(float v) { v += __shfl_xor(v, 16); v += __shfl_xor(v, 32); return v; }
__device__ __forceinline__ float siluf(float x) { return x / (1.f + __expf(-x)); }
__device__ __forceinline__ float sigmf(float x) { return 1.f / (1.f + __expf(-x)); }

#define XB_TMO      128
#define XB_XCNT(j)  (256  + 64 * (j))
#define XB_XSUB(j)  (1280 + 64 * (j))
#define XB_XGEN(j)  (2304 + 64 * (j))
#define XB_TOP      3328
#define XB_TOPGEN   3392
#define XCD_BAR_WORDS 3456
#define XB_SPIN_CAP (1u << 20)
__device__ __forceinline__ unsigned xb_ld(unsigned* p)              { return __hip_atomic_load(p, __ATOMIC_RELAXED, __HIP_MEMORY_SCOPE_AGENT); }
__device__ __forceinline__ unsigned xb_add(unsigned* p, unsigned v) { return __hip_atomic_fetch_add(p, v, __ATOMIC_RELAXED, __HIP_MEMORY_SCOPE_AGENT); }
__device__ __forceinline__ unsigned xb_xcc_id() { return (unsigned)__builtin_amdgcn_s_getreg((3 << 11) | 20) & 0xFu; }
#define XB_SPIN(cond, bar) do { unsigned _sp = 0; while (cond) { __builtin_amdgcn_s_sleep(1); \
    if ((++_sp & 255u) == 0u) { if (xb_ld(&(bar)[XB_TMO])) break; if (_sp > XB_SPIN_CAP) { atomicAdd(&(bar)[XB_TMO], 1u); break; } } } } while (0)
struct XcdBarrier { unsigned* bar; unsigned x; volatile LAS unsigned* st; };
__device__ __forceinline__ XcdBarrier xcd_barrier_post(unsigned* bar, volatile LAS unsigned* st) {
    XcdBarrier b; b.bar = bar; b.x = xb_xcc_id(); b.st = st;
    if (threadIdx.x == 0) (void)xb_add(&bar[XB_XCNT(b.x)], 1u);
    return b;
}
__device__ __forceinline__ void xcd_barrier_complete(unsigned* bar, unsigned x, unsigned& nloc, unsigned& nx) {
    const unsigned G = gridDim.x * gridDim.y * gridDim.z;
    unsigned sum, cnt, mine, sp = 0u;
    for (;;) {
        sum = 0u; cnt = 0u; mine = 0u;
#pragma unroll
        for (unsigned j = 0; j < 16; ++j) { const unsigned c = xb_ld(&bar[XB_XCNT(j)]); sum += c; cnt += (c > 0u) ? 1u : 0u; mine = (j == x) ? c : mine; }
        if (sum == G) break;
        __builtin_amdgcn_s_sleep(1);
        if ((++sp & 255u) == 0u) { if (xb_ld(&bar[XB_TMO])) break; if (sp > XB_SPIN_CAP) { atomicAdd(&bar[XB_TMO], 1u); break; } }
    }
    nloc = mine > 0u ? mine : 1u; nx = cnt > 0u ? cnt : 1u;
}
__device__ __forceinline__ void xcd_barrier(const XcdBarrier& b) {
    asm volatile("s_waitcnt vmcnt(0)" ::: "memory");
    __syncthreads();
    if (threadIdx.x == 0) {
        unsigned* bar = b.bar;
        __builtin_amdgcn_s_waitcnt(0);
        unsigned nloc = b.st[0], nx = b.st[1];
        if (nloc == 0u) { xcd_barrier_complete(bar, b.x, nloc, nx); b.st[0] = nloc; b.st[1] = nx; }
        const unsigned old = xb_add(&bar[XB_XSUB(b.x)], 1u);
        const unsigned gen = old / nloc;
        if (old + 1u == (gen + 1u) * nloc) {
            __builtin_amdgcn_fence(__ATOMIC_RELEASE, "agent");
            asm volatile("s_waitcnt vmcnt(0)" ::: "memory");
            const unsigned og = xb_add(&bar[XB_TOP], 1u);
            const unsigned tg = og / nx;
            if (og + 1u == (tg + 1u) * nx) xb_add(&bar[XB_TOPGEN], 1u);
            else XB_SPIN(xb_ld(&bar[XB_TOPGEN]) == tg, bar);
            __builtin_amdgcn_fence(__ATOMIC_ACQUIRE, "agent");
            xb_add(&bar[XB_XGEN(b.x)], 1u);
            asm volatile("s_waitcnt vmcnt(0)" ::: "memory");
        } else {
            XB_SPIN(xb_ld(&bar[XB_XGEN(b.x)]) == gen, bar);
            __builtin_amdgcn_fence(__ATOMIC_ACQUIRE, "agent");
            asm volatile("s_waitcnt vmcnt(0)" ::: "memory");
        }
    }
    __syncthreads();
}

struct Args { const float* in[26]; float* out; unsigned char* ws; };

__device__ __forceinline__ void p0_transpose_item(const float* W, int ldw, int src_col0, const float* kscale, bf16* WT, int K, int dst_row0, int k0, LAS float* scr, int lane) {
    float tv[32];
#pragma unroll
    for (int i = 0; i < 32; ++i) { const int kk = 2 * i + (lane >> 5); tv[i] = W[(size_t)(k0 + kk) * ldw + src_col0 + (lane & 31)]; }
#pragma unroll
    for (int i = 0; i < 32; ++i) { const int kk = 2 * i + (lane >> 5); float v = tv[i]; if (kscale) v *= kscale[k0 + kk]; scr[kk * 33 + (lane & 31)] = v; }
    LDS_WAIT(); asm volatile("" ::: "memory");
    const int c = lane & 7;
#pragma unroll
    for (int j = 0; j < 4; ++j) { const int n = (lane >> 3) + 8 * j; const LAS float* s = scr + (8 * c) * 33 + n;
        v4u o; o.x = pk2(s[0 * 33], s[1 * 33]); o.y = pk2(s[2 * 33], s[3 * 33]); o.z = pk2(s[4 * 33], s[5 * 33]); o.w = pk2(s[6 * 33], s[7 * 33]);
        *(v4u*)(WT + (size_t)(dst_row0 + n) * K + k0 + 8 * c) = o; }
    LDS_WAIT(); asm volatile("" ::: "memory");
}
__device__ __forceinline__ double rope_inv_freq(int i) {
    return i == 0 ? 1.0 : i == 1 ? 0.19392274474868576 : i == 2 ? 0.03760603093086393 : i == 3 ? 0.007292664737217109 : i == 4 ? 0.001414213562373095 :
           i == 5 ? 0.0002742481756762073 : i == 6 ? 5.318295896944988e-05 : 1.031338537721246e-05;
}
__device__ __forceinline__ void rope_cs(int pos, int i, float& c, float& s) {
    const double ang = (double)pos * rope_inv_freq(i);
    const double n = __builtin_rint(ang * 0.15915494309189535);
    const double r = __builtin_fma(-n, 6.283185307179586, ang);
    const double kq = __builtin_rint(r * 0.6366197723675814);
    const double y = __builtin_fma(-kq, 1.5707963267948966, r);
    const double y2 = y * y;
    const double sy = y * (1.0 + y2 * (-1.0 / 6 + y2 * (1.0 / 120 + y2 * (-1.0 / 5040 + y2 * (1.0 / 362880 - y2 * (1.0 / 39916800))))));
    const double cy = 1.0 + y2 * (-0.5 + y2 * (1.0 / 24 + y2 * (-1.0 / 720 + y2 * (1.0 / 40320 + y2 * (-1.0 / 3628800 + y2 * (1.0 / 479001600))))));
    const int q = ((int)kq) & 3;
    const double cc = q == 0 ? cy : q == 1 ? -sy : q == 2 ? -cy : sy;
    const double ss = q == 0 ? sy : q == 1 ? cy : q == 2 ? -sy : -cy;
    c = (float)cc; s = (float)ss;
}

#ifndef REPEAT
#define REPEAT 0
#endif
#define RPT(k) (((REPEAT >> (k)) & 1) ? 2 : 1)

typedef short bf16x8 __attribute__((ext_vector_type(8)));
typedef short v4i16 __attribute__((ext_vector_type(4)));
#define MFMA16(a, b, c) __builtin_amdgcn_mfma_f32_16x16x32_bf16(a, b, c, 0, 0, 0)
constexpr int AT_SLOT = 16384, AT_RING = 3 * AT_SLOT, AT_IMP = AT_RING, AT_IMP_W = 8448, AT_SELM = AT_IMP + 8 * AT_IMP_W, AT_TILEM = AT_SELM + 1024, AT_LIST = AT_TILEM + 16, AT_NB = AT_LIST + 544;
constexpr float SM_C = 0.125f * 1.4426950408889634f;
#define AT_WAITBAR(N) asm volatile("s_waitcnt vmcnt(" #N ") lgkmcnt(0)\n\ts_barrier" ::: "memory")

struct Grp { bf16x8 q[2]; f32x4 o[4]; float m, l; };

__device__ __forceinline__ void glds16(const void* gsrc, unsigned lds_dst) { unsigned keep;
    asm volatile("s_mov_b32 %0, m0\n\ts_mov_b32 m0, %2\n\ts_nop 0\n\tglobal_load_lds_dwordx4 %1, off\n\ts_mov_b32 m0, %0" : "=&s"(keep) : "v"(gsrc), "s"(lds_dst) : "memory"); }
__device__ __forceinline__ void at_dma(const bf16* kb, size_t kpitch, const bf16* vb, size_t vpitch, LAS unsigned char* slot, int tid, int wave, bool withV) {
    const int r = tid >> 3, c = (tid & 7) ^ (2 * ((r >> 1) & 3));
    const unsigned dst = (unsigned)__builtin_amdgcn_readfirstlane((int)((unsigned)(size_t)slot + (unsigned)wave * 1024u));
    glds16(kb + (size_t)r * kpitch + c * 8, dst);
    if (withV) glds16(vb + (size_t)r * vpitch + c * 8, dst + 8192u);
}
__device__ __forceinline__ unsigned cvtpk(float lo, float hi) { typedef float f2 __attribute__((ext_vector_type(2))); typedef __bf16 b2 __attribute__((ext_vector_type(2))); f2 v = {lo, hi}; b2 b = __builtin_convertvector(v, b2); return __builtin_bit_cast(unsigned, b); }
__device__ __forceinline__ float fmax3(float a, float b, float c) { return fmaxf(fmaxf(a, b), c); }

template <int NG, int MODE>
__device__ __forceinline__ void at_block(Grp (&G)[NG], LAS const unsigned char* slot, int koff0, int koff1, const int (&vdt)[4], int g, const int (&lo)[NG], const int (&hi)[NG], const bool (&need)[NG], const bool (&on)[NG], bool partial,
                                         LAS float* impA, LAS float* impB, int sb0, int lane) {
    bf16x8 kf[4][2];
#pragma unroll
    for (int kt = 0; kt < 4; ++kt) { kf[kt][0] = *(const LAS bf16x8*)(slot + kt * 2048 + koff0); kf[kt][1] = *(const LAS bf16x8*)(slot + kt * 2048 + koff1); }
    bf16x8 pf[NG][2];
#pragma unroll
    for (int gi = 0; gi < NG; ++gi) {
        if (!need[gi]) continue;
        f32x4 s[4];
#pragma unroll
        for (int kt = 0; kt < 4; ++kt) { s[kt] = (f32x4){0.f, 0.f, 0.f, 0.f}; s[kt] = MFMA16(kf[kt][0], G[gi].q[0], s[kt]); s[kt] = MFMA16(kf[kt][1], G[gi].q[1], s[kt]); }
        if (partial) {
#pragma unroll
            for (int kt = 0; kt < 4; ++kt)
#pragma unroll
                for (int r = 0; r < 4; ++r) { const int kl = 16 * kt + 4 * g + r; if (kl < lo[gi] || kl > hi[gi]) s[kt][r] = -INFINITY; }
        }
        float mref;
        if (MODE != 1) {
            float mx = fmax3(s[0][0], s[0][1], s[0][2]); mx = fmax3(mx, s[0][3], s[1][0]); mx = fmax3(mx, s[1][1], s[1][2]); mx = fmax3(mx, s[1][3], s[2][0]);
            mx = fmax3(mx, s[2][1], s[2][2]); mx = fmax3(mx, s[2][3], s[3][0]); mx = fmax3(mx, s[3][1], s[3][2]); mx = fmaxf(mx, s[3][3]);
            mx = xrow_max(mx);
            const float mn = fmaxf(G[gi].m, on[gi] ? mx * SM_C : -INFINITY);
            const float alpha = __builtin_amdgcn_exp2f(G[gi].m - mn);
            G[gi].m = mn; mref = on[gi] ? mn : INFINITY;
            if (__builtin_amdgcn_ballot_w64(alpha != 1.0f)) {
                G[gi].l *= alpha;
                if (MODE == 2) {
#pragma unroll
                    for (int dt = 0; dt < 4; ++dt) G[gi].o[dt] *= alpha; }
            }
        } else mref = G[gi].m;
        float lsum = 0.f;
#pragma unroll
        for (int kt = 0; kt < 4; ++kt)
#pragma unroll
            for (int r = 0; r < 4; ++r) { const float p = __builtin_amdgcn_exp2f(__builtin_fmaf(s[kt][r], SM_C, -mref)); s[kt][r] = p; lsum += p; }
        if (MODE != 1) G[gi].l += lsum;
        if (MODE == 1) {
            const float il = G[gi].l;
#pragma unroll
            for (int kt = 0; kt < 4; ++kt) { s[kt] *= il;
                float a = s[kt][0] + s[kt][1] + s[kt][2] + 0.5f * s[kt][3], b = 0.5f * s[kt][3];
                a += dppf<0xB1>(a); a += dppf<0x4E>(a); b += dppf<0xB1>(b); b += dppf<0x4E>(b);
                if ((lane & 3) == 0) { const int q8 = gi * 4 + ((lane & 15) >> 2); impA[q8 * 132 + sb0 + 4 * kt + g] = a; impB[q8 * 132 + sb0 + 4 * kt + g + 1] = b; } }
        }
        if (MODE != 0) {
            pf[gi][0] = __builtin_bit_cast(bf16x8, (v4u){cvtpk(s[0][0], s[0][1]), cvtpk(s[0][2], s[0][3]), cvtpk(s[1][0], s[1][1]), cvtpk(s[1][2], s[1][3])});
            pf[gi][1] = __builtin_bit_cast(bf16x8, (v4u){cvtpk(s[2][0], s[2][1]), cvtpk(s[2][2], s[2][3]), cvtpk(s[3][0], s[3][1]), cvtpk(s[3][2], s[3][3])});
        }
    }
    if (MODE != 0) {
        LAS const unsigned char* vs = slot + 8192;
#pragma unroll
        for (int dt = 0; dt < 4; ++dt) {
            bf16x8 vf[2];
#pragma unroll
            for (int kp = 0; kp < 2; ++kp) {
                const v4i16 a = __builtin_amdgcn_ds_read_tr16_b64_v4i16((LAS v4i16*)(vs + vdt[dt] + (2 * kp) * 2048));
                const v4i16 b = __builtin_amdgcn_ds_read_tr16_b64_v4i16((LAS v4i16*)(vs + vdt[dt] + (2 * kp + 1) * 2048));
                vf[kp] = (bf16x8){a[0], a[1], a[2], a[3], b[0], b[1], b[2], b[3]};
            }
#pragma unroll
            for (int gi = 0; gi < NG; ++gi) if (need[gi]) { G[gi].o[dt] = MFMA16(vf[0], pf[gi][0], G[gi].o[dt]); G[gi].o[dt] = MFMA16(vf[1], pf[gi][1], G[gi].o[dt]); }
        }
    }
}


template <int NEEDMASK, bool PARTIAL, int MODE>
__device__ __forceinline__ void at_block2(Grp (&G)[2], LAS const unsigned char* slot, int koff0, int koff1, const int (&vdt)[4], int g, const int (&lo)[2], const int (&hi)[2], const bool (&on)[2],
                                          LAS float* impA, LAS float* impB, int sb0, int lane) {
    bf16x8 kf[4][2];
#pragma unroll
    for (int kt = 0; kt < 4; ++kt) { kf[kt][0] = *(const LAS bf16x8*)(slot + kt * 2048 + koff0); kf[kt][1] = *(const LAS bf16x8*)(slot + kt * 2048 + koff1); }
    f32x4 s[2][4];
#pragma unroll
    for (int kt = 0; kt < 4; ++kt)
#pragma unroll
        for (int gi = 0; gi < 2; ++gi) if (NEEDMASK & (1 << gi)) s[gi][kt] = MFMA16(kf[kt][0], G[gi].q[0], ((f32x4){0.f, 0.f, 0.f, 0.f}));
#pragma unroll
    for (int kt = 0; kt < 4; ++kt)
#pragma unroll
        for (int gi = 0; gi < 2; ++gi) if (NEEDMASK & (1 << gi)) s[gi][kt] = MFMA16(kf[kt][1], G[gi].q[1], s[gi][kt]);
    float mref[2];
    if (MODE != 1) {
        float mx[2];
#pragma unroll
        for (int gi = 0; gi < 2; ++gi) if (NEEDMASK & (1 << gi)) {
            if (PARTIAL) {
#pragma unroll
                for (int kt = 0; kt < 4; ++kt)
#pragma unroll
                    for (int r = 0; r < 4; ++r) { const int kl = 16 * kt + 4 * g + r; if (kl < lo[gi] || kl > hi[gi]) s[gi][kt][r] = -INFINITY; }
            }
            float m0 = fmax3(s[gi][0][0], s[gi][0][1], s[gi][0][2]), m1 = fmax3(s[gi][0][3], s[gi][1][0], s[gi][1][1]);
            m0 = fmax3(m0, s[gi][1][2], s[gi][1][3]); m1 = fmax3(m1, s[gi][2][0], s[gi][2][1]); m0 = fmax3(m0, s[gi][2][2], s[gi][2][3]); m1 = fmax3(m1, s[gi][3][0], s[gi][3][1]);
            m0 = fmax3(m0, s[gi][3][2], s[gi][3][3]); mx[gi] = fmaxf(m0, m1);
        }
        float t[2];
#pragma unroll
        for (int gi = 0; gi < 2; ++gi) if (NEEDMASK & (1 << gi)) t[gi] = __shfl_xor(mx[gi], 16);
#pragma unroll
        for (int gi = 0; gi < 2; ++gi) if (NEEDMASK & (1 << gi)) mx[gi] = fmaxf(mx[gi], t[gi]);
#pragma unroll
        for (int gi = 0; gi < 2; ++gi) if (NEEDMASK & (1 << gi)) t[gi] = __shfl_xor(mx[gi], 32);
#pragma unroll
        for (int gi = 0; gi < 2; ++gi) if (NEEDMASK & (1 << gi)) {
            mx[gi] = fmaxf(mx[gi], t[gi]);
            const float mxs = on[gi] ? mx[gi] * SM_C : -INFINITY;
            const float mn = fmaxf(G[gi].m, mxs);
            const float alpha = __builtin_amdgcn_exp2f(G[gi].m - mn);
            G[gi].m = mn; mref[gi] = on[gi] ? mn : INFINITY;
            G[gi].l *= alpha;
            if (MODE == 2) {
#pragma unroll
                for (int dt = 0; dt < 4; ++dt) G[gi].o[dt] *= alpha; }
        }
    } else {
#pragma unroll
        for (int gi = 0; gi < 2; ++gi) {
            if (PARTIAL) {
#pragma unroll
                for (int kt = 0; kt < 4; ++kt)
#pragma unroll
                    for (int r = 0; r < 4; ++r) { const int kl = 16 * kt + 4 * g + r; if (kl < lo[gi] || kl > hi[gi]) s[gi][kt][r] = -INFINITY; }
            }
            mref[gi] = G[gi].m; }
    }
    bf16x8 pf[2][2];
#pragma unroll
    for (int gi = 0; gi < 2; ++gi) if (NEEDMASK & (1 << gi)) {
#pragma unroll
        for (int kt = 0; kt < 4; ++kt)
#pragma unroll
            for (int r = 0; r < 4; ++r) s[gi][kt][r] = __builtin_amdgcn_exp2f(__builtin_fmaf(s[gi][kt][r], SM_C, -mref[gi]));
        const f32x4 ls4 = (s[gi][0] + s[gi][1]) + (s[gi][2] + s[gi][3]); const float lsum = (ls4.x + ls4.y) + (ls4.z + ls4.w);
        if (MODE != 1) G[gi].l += lsum;
        if (MODE == 1) {
            const float il = G[gi].l;
#pragma unroll
            for (int kt = 0; kt < 4; ++kt) { s[gi][kt] *= il;
                float a = s[gi][kt][0] + s[gi][kt][1] + s[gi][kt][2] + 0.5f * s[gi][kt][3], b = 0.5f * s[gi][kt][3];
                a += dppf<0xB1>(a); a += dppf<0x4E>(a); b += dppf<0xB1>(b); b += dppf<0x4E>(b);
                if ((lane & 3) == 0) { const int q8 = gi * 4 + ((lane & 15) >> 2); impA[q8 * 132 + sb0 + 4 * kt + g] = a; impB[q8 * 132 + sb0 + 4 * kt + g + 1] = b; } }
        }
        if (MODE != 0) {
            pf[gi][0] = __builtin_bit_cast(bf16x8, (v4u){cvtpk(s[gi][0][0], s[gi][0][1]), cvtpk(s[gi][0][2], s[gi][0][3]), cvtpk(s[gi][1][0], s[gi][1][1]), cvtpk(s[gi][1][2], s[gi][1][3])});
            pf[gi][1] = __builtin_bit_cast(bf16x8, (v4u){cvtpk(s[gi][2][0], s[gi][2][1]), cvtpk(s[gi][2][2], s[gi][2][3]), cvtpk(s[gi][3][0], s[gi][3][1]), cvtpk(s[gi][3][2], s[gi][3][3])});
        }
    }
    if (MODE != 0) {
        LAS const unsigned char* vs = slot + 8192;
#pragma unroll
        for (int dt = 0; dt < 4; ++dt) {
            bf16x8 vf[2];
#pragma unroll
            for (int kp = 0; kp < 2; ++kp) {
                const v4i16 a = __builtin_amdgcn_ds_read_tr16_b64_v4i16((LAS v4i16*)(vs + vdt[dt] + (2 * kp) * 2048));
                const v4i16 b = __builtin_amdgcn_ds_read_tr16_b64_v4i16((LAS v4i16*)(vs + vdt[dt] + (2 * kp + 1) * 2048));
                vf[kp] = (bf16x8){a[0], a[1], a[2], a[3], b[0], b[1], b[2], b[3]};
            }
#pragma unroll
            for (int gi = 0; gi < 2; ++gi) if (NEEDMASK & (1 << gi)) G[gi].o[dt] = MFMA16(vf[0], pf[gi][0], G[gi].o[dt]);
#pragma unroll
            for (int gi = 0; gi < 2; ++gi) if (NEEDMASK & (1 << gi)) G[gi].o[dt] = MFMA16(vf[1], pf[gi][1], G[gi].o[dt]);
        }
    }
}

template <int N> __device__ __forceinline__ void at_waitbar_blocks(int ahead, bool withv) {
    if (withv) { switch (ahead) { case 0: AT_WAITBAR(0); break; case 1: AT_WAITBAR(2); break; case 2: AT_WAITBAR(4); break; case 3: AT_WAITBAR(6); break; default: AT_WAITBAR(8); break; } }
    else { switch (ahead) { case 0: AT_WAITBAR(0); break; case 1: AT_WAITBAR(1); break; case 2: AT_WAITBAR(2); break; case 3: AT_WAITBAR(3); break; default: AT_WAITBAR(4); break; } }
}
template <bool WITHV, int NSLOT, class Src, class Body>
__device__ __forceinline__ void at_ring(LAS unsigned char* ring, int nb, int tid, int wave, const Src& src, Body& body) {
    const bf16 *kb = nullptr, *vb = nullptr; size_t kp = 0, vp = 0;
#pragma unroll
    for (int j = 0; j < NSLOT - 1; ++j) if (j < nb) { src(j, kb, kp, vb, vp); at_dma(kb, kp, vb, vp, ring + j * AT_SLOT, tid, wave, WITHV); }
    int sl = 0, sn = NSLOT - 1;
    for (int i = 0; i < nb; ++i) {
        const int last = (i + NSLOT - 2 < nb - 1) ? i + NSLOT - 2 : nb - 1;
        at_waitbar_blocks<NSLOT>(last - i, WITHV);
        if (i + NSLOT - 1 < nb) { src(i + NSLOT - 1, kb, kp, vb, vp); at_dma(kb, kp, vb, vp, ring + sn * AT_SLOT, tid, wave, WITHV); }
        body(i, ring + sl * AT_SLOT);
        sl = (sl + 1 == NSLOT) ? 0 : sl + 1; sn = (sn + 1 == NSLOT) ? 0 : sn + 1;
    }
    AT_WAITBAR(0);
}

struct LaneGeo { int lane, i16, g, koff0, koff1; int vdt[4]; };
__device__ __forceinline__ LaneGeo make_geo(int lane) {
    LaneGeo L; L.lane = lane; L.i16 = lane & 15; L.g = lane >> 4;
    const int swz = 2 * ((L.i16 >> 1) & 3);
    L.koff0 = L.i16 * 128 + (((0 ^ (swz >> 2)) * 4 + (L.g ^ (swz & 3))) * 16);
    L.koff1 = L.i16 * 128 + (((1 ^ (swz >> 2)) * 4 + (L.g ^ (swz & 3))) * 16);
    const int sv = (2 * L.g + (L.i16 >> 3)) & 3; const int vbase = (4 * L.g + (L.i16 >> 2)) * 128 + 8 * (L.i16 & 1) + ((L.i16 & 3) >> 1) * 16;
#pragma unroll
    for (int dt = 0; dt < 4; ++dt) L.vdt[dt] = vbase + ((dt ^ sv) << 5);
    return L;
}
__device__ __forceinline__ float xg_sum(float v) { return xrow_sum(v); }

struct SrcCmp { const bf16* K; const bf16* V; int b; __device__ __forceinline__ void operator()(int i, const bf16*& kb, size_t& kp, const bf16*& vb, size_t& vp) const {
    kb = K + (size_t)(b * 512 + 64 * i) * 64; kp = 64; vb = V + (size_t)(b * 512 + 64 * i) * 64; vp = 64; } };
struct SrcSel { const bf16* P; LAS const unsigned* list; bool use_list; int b; int kcol, vcol; int s0;
    __device__ __forceinline__ void operator()(int i, const bf16*& kb, size_t& kp, const bf16*& vb, size_t& vp) const {
        const int s = use_list ? (int)__builtin_amdgcn_readfirstlane(list[i]) : s0 + i; const bf16* base = P + (size_t)(b * T + 64 * s) * NP; kb = base + kcol; vb = base + vcol; kp = NP; vp = NP; } };

struct BodyCmp0 { Grp (&G)[2]; const LaneGeo& L; const int (&nv)[2];
    __device__ __forceinline__ void operator()(int i, LAS const unsigned char* slot) {
        const int lo[2] = {0, 0}; const int hi[2] = {nv[0] - 64 * i - 1, nv[1] - 64 * i - 1}; const bool on[2] = {true, true};
        const bool partial = __builtin_amdgcn_ballot_w64(hi[0] < 63 || hi[1] < 63) != 0ull;
        if (partial) at_block2<3, true, 0>(G, slot, L.koff0, L.koff1, L.vdt, L.g, lo, hi, on, nullptr, nullptr, 0, L.lane);
        else at_block2<3, false, 0>(G, slot, L.koff0, L.koff1, L.vdt, L.g, lo, hi, on, nullptr, nullptr, 0, L.lane); } };
struct BodyCmp1 { Grp (&G)[2]; const LaneGeo& L; const int (&nv)[2]; LAS float* impA; LAS float* impB;
    __device__ __forceinline__ void operator()(int i, LAS const unsigned char* slot) {
        const int lo[2] = {0, 0}; const int hi[2] = {nv[0] - 64 * i - 1, nv[1] - 64 * i - 1}; const bool on[2] = {true, true};
        const bool partial = __builtin_amdgcn_ballot_w64(hi[0] < 63 || hi[1] < 63) != 0ull;
        if (partial) at_block2<3, true, 1>(G, slot, L.koff0, L.koff1, L.vdt, L.g, lo, hi, on, impA, impB, 16 * i, L.lane);
        else at_block2<3, false, 1>(G, slot, L.koff0, L.koff1, L.vdt, L.g, lo, hi, on, impA, impB, 16 * i, L.lane); } };
struct BodySel { Grp (&G)[2]; const LaneGeo& L; LAS const unsigned* list; LAS const unsigned* selm; const int (&tql)[2]; int cur;
    __device__ __forceinline__ void operator()(int i, LAS const unsigned char* slot) {
        const int s = (int)__builtin_amdgcn_readfirstlane(list[i]); const int w = s >> 5, bit = s & 31;
        const int lo[2] = {0, 0}; int hi[2]; bool on[2], need[2];
#pragma unroll
        for (int gi = 0; gi < 2; ++gi) { const unsigned word = selm[tql[gi] * 4 + w]; on[gi] = (word >> bit) & 1u;
            hi[gi] = (s == cur) ? tql[gi] : 63; need[gi] = __builtin_amdgcn_ballot_w64(on[gi]) != 0ull; }
        if (s == cur) { at_block2<3, true, 2>(G, slot, L.koff0, L.koff1, L.vdt, L.g, lo, hi, on, nullptr, nullptr, 0, L.lane); return; }
        if (RPT(17) == 2) { Grp G2[2] = {G[0], G[1]}; at_block2<3, false, 2>(G2, slot, L.koff0, L.koff1, L.vdt, L.g, lo, hi, on, nullptr, nullptr, 0, L.lane);
            asm volatile("" :: "v"(G2[0].o[0]), "v"(G2[0].o[1]), "v"(G2[0].o[2]), "v"(G2[0].o[3]), "v"(G2[1].o[0]), "v"(G2[1].o[1]), "v"(G2[1].o[2]), "v"(G2[1].o[3]), "v"(G2[0].l), "v"(G2[1].l)); }
        if (need[0] && need[1]) at_block2<3, false, 2>(G, slot, L.koff0, L.koff1, L.vdt, L.g, lo, hi, on, nullptr, nullptr, 0, L.lane);
        else if (need[0]) at_block2<1, false, 2>(G, slot, L.koff0, L.koff1, L.vdt, L.g, lo, hi, on, nullptr, nullptr, 0, L.lane);
        else if (need[1]) at_block2<2, false, 2>(G, slot, L.koff0, L.koff1, L.vdt, L.g, lo, hi, on, nullptr, nullptr, 0, L.lane); } };
struct BodyWin { Grp (&G)[2]; const LaneGeo& L; const int (&tql)[2]; int cur, s0;
    __device__ __forceinline__ void operator()(int i, LAS const unsigned char* slot) {
        const int s = s0 + i; int lo[2], hi[2]; const bool on[2] = {true, true};
#pragma unroll
        for (int gi = 0; gi < 2; ++gi) { lo[gi] = (s == cur - 8) ? tql[gi] + 1 : 0; hi[gi] = (s == cur) ? tql[gi] : 63; }
        if ((s == cur) || (s == cur - 8)) at_block2<3, true, 2>(G, slot, L.koff0, L.koff1, L.vdt, L.g, lo, hi, on, nullptr, nullptr, 0, L.lane);
        else at_block2<3, false, 2>(G, slot, L.koff0, L.koff1, L.vdt, L.g, lo, hi, on, nullptr, nullptr, 0, L.lane); } };

__device__ __forceinline__ void grp_reset(Grp& g) { g.m = -1e30f; g.l = 0.f;
#pragma unroll
    for (int dt = 0; dt < 4; ++dt) g.o[dt] = (f32x4){0.f, 0.f, 0.f, 0.f}; }

__device__ __forceinline__ void nsa_unit(int b, int cur, LAS unsigned char* lds, int tid, int wave, int lane, const bf16* P, const bf16* KCMPb, const bf16* VCMPb, const float* GLOG, const float* gate_b,
                                         const float* nsa_out_g, const float* ROPE, bf16* Y, float* otp_wave) {
    asm volatile("" : "+v"(lane), "+v"(tid));
    LAS unsigned char* ring = lds;
    LAS float* impA = (LAS float*)(lds + AT_IMP + wave * AT_IMP_W); LAS float* impB = impA + 8 * 132;
    LAS unsigned* selm = (LAS unsigned*)(lds + AT_SELM); LAS unsigned* tilem = (LAS unsigned*)(lds + AT_TILEM); LAS unsigned* blist = (LAS unsigned*)(lds + AT_LIST); LAS unsigned* nbw = (LAS unsigned*)(lds + AT_NB);
    const LaneGeo L = make_geo(lane);
    const int t0 = cur * 64; const size_t m0 = (size_t)b * T + t0;
    const int h = L.i16 & 3;
    int tql[2]; tql[0] = 8 * wave + (L.i16 >> 2); tql[1] = tql[0] + 4;
    if (tid < 4) tilem[tid] = 0u;
    Grp G[2]; int nv[2];
    float* otp = otp_wave + lane;
#pragma unroll
    for (int gi = 0; gi < 2; ++gi) {
        const bf16* qp = P + (m0 + tql[gi]) * NP + C_NQ + h * 64 + 8 * L.g;
        G[gi].q[0] = *(const bf16x8*)qp; G[gi].q[1] = *(const bf16x8*)(qp + 32);
        const int tq = t0 + tql[gi]; nv[gi] = tq >= 31 ? min((tq - 31) / 16 + 1, NCMP) : 0;
        grp_reset(G[gi]);
    }
    asm volatile("" :: "v"(G[0].q[0]), "v"(G[0].q[1]), "v"(G[1].q[0]), "v"(G[1].q[1]));
    for (int i = lane; i < 2 * 8 * 132; i += 64) impA[i] = 0.f;
    const int nvmax = (t0 + 63 >= 31) ? min((t0 + 63 - 31) / 16 + 1, NCMP) : 0; const int nblk = (nvmax + 63) >> 6;
    for (int rp_ = 0; rp_ < RPT(8); ++rp_) { grp_reset(G[0]); grp_reset(G[1]); SrcCmp src{KCMPb, VCMPb, b}; BodyCmp0 body{G, L, nv}; at_ring<false, 3>(ring, nblk, tid, wave, src, body); }
#pragma unroll
    for (int gi = 0; gi < 2; ++gi) { const float lt = xg_sum(G[gi].l); G[gi].l = 1.0f / fmaxf(lt, 1e-30f); }
    for (int rp_ = 0; rp_ < RPT(9); ++rp_) {
#pragma unroll
        for (int gi = 0; gi < 2; ++gi)
#pragma unroll
            for (int dt = 0; dt < 4; ++dt) G[gi].o[dt] = (f32x4){0.f, 0.f, 0.f, 0.f};
        SrcCmp src{KCMPb, VCMPb, b}; BodyCmp1 body{G, L, nv, impA, impB}; at_ring<true, 3>(ring, nblk, tid, wave, src, body); }
    for (int rp_ = 0; rp_ < RPT(10); ++rp_) {
        const int q8 = lane >> 3, part = lane & 7;
        unsigned va[16];
        { const LAS float* ia = impA + q8 * 132 + 16 * part; const LAS float* ib = impB + q8 * 132 + 16 * part;
#pragma unroll
          for (int j4 = 0; j4 < 4; ++j4) { const f32x4 x = *(const LAS f32x4*)(ia + 4 * j4), y = *(const LAS f32x4*)(ib + 4 * j4);
#pragma unroll
              for (int e = 0; e < 4; ++e) { const int sb = 16 * part + 4 * j4 + e; unsigned v = __builtin_bit_cast(unsigned, x[e] + y[e]);
                  if (sb == 0 || sb == cur || sb == cur - 1) v = 0x7f000000u; else if (sb > cur) v = 0u; va[4 * j4 + e] = v; } } }
        unsigned tau = 0u;
#pragma unroll 1
        for (int bit = 30; bit >= 0; --bit) { const unsigned cand = tau | (1u << bit); int cnt = 0;
#pragma unroll
            for (int j = 0; j < 16; ++j) cnt += (va[j] >= cand) ? 1 : 0;
            cnt = sum8i(cnt); if (cnt >= 16) tau = cand; }
        int gt = 0, eq = 0;
#pragma unroll
        for (int j = 0; j < 16; ++j) { gt += (va[j] > tau) ? 1 : 0; eq += (va[j] == tau) ? 1 : 0; }
        const int needn = 16 - sum8i(gt);
        int incl = eq;
        { const int s1 = dppi<0x111>(incl); if (part >= 1) incl += s1; const int s2 = dppi<0x112>(incl); if (part >= 2) incl += s2; const int s4 = dppi<0x114>(incl); if (part >= 4) incl += s4; }
        int run = incl - eq; unsigned bits = 0u;
#pragma unroll
        for (int j = 0; j < 16; ++j) { const bool iseq = va[j] == tau; const bool s = (va[j] > tau) || (iseq && run < needn); run += iseq ? 1 : 0; bits |= (s ? 1u : 0u) << j; }
        { const int rem = cur - 16 * part; const unsigned vm = rem >= 15 ? 0xffffu : (rem < 0 ? 0u : ((1u << (rem + 1)) - 1u)); bits &= vm; }
        const unsigned hi = (unsigned)dppi<0xB1>((int)bits);
        if ((part & 1) == 0) { const unsigned word = bits | (hi << 16); selm[(8 * wave + q8) * 4 + (part >> 1)] = word; atomicOr((unsigned*)&tilem[part >> 1], word); }
    }
    AT_WAITBAR(0);
    if (wave == 0) {
        const unsigned long long mA = (unsigned long long)tilem[0] | ((unsigned long long)tilem[1] << 32), mB = (unsigned long long)tilem[2] | ((unsigned long long)tilem[3] << 32);
        const int rA = __builtin_amdgcn_mbcnt_hi((unsigned)(mA >> 32), __builtin_amdgcn_mbcnt_lo((unsigned)mA, 0));
        const int rB = __builtin_amdgcn_mbcnt_hi((unsigned)(mB >> 32), __builtin_amdgcn_mbcnt_lo((unsigned)mB, 0));
        const int nA = __builtin_popcountll(mA);
        if ((mA >> lane) & 1ull) blist[rA] = (unsigned)lane;
        if ((mB >> lane) & 1ull) blist[nA + rB] = (unsigned)(64 + lane);
        if (lane == 0) nbw[0] = (unsigned)(nA + __builtin_popcountll(mB));
    }
    AT_WAITBAR(0);
    const int nsel = (int)__builtin_amdgcn_readfirstlane(nbw[0]);
#pragma unroll
    for (int gi = 0; gi < 2; ++gi) { const float gt = sigmf(GLOG[(m0 + tql[gi]) * 12 + h * 3 + 0] + gate_b[h * 3 + 0]);
#pragma unroll
        for (int dt = 0; dt < 4; ++dt)
#pragma unroll
            for (int r = 0; r < 4; ++r) otp[((gi * 4 + dt) * 4 + r) * 64] = G[gi].o[dt][r] * gt; }
#pragma unroll
    for (int gi = 0; gi < 2; ++gi) {
        const int tq = t0 + tql[gi];
        float xf[8]; unpack8(__builtin_bit_cast(v4u, G[gi].q[0]), xf);
        float of[8];
#pragma unroll
        for (int j = 0; j < 8; ++j) of[j] = __shfl_xor(xf[j], 16);
        if (L.g < 2) {
            const f32x4 c0 = *(const f32x4*)(ROPE + tq * 16), c1 = *(const f32x4*)(ROPE + tq * 16 + 4), s0 = *(const f32x4*)(ROPE + tq * 16 + 8), s1 = *(const f32x4*)(ROPE + tq * 16 + 12);
            const float cs[8] = {c0.x, c0.y, c0.z, c0.w, c1.x, c1.y, c1.z, c1.w}, sn[8] = {s0.x, s0.y, s0.z, s0.w, s1.x, s1.y, s1.z, s1.w};
#pragma unroll
            for (int j = 0; j < 8; ++j) xf[j] = (L.g == 0) ? (xf[j] * cs[j] - of[j] * sn[j]) : (xf[j] * cs[j] + of[j] * sn[j]);
        }
        G[gi].q[0] = __builtin_bit_cast(bf16x8, pack8(xf));
        grp_reset(G[gi]);
    }
    for (int rp_ = 0; rp_ < RPT(11); ++rp_) { grp_reset(G[0]); grp_reset(G[1]); SrcSel src{P, blist, true, b, C_KS, C_VS, 0}; BodySel body{G, L, blist, selm, tql, cur}; at_ring<true, 6>(ring, nsel, tid, wave, src, body); }
#pragma unroll
    for (int gi = 0; gi < 2; ++gi) { const float il = sigmf(GLOG[(m0 + tql[gi]) * 12 + h * 3 + 1] + gate_b[h * 3 + 1]) / fmaxf(xg_sum(G[gi].l), 1e-30f);
#pragma unroll
        for (int dt = 0; dt < 4; ++dt)
#pragma unroll
            for (int r = 0; r < 4; ++r) otp[((gi * 4 + dt) * 4 + r) * 64] += G[gi].o[dt][r] * il;
        grp_reset(G[gi]); }
    for (int rp_ = 0; rp_ < RPT(12); ++rp_) { grp_reset(G[0]); grp_reset(G[1]); const int s0 = max(0, cur - 8); SrcSel src{P, blist, false, b, C_KW, C_VW, s0}; BodyWin body{G, L, tql, cur, s0}; at_ring<true, 6>(ring, cur - s0 + 1, tid, wave, src, body); }
#pragma unroll
    for (int gi = 0; gi < 2; ++gi) { const float il = sigmf(GLOG[(m0 + tql[gi]) * 12 + h * 3 + 2] + gate_b[h * 3 + 2]) / fmaxf(xg_sum(G[gi].l), 1e-30f);
#pragma unroll
        for (int dt = 0; dt < 4; ++dt)
#pragma unroll
            for (int r = 0; r < 4; ++r) G[gi].o[dt][r] = otp[((gi * 4 + dt) * 4 + r) * 64] + G[gi].o[dt][r] * il; }
#pragma unroll
    for (int gi = 0; gi < 2; ++gi) {
        float ss = 0.f;
#pragma unroll
        for (int dt = 0; dt < 4; ++dt) ss += G[gi].o[dt].x * G[gi].o[dt].x + G[gi].o[dt].y * G[gi].o[dt].y + G[gi].o[dt].z * G[gi].o[dt].z + G[gi].o[dt].w * G[gi].o[dt].w;
        ss = xg_sum(ss); const float sc = 1.0f / sqrtf(ss * (1.f / 64.f) + 1e-6f);
        const size_t mq = m0 + tql[gi];
#pragma unroll
        for (int dt = 0; dt < 4; ++dt) { const int d = h * 64 + 16 * dt + 4 * L.g;
            const f32x4 gn = *(const f32x4*)(nsa_out_g + d); const v2u gt = *(const v2u*)(P + mq * NP + C_NG + d);
            const float o0 = G[gi].o[dt].x * sc * gn.x * siluf(bflo(gt.x)), o1 = G[gi].o[dt].y * sc * gn.y * siluf(bfhi(gt.x)), o2 = G[gi].o[dt].z * sc * gn.z * siluf(bflo(gt.y)), o3 = G[gi].o[dt].w * sc * gn.w * siluf(bfhi(gt.y));
            *(v2u*)(Y + mq * D + 512 + d) = (v2u){pk2(o0, o1), pk2(o2, o3)}; }
    }
}

struct SrcMem { const bf16* KV; int b; __device__ __forceinline__ void operator()(int i, const bf16*& kb, size_t& kp, const bf16*& vb, size_t& vp) const {
    const int hh = i >> 2, blk = i & 3; kb = KV + (size_t)(b * MEML + 64 * blk) * 512 + hh * 64; vb = kb + 256; kp = 512; vp = 512; } };
struct BodyMem { Grp (&G)[1]; const LaneGeo& L; const bf16* P; bf16* Y; const float* og; size_t mq;
    __device__ __forceinline__ void operator()(int i, LAS const unsigned char* slot) {
        const int hh = i >> 2, blk = i & 3;
        if (blk == 0) { const bf16* qp = P + mq * NP + C_MQ + hh * 64 + 8 * L.g; G[0].q[0] = *(const bf16x8*)qp; G[0].q[1] = *(const bf16x8*)(qp + 32); grp_reset(G[0]); }
        const int lo[1] = {0}, hi[1] = {63}; const bool need[1] = {true}, on[1] = {true};
        at_block<1, 2>(G, slot, L.koff0, L.koff1, L.vdt, L.g, lo, hi, need, on, false, nullptr, nullptr, 0, L.lane);
        if (blk == 3) {
            const float il = 1.0f / fmaxf(xg_sum(G[0].l), 1e-30f); float ss = 0.f;
#pragma unroll
            for (int dt = 0; dt < 4; ++dt) { G[0].o[dt] *= il; ss += G[0].o[dt].x * G[0].o[dt].x + G[0].o[dt].y * G[0].o[dt].y + G[0].o[dt].z * G[0].o[dt].z + G[0].o[dt].w * G[0].o[dt].w; }
            ss = xg_sum(ss); const float sc = 1.0f / sqrtf(ss * (1.f / 64.f) + 1e-6f);
#pragma unroll
            for (int dt = 0; dt < 4; ++dt) { const int d = hh * 64 + 16 * dt + 4 * L.g;
                const f32x4 gn = *(const f32x4*)(og + d); const v2u gt = *(const v2u*)(P + mq * NP + C_MG + d); const f32x4 o = G[0].o[dt];
                const float o0 = o.x * sc * gn.x * siluf(bflo(gt.x)), o1 = o.y * sc * gn.y * siluf(bfhi(gt.x)), o2 = o.z * sc * gn.z * siluf(bflo(gt.y)), o3 = o.w * sc * gn.w * siluf(bfhi(gt.y));
                *(v2u*)(Y + mq * D + 768 + d) = (v2u){pk2(o0, o1), pk2(o2, o3)}; }
        }
    } };

constexpr int RW_PITCH = 144, RW_MAT = 64 * RW_PITCH;
constexpr int RW_KKT = 0 * RW_MAT, RW_KD = 1 * RW_MAT, RW_U = 1 * RW_MAT, RW_BD = 2 * RW_MAT, RW_TII = 2 * RW_MAT, RW_RT = 3 * RW_MAT, RW_KH = 4 * RW_MAT, RW_BH = 5 * RW_MAT, RW_V = 6 * RW_MAT,
              RW_ABK = 7 * RW_MAT, RW_AVK = 8 * RW_MAT, RW_ARK = 9 * RW_MAT, RW_ARB = 10 * RW_MAT, RW_M1 = 11 * RW_MAT, RW_M2 = 12 * RW_MAT, RW_WC = 13 * RW_MAT, RW_TII2 = 13 * RW_MAT + 256 + 2048  ;
typedef short s16x4 __attribute__((ext_vector_type(4)));
#define MFMA16K16(a, b, c) __builtin_amdgcn_mfma_f32_16x16x16bf16_1k(a, b, c, 0, 0, 0)
__device__ __forceinline__ s16x4 ds_tr(LAS const unsigned char* p) { return __builtin_bit_cast(s16x4, __builtin_amdgcn_ds_read_tr16_b64_v4i16((LAS v4i16*)p)); }
__device__ __forceinline__ bf16x8 frag_rm(LAS const unsigned char* X, int row0, int k0, int i16, int g) { return *(const LAS bf16x8*)(X + (row0 + i16) * RW_PITCH + (k0 + 8 * g) * 2); }
__device__ __forceinline__ bf16x8 frag_tr(LAS const unsigned char* X, int k0, int col0, int i16, int g) {
    LAS const unsigned char* p = X + (k0 + 8 * g + (i16 >> 2)) * RW_PITCH + (col0 + 4 * (i16 & 3)) * 2;
    const s16x4 a = ds_tr(p), b = ds_tr(p + 4 * RW_PITCH);
    return (bf16x8){a[0], a[1], a[2], a[3], b[0], b[1], b[2], b[3]};
}
__device__ __forceinline__ f32x4 bf4_to_f32(s16x4 v) { return (f32x4){bf2f((unsigned short)v[0]), bf2f((unsigned short)v[1]), bf2f((unsigned short)v[2]), bf2f((unsigned short)v[3])}; }
__device__ __forceinline__ v2u f32_to_bf4(f32x4 v) { return (v2u){cvtpk(v.x, v.y), cvtpk(v.z, v.w)}; }

struct RwRaw { v4u rc, kc, vc, rp, kp, vp, a, lw; };
__device__ __forceinline__ void rwkv_load_raw(RwRaw& R, int u, int wave, int lane, const bf16* P, const bf16* Aarr, const bf16* LW) {
    const int bh = u >> 7, c = u & 127, b = bh >> 3, h = bh & 7; const int t = 8 * wave + (lane >> 3), ch = h * 64 + 8 * (lane & 7);
    const size_t m = (size_t)b * T + 64 * c + t; const bf16* pc = P + m * NP;
    R.rc = *(const v4u*)(pc + C_R + ch); R.kc = *(const v4u*)(pc + C_K + ch); R.vc = *(const v4u*)(pc + C_V + ch); R.a = *(const v4u*)(Aarr + m * 512 + ch); R.lw = *(const v4u*)(LW + m * 512 + ch);
    if (64 * c + t > 0) { const bf16* pp = pc - NP; R.rp = *(const v4u*)(pp + C_R + ch); R.kp = *(const v4u*)(pp + C_K + ch); R.vp = *(const v4u*)(pp + C_V + ch); }
    else { R.rp = (v4u){0u, 0u, 0u, 0u}; R.kp = R.rp; R.vp = R.rp; }
}
__device__ __forceinline__ void rwkv_chunk_unit(int u, const RwRaw& R, int u_next, RwRaw& Rn, LAS unsigned char* lds, int wave, int lane, const bf16* P, const bf16* Aarr, const bf16* LW, const float* mu, const float* k_k, const float* k_a,
                                                const float* r_k, float* BONUS, unsigned char* CHK_PR, unsigned char* CHK_QY) {
    const int bh = u >> 7, c = u & 127, b = bh >> 3, h = bh & 7;
    const size_t m0 = (size_t)b * T + 64 * c;
    asm volatile("" : "+v"(lane));
    const int i16 = lane & 15, g = lane >> 4;
    {
#define BFE(v, e) (((e) & 1) ? bfhi((v)[(e) >> 1]) : bflo((v)[(e) >> 1]))
        const int tl = lane >> 3, co = lane & 7, t = 8 * wave + tl, ch = h * 64 + 8 * co;
        LAS float* scan = (LAS float*)(lds + RW_ABK) + wave * 512;
        LAS float* psum = (LAS float*)(lds + RW_WC + 256);
        float inc[8];
#pragma unroll
        for (int e = 0; e < 8; ++e) inc[e] = BFE(R.lw, e);
        *(LAS f32x4*)(scan + tl * 64 + 8 * co) = (f32x4){inc[0], inc[1], inc[2], inc[3]}; *(LAS f32x4*)(scan + tl * 64 + 8 * co + 4) = (f32x4){inc[4], inc[5], inc[6], inc[7]};
#pragma unroll
        for (int tp = 0; tp < 7; ++tp) { const f32x4 x0 = *(const LAS f32x4*)(scan + tp * 64 + 8 * co), x1 = *(const LAS f32x4*)(scan + tp * 64 + 8 * co + 4);
            if (tp < tl) { inc[0] += x0.x; inc[1] += x0.y; inc[2] += x0.z; inc[3] += x0.w; inc[4] += x1.x; inc[5] += x1.y; inc[6] += x1.z; inc[7] += x1.w; } }
        if (tl == 7) { *(LAS f32x4*)(psum + wave * 64 + 8 * co) = (f32x4){inc[0], inc[1], inc[2], inc[3]}; *(LAS f32x4*)(psum + wave * 64 + 8 * co + 4) = (f32x4){inc[4], inc[5], inc[6], inc[7]}; }
        __syncthreads();
        if (u_next >= 0) rwkv_load_raw(Rn, u_next, wave, lane, P, Aarr, LW);
        float tot[8];
#pragma unroll
        for (int e = 0; e < 8; ++e) tot[e] = 0.f;
#pragma unroll
        for (int w2 = 0; w2 < 8; ++w2) { const f32x4 x0 = *(const LAS f32x4*)(psum + w2 * 64 + 8 * co), x1 = *(const LAS f32x4*)(psum + w2 * 64 + 8 * co + 4);
            const float xs[8] = {x0.x, x0.y, x0.z, x0.w, x1.x, x1.y, x1.z, x1.w};
#pragma unroll
            for (int e = 0; e < 8; ++e) { tot[e] += xs[e]; if (w2 < wave) inc[e] += xs[e]; } }
        float kk[8], ka[8], rr[8]; float ss = 0.f, bon = 0.f; v4u vpk;
#pragma unroll
        for (int q = 0; q < 2; ++q) {
            const f32x4 mr = *(const f32x4*)(mu + C_R + ch + 4 * q), mk = *(const f32x4*)(mu + C_K + ch + 4 * q), mv = *(const f32x4*)(mu + C_V + ch + 4 * q);
            const f32x4 kkc = *(const f32x4*)(k_k + ch + 4 * q), kac = *(const f32x4*)(k_a + ch + 4 * q), rkc = *(const f32x4*)(r_k + ch + 4 * q);
            float vv[4];
#pragma unroll
            for (int j = 0; j < 4; ++j) { const int e = 4 * q + j;
                const float rc = BFE(R.rc, e), kc = BFE(R.kc, e), vc = BFE(R.vc, e);
                rr[e] = rc + mr[j] * (BFE(R.rp, e) - rc); const float k = kc + mk[j] * (BFE(R.kp, e) - kc); vv[j] = vc + mv[j] * (BFE(R.vp, e) - vc);
                kk[e] = k * kkc[j]; ss += kk[e] * kk[e]; ka[e] = k * (1.f + (BFE(R.a, e) - 1.f) * kac[j]); bon += rr[e] * ka[e] * rkc[j]; }
            vpk[2 * q] = pk2(vv[0], vv[1]); vpk[2 * q + 1] = pk2(vv[2], vv[3]);
        }
        ss = sum8(ss); bon = sum8(bon);
        const float inv = 1.f / fmaxf(sqrtf(ss), 1e-12f);
        if (co == 0) BONUS[(m0 + t) * 8 + h] = bon;
        v4u p_kkt, p_kd, p_bd, p_rt, p_kh, p_bh;
#pragma unroll
        for (int i = 0; i < 4; ++i) {
            float okkt[2], okd[2], obd[2], ort[2], okh[2], obh[2];
#pragma unroll
            for (int j = 0; j < 2; ++j) { const int e = 2 * i + j; const float kn = kk[e] * inv, bbv = kn * BFE(R.a, e);
                const float cl = inc[e]; const float Wp = __expf(cl - BFE(R.lw, e)), Wt = __expf(cl), iW = __expf(-cl), hW = __expf(tot[e] - cl);
                okkt[j] = kn * Wp; okd[j] = ka[e] * iW; obd[j] = bbv * iW; ort[j] = rr[e] * Wt; okh[j] = ka[e] * hW; obh[j] = bbv * hW; }
            p_kkt[i] = pk2(okkt[0], okkt[1]); p_kd[i] = pk2(okd[0], okd[1]); p_bd[i] = pk2(obd[0], obd[1]); p_rt[i] = pk2(ort[0], ort[1]); p_kh[i] = pk2(okh[0], okh[1]); p_bh[i] = pk2(obh[0], obh[1]);
        }
        LAS unsigned char* row = lds + t * RW_PITCH + co * 16;
        *(LAS v4u*)(row + RW_KKT) = p_kkt; *(LAS v4u*)(row + RW_KD) = p_kd; *(LAS v4u*)(row + RW_BD) = p_bd; *(LAS v4u*)(row + RW_RT) = p_rt;
        *(LAS v4u*)(row + RW_KH) = p_kh; *(LAS v4u*)(row + RW_BH) = p_bh; *(LAS v4u*)(row + RW_V) = vpk;
        if (wave == 0 && tl == 0) { LAS float* wc = (LAS float*)(lds + RW_WC) + 8 * co;
#pragma unroll
            for (int e = 0; e < 8; ++e) wc[e] = __expf(tot[e]); }
#undef BFE
    }
    __syncthreads();
    {
        const int mb = wave & 3; const bool top = wave < 4;
        LAS const unsigned char* Am = lds + (top ? RW_KKT : RW_RT);
        const bf16x8 a0 = frag_rm(Am, 16 * mb, 0, i16, g), a1 = frag_rm(Am, 16 * mb, 32, i16, g);
#pragma unroll
        for (int nb = 0; nb < 8; ++nb) {
            const int jb = nb & 3; LAS const unsigned char* Bm = lds + (nb < 4 ? RW_BD : RW_KD);
            f32x4 d = {0.f, 0.f, 0.f, 0.f};
            if (jb <= mb) { d = MFMA16(a0, frag_rm(Bm, 16 * jb, 0, i16, g), d); d = MFMA16(a1, frag_rm(Bm, 16 * jb, 32, i16, g), d); }
            const int j = 16 * jb + i16, s0 = 16 * mb + 4 * g;
#pragma unroll
            for (int r = 0; r < 4; ++r) { const bool keep = top ? (j < s0 + r) : (j <= s0 + r); if (!keep) d[r] = 0.f; }
            LAS unsigned char* dst = lds + (top ? (nb < 4 ? RW_ABK : RW_AVK) : (nb < 4 ? RW_ARB : RW_ARK));
            *(LAS v2u*)(dst + j * RW_PITCH + s0 * 2) = f32_to_bf4(d);
        }
    }
    if (wave < 4) {
        const int blk = wave, cc = i16;
        float Tv[16];
#pragma unroll
        for (int s = 0; s < 16; ++s) Tv[s] = (s == cc) ? 1.f : 0.f;
#pragma unroll
        for (int j = 0; j < 15; ++j) {
            LAS const unsigned char* rowp = lds + RW_ABK + (16 * blk + j) * RW_PITCH + (16 * blk) * 2;
            float L[16]; { float t8[8]; unpack8(*(const LAS v4u*)rowp, t8);
#pragma unroll
                for (int e = 0; e < 8; ++e) L[e] = t8[e];
                unpack8(*(const LAS v4u*)(rowp + 16), t8);
#pragma unroll
                for (int e = 0; e < 8; ++e) L[8 + e] = t8[e]; }
            const float Tj = Tv[j];
#pragma unroll
            for (int s = j + 1; s < 16; ++s) Tv[s] -= L[s] * Tj;
        }
        if (g == 0) {
#pragma unroll
            for (int s = 0; s < 16; ++s) *(LAS unsigned short*)(lds + RW_TII2 + blk * 512 + s * 32 + cc * 2) = (unsigned short)f2bf(Tv[s]); }
        const int mb = wave;
        const bf16x8 a0 = frag_tr(lds + RW_AVK, 0, 16 * mb, i16, g), a1 = frag_tr(lds + RW_AVK, 32, 16 * mb, i16, g);
#pragma unroll
        for (int vt = 0; vt < 4; ++vt) {
            f32x4 d = {0.f, 0.f, 0.f, 0.f};
            d = MFMA16(a0, frag_tr(lds + RW_V, 0, 16 * vt, i16, g), d); d = MFMA16(a1, frag_tr(lds + RW_V, 32, 16 * vt, i16, g), d);
            *(LAS v2u*)(lds + RW_M2 + (16 * vt + i16) * RW_PITCH + (16 * mb + 4 * g) * 2) = f32_to_bf4(d);
        }
    }
    __syncthreads();
    {
        const int c0 = 16 * (wave & 3); const bool top = wave < 4;
        s16x4 Xb[4];
#pragma unroll
        for (int i = 0; i < 4; ++i) {
            f32x4 rhs;
            if (top) rhs = bf4_to_f32(ds_tr(lds + RW_KKT + (16 * i + 4 * g + (i16 >> 2)) * RW_PITCH + (c0 + 4 * (i16 & 3)) * 2));
            else { const v2u w2 = *(const LAS v2u*)(lds + RW_M2 + (c0 + i16) * RW_PITCH + (16 * i + 4 * g) * 2); rhs = (f32x4){bflo(w2.x), bfhi(w2.x), bflo(w2.y), bfhi(w2.y)}; }
            f32x4 acc = {0.f, 0.f, 0.f, 0.f};
#pragma unroll
            for (int k = 0; k < 4; ++k) if (k < i) {
                const s16x4 al = ds_tr(lds + RW_ABK + (16 * k + 4 * g + (i16 >> 2)) * RW_PITCH + (16 * i + 4 * (i16 & 3)) * 2);
                acc = MFMA16K16(al, Xb[k], acc); }
            rhs -= acc;
            const s16x4 rb = __builtin_bit_cast(s16x4, f32_to_bf4(rhs));
            const s16x4 at = __builtin_bit_cast(s16x4, *(const LAS v2u*)(lds + RW_TII2 + i * 512 + i16 * 32 + 8 * g));
            f32x4 X = {0.f, 0.f, 0.f, 0.f}; X = MFMA16K16(at, rb, X);
            Xb[i] = __builtin_bit_cast(s16x4, f32_to_bf4(X));
            *(LAS v2u*)(lds + (top ? RW_M1 : RW_M2) + (c0 + i16) * RW_PITCH + (16 * i + 4 * g) * 2) = f32_to_bf4(-X);
        }
    }
    __syncthreads();
    {
        const int nt = wave & 3;
        unsigned char* gpr = CHK_PR + (size_t)u * 16384; unsigned char* gqy = CHK_QY + (size_t)u * 16384;
        if (wave < 4) {
            const bf16x8 bh0 = frag_tr(lds + RW_BH, 0, 16 * nt, i16, g), bh1 = frag_tr(lds + RW_BH, 32, 16 * nt, i16, g);
            f32x4 d[4];
#pragma unroll
            for (int kt = 0; kt < 4; ++kt) { d[kt] = (f32x4){0.f, 0.f, 0.f, 0.f};
                d[kt] = MFMA16(frag_rm(lds + RW_M1, 16 * kt, 0, i16, g), bh0, d[kt]); d[kt] = MFMA16(frag_rm(lds + RW_M1, 16 * kt, 32, i16, g), bh1, d[kt]);
                if (kt == nt) {
#pragma unroll
                    for (int r = 0; r < 4; ++r) if (4 * g + r == i16) d[kt][r] += ((const LAS float*)(lds + RW_WC))[16 * kt + 4 * g + r]; } }
#pragma unroll
            for (int ks = 0; ks < 2; ++ks) { const v2u lo = f32_to_bf4(d[2 * ks]), hi = f32_to_bf4(d[2 * ks + 1]); *(v4u*)(gpr + (nt * 2 + ks) * 1024 + lane * 16) = (v4u){lo.x, lo.y, hi.x, hi.y}; }
            const bf16x8 kh0 = frag_tr(lds + RW_KH, 0, 16 * nt, i16, g), kh1 = frag_tr(lds + RW_KH, 32, 16 * nt, i16, g);
#pragma unroll
            for (int vt = 0; vt < 4; ++vt) { f32x4 q = {0.f, 0.f, 0.f, 0.f};
                q = MFMA16(kh0, frag_tr(lds + RW_V, 0, 16 * vt, i16, g), q); q = MFMA16(kh1, frag_tr(lds + RW_V, 32, 16 * vt, i16, g), q);
                q = MFMA16(bh0, frag_rm(lds + RW_M2, 16 * vt, 0, i16, g), q); q = MFMA16(bh1, frag_rm(lds + RW_M2, 16 * vt, 32, i16, g), q);
                *(v2u*)(gqy + ((vt * 4 + nt) * 64 + lane) * 8) = f32_to_bf4(q); }
        } else {
            const bf16x8 ab0 = frag_tr(lds + RW_ARB, 0, 16 * nt, i16, g), ab1 = frag_tr(lds + RW_ARB, 32, 16 * nt, i16, g);
            f32x4 d[4];
#pragma unroll
            for (int kt = 0; kt < 4; ++kt) { const v2u w2 = *(const LAS v2u*)(lds + RW_RT + (16 * nt + i16) * RW_PITCH + (16 * kt + 4 * g) * 2);
                d[kt] = (f32x4){bflo(w2.x), bfhi(w2.x), bflo(w2.y), bfhi(w2.y)};
                d[kt] = MFMA16(frag_rm(lds + RW_M1, 16 * kt, 0, i16, g), ab0, d[kt]); d[kt] = MFMA16(frag_rm(lds + RW_M1, 16 * kt, 32, i16, g), ab1, d[kt]); }
#pragma unroll
            for (int ks = 0; ks < 2; ++ks) { const v2u lo = f32_to_bf4(d[2 * ks]), hi = f32_to_bf4(d[2 * ks + 1]); *(v4u*)(gpr + 8192 + (nt * 2 + ks) * 1024 + lane * 16) = (v4u){lo.x, lo.y, hi.x, hi.y}; }
            const bf16x8 ak0 = frag_tr(lds + RW_ARK, 0, 16 * nt, i16, g), ak1 = frag_tr(lds + RW_ARK, 32, 16 * nt, i16, g);
#pragma unroll
            for (int vt = 0; vt < 4; ++vt) { f32x4 q = {0.f, 0.f, 0.f, 0.f};
                q = MFMA16(ak0, frag_tr(lds + RW_V, 0, 16 * vt, i16, g), q); q = MFMA16(ak1, frag_tr(lds + RW_V, 32, 16 * vt, i16, g), q);
                q = MFMA16(ab0, frag_rm(lds + RW_M2, 16 * vt, 0, i16, g), q); q = MFMA16(ab1, frag_rm(lds + RW_M2, 16 * vt, 32, i16, g), q);
                *(v2u*)(gqy + 8192 + ((vt * 4 + nt) * 64 + lane) * 8) = f32_to_bf4(q); }
        }
    }
    __syncthreads();
}

__device__ __forceinline__ void rwkv_scan_unit(int unit, int lane, const unsigned char* CHK_PR, const unsigned char* CHK_QY, unsigned char* CHK_S) {
    const int bh = unit >> 2, vt = unit & 3;
    f32x4 S[4];
#pragma unroll
    for (int kt = 0; kt < 4; ++kt) S[kt] = (f32x4){0.f, 0.f, 0.f, 0.f};
    constexpr int PD = 4;
    v4u pf[PD][8]; v2u qf[PD][4];
#pragma unroll
    for (int d = 0; d < PD; ++d) { const size_t u = (size_t)bh * 128 + d;
#pragma unroll
        for (int f = 0; f < 8; ++f) pf[d][f] = *(const v4u*)(CHK_PR + u * 16384 + f * 1024 + lane * 16);
#pragma unroll
        for (int mt = 0; mt < 4; ++mt) qf[d][mt] = *(const v2u*)(CHK_QY + u * 16384 + ((vt * 4 + mt) * 64 + lane) * 8); }
#pragma unroll 1
    for (int c0 = 0; c0 < 128; c0 += PD) {
#pragma unroll
        for (int d = 0; d < PD; ++d) {
            const int c = c0 + d; const size_t u = (size_t)bh * 128 + c;
            const v2u s0 = f32_to_bf4(S[0]), s1 = f32_to_bf4(S[1]), s2 = f32_to_bf4(S[2]), s3 = f32_to_bf4(S[3]);
            const v4u b0 = {s0.x, s0.y, s1.x, s1.y}, b1 = {s2.x, s2.y, s3.x, s3.y};
            *(v4u*)(CHK_S + u * 8192 + ((vt * 2 + 0) * 64 + lane) * 16) = b0; *(v4u*)(CHK_S + u * 8192 + ((vt * 2 + 1) * 64 + lane) * 16) = b1;
#pragma unroll
            for (int mt = 0; mt < 4; ++mt) { f32x4 acc = {bflo(qf[d][mt].x), bfhi(qf[d][mt].x), bflo(qf[d][mt].y), bfhi(qf[d][mt].y)};
                acc = MFMA16(__builtin_bit_cast(bf16x8, pf[d][mt * 2 + 0]), __builtin_bit_cast(bf16x8, b0), acc);
                acc = MFMA16(__builtin_bit_cast(bf16x8, pf[d][mt * 2 + 1]), __builtin_bit_cast(bf16x8, b1), acc); S[mt] = acc; }
            if (c + PD < 128) { const size_t un = u + PD;
#pragma unroll
                for (int f = 0; f < 8; ++f) pf[d][f] = *(const v4u*)(CHK_PR + un * 16384 + f * 1024 + lane * 16);
#pragma unroll
                for (int mt = 0; mt < 4; ++mt) qf[d][mt] = *(const v2u*)(CHK_QY + un * 16384 + ((vt * 4 + mt) * 64 + lane) * 8); }
        }
    }
}

__device__ __forceinline__ void rwkv_out_unit(int u, LAS unsigned char* wl  , int lane, const bf16* P, const unsigned char* CHK_PR, const unsigned char* CHK_QY, const unsigned char* CHK_S,
                                              const float* BONUS, const float* mu, const float* ln_w, const float* ln_b, bf16* Y) {
    const int bh = u >> 7, c = u & 127, b = bh >> 3, h = bh & 7;
    const size_t m0 = (size_t)b * T + 64 * c;
    const int i16 = lane & 15, g = lane >> 4;
    const int ch = h * 64 + lane;
    unsigned short pva[33], pga[33];
    if (64 * c > 0) { const bf16* pp = P + (m0 - 1) * NP; pva[0] = pp[C_V + ch]; pga[0] = pp[C_G + ch]; } else { pva[0] = 0; pga[0] = 0; }
#pragma unroll
    for (int t = 0; t < 32; ++t) { const bf16* pc = P + (m0 + t) * NP; pva[t + 1] = pc[C_V + ch]; pga[t + 1] = pc[C_G + ch]; }
    const float bmine = BONUS[(m0 + lane) * 8 + h];
    bf16x8 sf[4][2];
#pragma unroll
    for (int vt = 0; vt < 4; ++vt)
#pragma unroll
        for (int ks = 0; ks < 2; ++ks) sf[vt][ks] = *(const bf16x8*)(CHK_S + (size_t)u * 8192 + ((vt * 2 + ks) * 64 + lane) * 16);
#pragma unroll
    for (int tt = 0; tt < 4; ++tt) {
        const bf16x8 r0 = *(const bf16x8*)(CHK_PR + (size_t)u * 16384 + 8192 + (tt * 2 + 0) * 1024 + lane * 16), r1 = *(const bf16x8*)(CHK_PR + (size_t)u * 16384 + 8192 + (tt * 2 + 1) * 1024 + lane * 16);
        f32x4 y[4];
#pragma unroll
        for (int vt = 0; vt < 4; ++vt) { const v2u w2 = *(const v2u*)(CHK_QY + (size_t)u * 16384 + 8192 + ((vt * 4 + tt) * 64 + lane) * 8);
            y[vt] = (f32x4){bflo(w2.x), bfhi(w2.x), bflo(w2.y), bfhi(w2.y)};
            y[vt] = MFMA16(r0, sf[vt][0], y[vt]); y[vt] = MFMA16(r1, sf[vt][1], y[vt]); }
#pragma unroll
        for (int r = 0; r < 4; ++r) {
            float s = (y[0][r] + y[1][r]) + (y[2][r] + y[3][r]);
            s += dppf<0xB1>(s); s += dppf<0x4E>(s); s += dppf<0x141>(s); s += dppf<0x140>(s);
            const float mean = s * (1.f / 64.f);
            float q = 0.f;
#pragma unroll
            for (int vt = 0; vt < 4; ++vt) { y[vt][r] -= mean; q += y[vt][r] * y[vt][r]; }
            q += dppf<0xB1>(q); q += dppf<0x4E>(q); q += dppf<0x141>(q); q += dppf<0x140>(q);
            const float rstd = 1.0f / sqrtf(q * (1.f / 64.f) + 64e-5f);
#pragma unroll
            for (int vt = 0; vt < 4; ++vt) *(LAS unsigned short*)(wl + (16 * tt + 4 * g + r) * 132 + (16 * vt + i16) * 2) = (unsigned short)f2bf(y[vt][r] * rstd);
        }
    }
    const float muv = mu[C_V + ch], mug = mu[C_G + ch], lw = ln_w[ch], lb = ln_b[ch];
    unsigned short pvb[32], pgb[32];
#pragma unroll
    for (int t = 0; t < 32; ++t) { const bf16* pc = P + (m0 + 32 + t) * NP; pvb[t] = pc[C_V + ch]; pgb[t] = pc[C_G + ch]; }
#pragma unroll
    for (int t = 0; t < 32; ++t) {
        const float pvc = bf2f(pva[t + 1]), pgc = bf2f(pga[t + 1]), pvp = bf2f(pva[t]), pgp = bf2f(pga[t]);
        const float v = pvc + muv * (pvp - pvc), gt = pgc + mug * (pgp - pgc);
        const float yn = bf2f(*(const LAS unsigned short*)(wl + t * 132 + lane * 2));
        const float o = (yn * lw + lb + rdlane(bmine, t) * v) * siluf(gt);
        Y[(m0 + t) * D + ch] = (bf16)f2bf(o);
    }
#pragma unroll
    for (int t = 0; t < 32; ++t) {
        const float pvc = bf2f(pvb[t]), pgc = bf2f(pgb[t]), pvp = bf2f(t ? pvb[t - 1] : pva[32]), pgp = bf2f(t ? pgb[t - 1] : pga[32]);
        const float v = pvc + muv * (pvp - pvc), gt = pgc + mug * (pgp - pgc);
        const float yn = bf2f(*(const LAS unsigned short*)(wl + (32 + t) * 132 + lane * 2));
        const float o = (yn * lw + lb + rdlane(bmine, 32 + t) * v) * siluf(gt);
        Y[(m0 + 32 + t) * D + ch] = (bf16)f2bf(o);
    }
}

#ifndef PHASES
#define PHASES 0x3ff
#endif
__global__ void __launch_bounds__(NWAVES * 64, 2) hymba_fwd(Args args) {
    extern __shared__ __attribute__((aligned(16))) unsigned char lds_raw[];
    LAS unsigned char* lds = (LAS unsigned char*)lds_raw;
    volatile LAS unsigned* MISC = (volatile LAS unsigned*)(lds + MISC_OFF);
    const int tid = threadIdx.x, lane = tid & 63, wave = __builtin_amdgcn_readfirstlane(tid >> 6);
    const int G = gridDim.x; const int bx = blockIdx.x; const int vcu = (G % 8 == 0) ? (bx % 8) * (G / 8) + bx / 8 : bx;
    const int gw = vcu * NWAVES + wave, NGW = G * NWAVES;
    unsigned char* ws = args.ws;
    unsigned* ctl = (unsigned*)(ws + WS_CTL);
    const float* x = args.in[0]; const float* mem = args.in[1]; const float* norm_in_g = args.in[2]; const float* w_in = args.in[3];
    const float* mu = args.in[4]; const float* w0 = args.in[5]; const float* w_up = args.in[6]; const float* a0 = args.in[7]; const float* a_up = args.in[8];
    const float* k_k = args.in[9]; const float* k_a = args.in[10]; const float* r_k = args.in[11]; const float* ln_w = args.in[12]; const float* ln_b = args.in[13];
    const float* cmp_pos = args.in[14]; const float* ck_w1 = args.in[15]; const float* ck_w2 = args.in[16]; const float* cv_w1 = args.in[17]; const float* cv_w2 = args.in[18];
    const float* gate_b = args.in[19]; const float* nsa_out_g = args.in[20]; const float* mem_norm_g = args.in[21]; const float* w_mem_kv = args.in[22];
    const float* mem_out_g = args.in[23]; const float* w_out = args.in[24]; const float* norm_final_g = args.in[25];
    float* out = args.out;
    bf16* WT_IN = (bf16*)(ws + WS_WIN); bf16* WT_OUT = (bf16*)(ws + WS_WOUT);
    float* ROPE = (float*)(ws + WS_ROPE); float* RS = (float*)(ws + WS_RS); bf16* KCMP = (bf16*)(ws + WS_KCMP); bf16* VCMP = (bf16*)(ws + WS_VCMP);
    bf16* MEMKV = (bf16*)(ws + WS_MEMKV); float* GLOG = (float*)(ws + WS_GLOG);
    bf16* P = (bf16*)(ws + WS_P); bf16* XB = (bf16*)(ws + WS_XB); bf16* Y = (bf16*)(ws + WS_Y);
    bf16* AA = (bf16*)(ws + WS_A); bf16* LWA = (bf16*)(ws + WS_LW); float* BONUS = (float*)(ws + WS_BONUS);
    bf16* W1TK = (bf16*)(ws + WS_W1TK); bf16* W1TV = (bf16*)(ws + WS_W1TV); bf16* W2TK = (bf16*)(ws + WS_W2TK); bf16* W2TV = (bf16*)(ws + WS_W2TV);
    bf16* WUPT = (bf16*)(ws + WS_WUPT); bf16* AUPT = (bf16*)(ws + WS_AUPT); bf16* WKVT = (bf16*)(ws + WS_WKVT); bf16* MEMN = (bf16*)(ws + WS_MEMN);
    unsigned char* CHK_PR = ws + WS_CHK_PR; unsigned char* CHK_QY = ws + WS_CHK_QY; unsigned char* CHK_S = ws + WS_CHK_S;

    for (int u = tid; u < (LDS_BYTES - LDSCTL_OFF) / 4; u += NWAVES * 64) ((LAS unsigned*)(lds + LDSCTL_OFF))[u] = 0u;
    __syncthreads();
    XcdBarrier bar = xcd_barrier_post(ctl + CW_BAR, MISC + 8);

#pragma unroll 1
    for (int rep = 0; rep < RPT(0); ++rep) { if (PHASES & 1) {
        LAS float* wgt = (LAS float*)(lds + 81920);
#pragma unroll
        for (int j = 0; j < (D * 12) / (NWAVES * 64); ++j) { const int i = tid + j * NWAVES * 64; const int k = i / 12, c = i % 12; wgt[c * D + k] = norm_in_g[k] * w_in[(size_t)k * W_IN_COLS + GLOG_SRC + c]; }
        __syncthreads();
        LAS float* scr = (LAS float*)(lds + wave * 8704);
        constexpr int I_IN = 16 * (NP / 32), I_OUT = 16 * (D / 32), I_W1 = 32 * 2, I_KV = 16 * 16, I_UP = 16, I_W2 = 2;
        constexpr int O_OUT = I_IN, O_W1K = O_OUT + I_OUT, O_W1V = O_W1K + I_W1, O_KV = O_W1V + I_W1, O_WUP = O_KV + I_KV, O_AUP = O_WUP + I_UP, O_W2K = O_AUP + I_UP, O_W2V = O_W2K + I_W2, I_ALL = O_W2V + I_W2;
        for (int it = gw; it < I_ALL; it += NGW) {
            if (it < O_OUT) { const int kb = it / (NP / 32), nb = it % (NP / 32); const int src = 32 * nb + (32 * nb >= GLOG_SRC ? 12 : 0);
                p0_transpose_item(w_in, W_IN_COLS, src, norm_in_g, WT_IN, D, 32 * nb, 64 * kb, scr, lane); }
            else if (it < O_W1K) { const int r = it - O_OUT; p0_transpose_item(w_out, D, 32 * (r % (D / 32)), nullptr, WT_OUT, D, 32 * (r % (D / 32)), 64 * (r / (D / 32)), scr, lane); }
            else if (it < O_W1V) { const int r = it - O_W1K; p0_transpose_item(ck_w1, 64, 32 * (r & 1), nullptr, W1TK, 2048, 32 * (r & 1), 64 * (r >> 1), scr, lane); }
            else if (it < O_KV) { const int r = it - O_W1V; p0_transpose_item(cv_w1, 64, 32 * (r & 1), nullptr, W1TV, 2048, 32 * (r & 1), 64 * (r >> 1), scr, lane); }
            else if (it < O_WUP) { const int r = it - O_KV; p0_transpose_item(w_mem_kv, 512, 32 * (r & 15), nullptr, WKVT, D, 32 * (r & 15), 64 * (r >> 4), scr, lane); }
            else if (it < O_AUP) { const int r = it - O_WUP; p0_transpose_item(w_up, 512, 32 * r, nullptr, WUPT, 64, 32 * r, 0, scr, lane); }
            else if (it < O_W2K) { const int r = it - O_AUP; p0_transpose_item(a_up, 512, 32 * r, nullptr, AUPT, 64, 32 * r, 0, scr, lane); }
            else if (it < O_W2V) { const int r = it - O_W2K; p0_transpose_item(ck_w2, 64, 32 * r, nullptr, W2TK, 64, 32 * r, 0, scr, lane); }
            else { const int r = it - O_W2V; p0_transpose_item(cv_w2, 64, 32 * r, nullptr, W2TV, 64, 32 * r, 0, scr, lane); }
        }
        for (int m = gw; m < NB * MEML; m += NGW) {
            const f32x4* xr = (const f32x4*)(mem + (size_t)m * D) + lane; f32x4 v[4]; float ss = 0.f;
#pragma unroll
            for (int j = 0; j < 4; ++j) { v[j] = xr[64 * j]; ss += (v[j].x * v[j].x + v[j].y * v[j].y) + (v[j].z * v[j].z + v[j].w * v[j].w); }
            ss = wave_sum(ss); const float rs = 1.0f / sqrtf(ss * (1.f / D) + 1e-6f);
            unsigned long long* o8 = (unsigned long long*)(MEMN + (size_t)m * D) + lane;
#pragma unroll
            for (int j = 0; j < 4; ++j) { const f32x4 gg = *((const f32x4*)mem_norm_g + 64 * j + lane); const f32x4 y = v[j] * rs * gg; o8[64 * j] = (unsigned long long)pk2(y.x, y.y) | ((unsigned long long)pk2(y.z, y.w) << 32); }
        }
        for (int i = gw * 64 + lane; i < T * 8; i += NGW * 64) { float c, s; rope_cs(i >> 3, i & 7, c, s); ROPE[(i >> 3) * 16 + (i & 7)] = c; ROPE[(i >> 3) * 16 + 8 + (i & 7)] = s; }
        {
        f32x4 vn[4];
        if (gw < M) { const f32x4* xr = (const f32x4*)(x + (size_t)gw * D) + lane;
#pragma unroll
            for (int j = 0; j < 4; ++j) vn[j] = xr[64 * j]; }
        for (int m = gw; m < M; m += NGW) {
            f32x4 v[4]; float ss = 0.f;
#pragma unroll
            for (int j = 0; j < 4; ++j) v[j] = vn[j];
            if (m + NGW < M) { const f32x4* xr = (const f32x4*)(x + (size_t)(m + NGW) * D) + lane;
#pragma unroll
                for (int j = 0; j < 4; ++j) vn[j] = xr[64 * j]; }
#pragma unroll
            for (int j = 0; j < 4; ++j) ss += (v[j].x * v[j].x + v[j].y * v[j].y) + (v[j].z * v[j].z + v[j].w * v[j].w);
            ss = wave_sum(ss);
            const float rs = 1.0f / sqrtf(ss * (1.f / D) + 1e-6f);
            unsigned long long* o8 = (unsigned long long*)(XB + (size_t)m * D) + lane;
#pragma unroll
            for (int j = 0; j < 4; ++j) o8[64 * j] = (unsigned long long)pk2(v[j].x, v[j].y) | ((unsigned long long)pk2(v[j].z, v[j].w) << 32);
            float mine = 0.f;
#pragma unroll 2
            for (int c = 0; c < 12; ++c) {
                float a = 0.f;
#pragma unroll
                for (int j = 0; j < 4; ++j) { const f32x4 w4 = *(const LAS f32x4*)(wgt + c * D + 256 * j + 4 * lane); a += (v[j].x * w4.x + v[j].y * w4.y) + (v[j].z * w4.z + v[j].w * w4.w); }
                a = wave_sum(a); if (lane == c) mine = a;
            }
            if (lane < 12) GLOG[(size_t)m * 12 + lane] = mine * rs;
            if (lane == 0) RS[m] = rs;
        }
        }
    }
    xcd_barrier(bar); }

    for (int rep = 0; rep < RPT(1); ++rep) { if (PHASES & 2) {
        pg8::Gemm g{XB, WT_IN, M, NP, D}; pg8::StaticOrder S; S.init(M, NP, G, bx);
        pg8::EpiRowScaleBf16 E{P, NP, RS};
        pg8::gemm_phase<pg8::EpiRowScaleBf16, pg8::StaticOrder, true, true>(lds, g, S, E);
    }
    xcd_barrier(bar); }

    for (int rb_ = 0; rb_ < 4 * (RPT(18) - 1); ++rb_) xcd_barrier(bar);
    for (int rep = 0; rep < RPT(2); ++rep) { if (PHASES & 4) {
        const int i16 = lane & 15, g = lane >> 4;
        constexpr int U_CMP = NB * 32 * 2, U_KV = 64 * 8, U_LORA = M / 16;
        for (int pass = 0; pass < 2; ++pass)
        for (int idx = (pass == 0 ? (wave == 0 ? vcu : (wave <= 2 ? U_CMP + vcu * 2 + (wave - 1) : U_CMP + U_KV)) : U_CMP + U_KV + gw);
             idx < (pass == 0 ? (wave == 0 ? U_CMP : (wave <= 2 ? U_CMP + U_KV : 0)) : U_CMP + U_KV + U_LORA); idx += (pass == 0 ? (wave == 0 ? G : 2 * G) : NGW)) {
            if (idx < U_CMP) {
                const int kv = idx & 1, ct = (idx >> 1) & 31, b = idx >> 6;
                const bf16* W1T = kv ? W1TV : W1TK; const bf16* W2T = kv ? W2TV : W2TK; const int col = kv ? C_VC : C_KC; bf16* dst = kv ? VCMP : KCMP;
                const int c = 16 * ct + i16, cl = min(c, NCMP - 1);
                const bf16* wbase = P + (size_t)(b * T + 16 * cl) * NP + col + 8 * g;
                f32x4 acc[4];
#pragma unroll
                for (int mt = 0; mt < 4; ++mt) acc[mt] = (f32x4){0.f, 0.f, 0.f, 0.f};
#pragma unroll 1
                for (int k4 = 0; k4 < 64; k4 += 4) {
                    v4u wv[4]; f32x4 p0[4], p1[4]; bf16x8 af[4][4];
#pragma unroll
                    for (int q = 0; q < 4; ++q) { const int ks = k4 + q, l = ks >> 1, db = 32 * (ks & 1);
                        wv[q] = *(const v4u*)(wbase + (size_t)l * NP + db); p0[q] = *(const f32x4*)(cmp_pos + l * 64 + db + 8 * g); p1[q] = *(const f32x4*)(cmp_pos + l * 64 + db + 8 * g + 4);
#pragma unroll
                        for (int mt = 0; mt < 4; ++mt) af[q][mt] = *(const bf16x8*)(W1T + (size_t)(16 * mt + i16) * 2048 + 32 * ks + 8 * g); }
#pragma unroll
                    for (int q = 0; q < 4; ++q) {
                        float wf[8]; unpack8(wv[q], wf);
                        wf[0] += p0[q].x; wf[1] += p0[q].y; wf[2] += p0[q].z; wf[3] += p0[q].w; wf[4] += p1[q].x; wf[5] += p1[q].y; wf[6] += p1[q].z; wf[7] += p1[q].w;
                        const bf16x8 bfr = __builtin_bit_cast(bf16x8, pack8(wf));
#pragma unroll
                        for (int mt = 0; mt < 4; ++mt) acc[mt] = MFMA16(af[q][mt], bfr, acc[mt]);
                    }
                }
                v2u hb[4];
#pragma unroll
                for (int mt = 0; mt < 4; ++mt) hb[mt] = f32_to_bf4((f32x4){siluf(acc[mt].x), siluf(acc[mt].y), siluf(acc[mt].z), siluf(acc[mt].w)});
                const bf16x8 b0 = __builtin_bit_cast(bf16x8, (v4u){hb[0].x, hb[0].y, hb[1].x, hb[1].y}), b1 = __builtin_bit_cast(bf16x8, (v4u){hb[2].x, hb[2].y, hb[3].x, hb[3].y});
#pragma unroll
                for (int mt = 0; mt < 4; ++mt) {
                    const bf16* wr = W2T + (16 * mt + i16) * 64 + 4 * g;
                    const v2u a00 = *(const v2u*)wr, a01 = *(const v2u*)(wr + 16), a10 = *(const v2u*)(wr + 32), a11 = *(const v2u*)(wr + 48);
                    f32x4 o = {0.f, 0.f, 0.f, 0.f};
                    o = MFMA16(__builtin_bit_cast(bf16x8, (v4u){a00.x, a00.y, a01.x, a01.y}), b0, o); o = MFMA16(__builtin_bit_cast(bf16x8, (v4u){a10.x, a10.y, a11.x, a11.y}), b1, o);
                    if (c >= NCMP) o = (f32x4){0.f, 0.f, 0.f, 0.f};
                    *(v2u*)(dst + (size_t)(b * 512 + c) * 64 + 16 * mt + 4 * g) = f32_to_bf4(o);
                }
            } else if (idx < U_CMP + U_KV) {
                const int r2 = idx - U_CMP, rt = r2 >> 3, cg = r2 & 7;
                const bf16* arow = WKVT + (size_t)(64 * cg + i16) * D + 8 * g; const bf16* brow = MEMN + (size_t)(16 * rt + i16) * D + 8 * g;
                f32x4 acc[4];
#pragma unroll
                for (int mt = 0; mt < 4; ++mt) acc[mt] = (f32x4){0.f, 0.f, 0.f, 0.f};
#pragma unroll 1
                for (int k4 = 0; k4 < 32; k4 += 4) {
                    bf16x8 bq[4], aq[4][4];
#pragma unroll
                    for (int q = 0; q < 4; ++q) { bq[q] = *(const bf16x8*)(brow + 32 * (k4 + q));
#pragma unroll
                        for (int mt = 0; mt < 4; ++mt) aq[q][mt] = *(const bf16x8*)(arow + (size_t)(16 * mt) * D + 32 * (k4 + q)); }
#pragma unroll
                    for (int q = 0; q < 4; ++q)
#pragma unroll
                        for (int mt = 0; mt < 4; ++mt) acc[mt] = MFMA16(aq[q][mt], bq[q], acc[mt]);
                }
#pragma unroll
                for (int mt = 0; mt < 4; ++mt) *(v2u*)(MEMKV + (size_t)(16 * rt + i16) * 512 + 64 * cg + 16 * mt + 4 * g) = f32_to_bf4(acc[mt]);
            } else {
                const int u = idx - U_CMP - U_KV; const size_t m = (size_t)u * 16 + i16; const int t = (int)(m & (T - 1)); const bool hp = t > 0;
                const bf16* pr = P + m * NP; const bf16* pp = pr - NP;
                bf16x8 bw[2], ba[2];
#pragma unroll
                for (int ks = 0; ks < 2; ++ks) {
                    const int j0 = 32 * ks + 8 * g; float cw[8], pw[8], ca[8], pa[8];
                    unpack8(*(const v4u*)(pr + C_WD + j0), cw); unpack8(*(const v4u*)(pr + C_AD + j0), ca);
                    if (hp) { unpack8(*(const v4u*)(pp + C_WD + j0), pw); unpack8(*(const v4u*)(pp + C_AD + j0), pa); }
                    else {
#pragma unroll
                        for (int e = 0; e < 8; ++e) { pw[e] = 0.f; pa[e] = 0.f; } }
#pragma unroll
                    for (int e = 0; e < 8; ++e) { cw[e] = tanhf(cw[e] + mu[C_WD + j0 + e] * (pw[e] - cw[e])); ca[e] = ca[e] + mu[C_AD + j0 + e] * (pa[e] - ca[e]); }
                    bw[ks] = __builtin_bit_cast(bf16x8, pack8(cw)); ba[ks] = __builtin_bit_cast(bf16x8, pack8(ca));
                }
#pragma unroll 1
                for (int m4 = 0; m4 < 32; m4 += 4) {
                    bf16x8 wa[4][2], aa[4][2]; f32x4 w0q[4], a0q[4];
#pragma unroll
                    for (int q = 0; q < 4; ++q) { const int mt = m4 + q; const bf16* wu = WUPT + (16 * mt + i16) * 64 + 8 * g; const bf16* au = AUPT + (16 * mt + i16) * 64 + 8 * g;
                        wa[q][0] = *(const bf16x8*)wu; wa[q][1] = *(const bf16x8*)(wu + 32); aa[q][0] = *(const bf16x8*)au; aa[q][1] = *(const bf16x8*)(au + 32);
                        w0q[q] = *(const f32x4*)(w0 + 16 * mt + 4 * g); a0q[q] = *(const f32x4*)(a0 + 16 * mt + 4 * g); }
#pragma unroll
                    for (int q = 0; q < 4; ++q) { const int mt = m4 + q;
                        f32x4 dw = {0.f, 0.f, 0.f, 0.f}, da = {0.f, 0.f, 0.f, 0.f};
                        dw = MFMA16(wa[q][0], bw[0], dw); dw = MFMA16(wa[q][1], bw[1], dw); da = MFMA16(aa[q][0], ba[0], da); da = MFMA16(aa[q][1], ba[1], da);
                        const int c = 16 * mt + 4 * g; f32x4 lo, ao;
#pragma unroll
                        for (int r = 0; r < 4; ++r) { const float nx = -(w0q[q][r] + dw[r]); const float sp = fmaxf(nx, 0.f) + __logf(1.f + __expf(-fabsf(nx))); lo[r] = -__expf(-sp - 0.5f); ao[r] = sigmf(a0q[q][r] + da[r]); }
                        *(v2u*)(LWA + m * 512 + c) = f32_to_bf4(lo); *(v2u*)(AA + m * 512 + c) = f32_to_bf4(ao);
                    }
                }
                { bf16* q = P + m * NP + ((g & 1) ? C_KW : C_KS) + 4 * (g >> 1);
                  const v2u x1 = *(const v2u*)q, x2 = *(const v2u*)(q + 8); const f32x4 cs = *(const f32x4*)(ROPE + t * 16 + 4 * (g >> 1)), sn = *(const f32x4*)(ROPE + t * 16 + 8 + 4 * (g >> 1));
                  const f32x4 a1 = {bflo(x1.x), bfhi(x1.x), bflo(x1.y), bfhi(x1.y)}, a2 = {bflo(x2.x), bfhi(x2.x), bflo(x2.y), bfhi(x2.y)};
                  if (rep == 0) { *(v2u*)q = f32_to_bf4(a1 * cs - a2 * sn); *(v2u*)(q + 8) = f32_to_bf4(a2 * cs + a1 * sn); } }
            }
        }
    }
    xcd_barrier(bar); }

    for (int rep = 0; rep < RPT(3); ++rep) { if (PHASES & 8) {
        RwRaw Rc, Rn; Rn = RwRaw{};
        if (vcu < NB * 8 * 128) rwkv_load_raw(Rc, vcu, wave, lane, P, AA, LWA);
        for (int u = vcu; u < NB * 8 * 128; u += G) { const int un = (u + G < NB * 8 * 128) ? u + G : -1;
            rwkv_chunk_unit(u, Rc, un, Rn, lds, wave, lane, P, AA, LWA, mu, k_k, k_a, r_k, BONUS, CHK_PR, CHK_QY); Rc = Rn; }
    }
    xcd_barrier(bar); }
    for (int rep = 0; rep < RPT(4); ++rep) if ((PHASES & 128) && wave == 0) {
        for (int unit = bx; unit < NB * 8 * 4; unit += G) rwkv_scan_unit(unit, lane, CHK_PR, CHK_QY, CHK_S);
    }
    for (int rep = 0; rep < RPT(6); ++rep) if (PHASES & 512) {
        const int mu0 = (G == 256) ? (bx >= 128 ? 2 * (bx - 128) : 256) : bx, mu1 = (G == 256) ? (bx >= 128 ? mu0 + 2 : 256) : 256, mus = (G == 256) ? 1 : G;
        for (int u = mu0; u < mu1; u += mus) {
            const int b = u >> 6; const size_t m0 = (size_t)b * T + 128 * (u & 63);
            Grp GM[1]; const LaneGeo L = make_geo(lane);
            SrcMem src{MEMKV, b}; BodyMem body{GM, L, P, Y, mem_out_g, m0 + 16 * wave + L.i16};
            at_ring<true, 6>(lds, 16, tid, wave, src, body);
        }
    }
    for (int rep = 0; rep < RPT(5); ++rep) if (PHASES & 256) {
        for (int pr = vcu; pr < 256; pr += G)
#pragma unroll 1
            for (int half = 0; half < 2; ++half)
                nsa_unit(pr >> 6, half ? 127 - (pr & 63) : (pr & 63), lds, tid, wave, lane, P, KCMP, VCMP, GLOG, gate_b, nsa_out_g, ROPE, Y, (float*)(ws + WS_OTP) + (size_t)(bx * NWAVES + wave) * 2048);
    }
    xcd_barrier(bar);

    for (int rep = 0; rep < RPT(7); ++rep) { if (PHASES & 16) {
        for (int u = gw; u < NB * 8 * 128; u += NGW) rwkv_out_unit(u, lds + wave * 8448, lane, P, CHK_PR, CHK_QY, CHK_S, BONUS, mu, ln_w, ln_b, Y);
    }
    xcd_barrier(bar); }

#pragma unroll 1
    for (int rep = 0; rep < RPT(13); ++rep) { if (PHASES & 32) {
        pg8::Gemm g{Y, WT_OUT, M, D, D}; pg8::StaticOrder S; S.init(M, D, G, bx);
        pg8::EpiResF32 E{x, out, D};
        pg8::gemm_phase<pg8::EpiResF32, pg8::StaticOrder, true, true>(lds, g, S, E);
    }
    xcd_barrier(bar); }

    if (PHASES & 64) for (int m = gw; m < M; m += NGW) {
        f32x4* xr = (f32x4*)(out + (size_t)m * D) + lane;
        f32x4 v[4]; float ss = 0.f;
#pragma unroll
        for (int j = 0; j < 4; ++j) { v[j] = xr[64 * j]; ss += (v[j].x * v[j].x + v[j].y * v[j].y) + (v[j].z * v[j].z + v[j].w * v[j].w); }
        ss = wave_sum(ss);
        const float rs = 1.0f / sqrtf(ss * (1.f / D) + 1e-6f);
#pragma unroll
        for (int j = 0; j < 4; ++j) { const f32x4 g = *((const f32x4*)norm_final_g + 64 * j + lane); xr[64 * j] = v[j] * rs * g; }
    }
}

extern "C" void kernel_launch(void* const* d_in, const int* in_sizes, int n_in, void* d_out, int out_size, void* d_ws, size_t ws_size, hipStream_t stream) {
    static int grid = 0;
    if (grid == 0) {
        if (n_in != 26 || in_sizes[0] != M * D || out_size != M * D || ws_size < WS_END) { fprintf(stderr, "kernel_launch: unexpected shapes (n_in %d, in0 %d, out %d, ws %zu); nothing launched\n", n_in, n_in > 0 ? in_sizes[0] : -1, out_size, ws_size); grid = -1; return; }
        int dev = 0, cus = 0;
        if (hipGetDevice(&dev) != hipSuccess || hipDeviceGetAttribute(&cus, hipDeviceAttributeMultiprocessorCount, dev) != hipSuccess) { grid = -1; return; }
        if (hipFuncSetAttribute((const void*)hymba_fwd, hipFuncAttributeMaxDynamicSharedMemorySize, LDS_BYTES) != hipSuccess) { fprintf(stderr, "kernel_launch: hipFuncSetAttribute failed\n"); grid = -1; return; }
        (void)hipGetLastError();
        grid = cus;
    }
    if (grid < 0) return;
    (void)hipMemsetAsync((char*)d_ws + WS_CTL, 0, CTL_ZERO_BYTES, stream);
    Args a{};
    for (int i = 0; i < 26; ++i) a.in[i] = (const float*)d_in[i];
    a.out = (float*)d_out; a.ws = (unsigned char*)d_ws;
    hipLaunchKernelGGL(hymba_fwd, dim3(grid), dim3(NWAVES * 64), LDS_BYTES, stream, a);
}
```
